# Optimizing an MI355X kernel written in HIP

```python
import math
import jax, jax.numpy as jnp
from jax import lax
import numpy as np

D_MODEL = 1024
BATCH = 32
SEQ = 2048
DEPTH = 4

N_MIXERS = 2
N_GLA = (DEPTH + 1) // 2
N_MLA = DEPTH // 2
EXPAND = 2
D_BRANCH = EXPAND * D_MODEL
GLA_HEADS = 4
GLA_DK = (D_MODEL // 2) // GLA_HEADS
GLA_DV = D_BRANCH // GLA_HEADS
GLA_GATE_RANK = 16
GLA_TAU = 16.0
GLA_CHUNK = 64
GLA_IN = 2 * GLA_HEADS * GLA_DK + 2 * D_BRANCH + 2 * GLA_GATE_RANK
MLA_HEADS = 16
MLA_Q_RANK = 384
MLA_KV_RANK = 256
MLA_NOPE = 128
MLA_ROPE = 64
MLA_DV = D_BRANCH // MLA_HEADS
MLA_IN = MLA_Q_RANK + MLA_KV_RANK + MLA_ROPE + D_BRANCH
ROPE_BASE = 10000.0
Q_BLOCK = 128
ALPHA = (2 * DEPTH) ** 0.25
BETA = (8 * DEPTH) ** -0.25
EPS = 1e-5

kernel_name = "hybrid_gla_mla_deepnorm_encoder"


def layer_norm(x, g, b):
    xf = x.astype(jnp.float32)
    mu = jnp.mean(xf, axis=-1, keepdims=True)
    var = jnp.mean(jnp.square(xf - mu), axis=-1, keepdims=True)
    return ((xf - mu) * lax.rsqrt(var + EPS) * g + b).astype(x.dtype)


def rms_norm(x, g):
    xf = x.astype(jnp.float32)
    return (xf * lax.rsqrt(jnp.mean(jnp.square(xf), axis=-1, keepdims=True) + EPS) * g).astype(x.dtype)


def rope_tables(positions):
    inv_freq = 1.0 / (ROPE_BASE ** (jnp.arange(0, MLA_ROPE, 2, dtype=jnp.float32) / MLA_ROPE))
    ang = positions.astype(jnp.float32)[..., None] * inv_freq
    return jnp.cos(ang), jnp.sin(ang)


def apply_rope(x, cos, sin):
    xf = x.astype(jnp.float32)
    x1, x2 = xf[..., : MLA_ROPE // 2], xf[..., MLA_ROPE // 2:]
    return jnp.concatenate([x1 * cos - x2 * sin, x2 * cos + x1 * sin], axis=-1).astype(x.dtype)


def gla_scan(q, k, v, lg):
    B, S, H, DK = q.shape
    DV = v.shape[-1]
    n = S // GLA_CHUNK

    def to_chunks(t):
        return t.reshape(B, n, GLA_CHUNK, H, t.shape[-1]).transpose(1, 0, 3, 2, 4)

    mask = jnp.tril(jnp.ones((GLA_CHUNK, GLA_CHUNK), dtype=bool))[None, None, :, :, None]

    def step(state, inp):
        qc, kc, vc, gc = inp
        b = jnp.cumsum(gc, axis=2)
        b_end = b[:, :, -1:, :]
        o_inter = jnp.einsum('bhcd,bhde->bhce', qc * jnp.exp(b), state)
        diff = b[:, :, :, None, :] - b[:, :, None, :, :]
        decay = jnp.where(mask, jnp.exp(jnp.where(mask, diff, 0.0)), 0.0)
        scores = jnp.einsum('bhid,bhjd,bhijd->bhij', qc, kc, decay)
        o_intra = jnp.einsum('bhij,bhje->bhie', scores, vc)
        new_state = (jnp.exp(b_end)[:, :, 0, :, None] * state
                     + jnp.einsum('bhcd,bhce->bhde', kc * jnp.exp(b_end - b), vc))
        return new_state, o_inter + o_intra

    state0 = jnp.zeros((B, H, DK, DV), jnp.float32)
    _, o = lax.scan(step, state0, (to_chunks(q), to_chunks(k), to_chunks(v), to_chunks(lg)))
    return o.transpose(1, 0, 3, 2, 4).reshape(B, S, H, DV)


def gla_mixer(x, w_in, w_gate, b_gate, gn_g, w_out):
    B, S, _ = x.shape
    dqk = GLA_HEADS * GLA_DK
    h = x @ w_in
    q, k, v, z, glr = jnp.split(h, [dqk, 2 * dqk, 2 * dqk + D_BRANCH, 2 * dqk + 2 * D_BRANCH], axis=-1)
    q = q.reshape(B, S, GLA_HEADS, GLA_DK) * (GLA_DK ** -0.5)
    k = k.reshape(B, S, GLA_HEADS, GLA_DK)
    v = v.reshape(B, S, GLA_HEADS, GLA_DV)
    glr = glr.reshape(B, S, 2, GLA_GATE_RANK)
    pre = jnp.einsum('bsnr,nrk->bsnk', glr, w_gate) + b_gate
    lg = (jax.nn.log_sigmoid(pre.astype(jnp.float32)) / GLA_TAU).reshape(B, S, 2, GLA_HEADS, GLA_DK)
    o_fw = gla_scan(q, k, v, lg[:, :, 0])
    o_bw = jnp.flip(gla_scan(jnp.flip(q, 1), jnp.flip(k, 1), jnp.flip(v, 1), jnp.flip(lg[:, :, 1], 1)), 1)
    o = (o_fw + o_bw).astype(jnp.float32)
    o = o * lax.rsqrt(jnp.mean(jnp.square(o), axis=-1, keepdims=True) + EPS)
    o = (o.reshape(B, S, D_BRANCH) * gn_g).astype(x.dtype)
    return (o * jax.nn.silu(z)) @ w_out


def mla_mixer(x, cos, sin, w_in, q_norm_g, kv_norm_g, w_uq, w_ukv, w_out):
    B, S, _ = x.shape
    h = x @ w_in
    cq, ckv, kr, z = jnp.split(h, [MLA_Q_RANK, MLA_Q_RANK + MLA_KV_RANK,
                                   MLA_Q_RANK + MLA_KV_RANK + MLA_ROPE], axis=-1)
    q = (rms_norm(cq, q_norm_g) @ w_uq).reshape(B, S, MLA_HEADS, MLA_NOPE + MLA_ROPE)
    qn = q[..., :MLA_NOPE]
    qr = apply_rope(q[..., MLA_NOPE:], cos[:, :, None], sin[:, :, None])
    kv = (rms_norm(ckv, kv_norm_g) @ w_ukv).reshape(B, S, MLA_HEADS, MLA_NOPE + MLA_DV)
    kn, v = kv[..., :MLA_NOPE], kv[..., MLA_NOPE:]
    kr = apply_rope(kr, cos, sin)
    scale = (MLA_NOPE + MLA_ROPE) ** -0.5
    nb = S // Q_BLOCK
    qn_b = qn.reshape(B, nb, Q_BLOCK, MLA_HEADS, MLA_NOPE).transpose(1, 0, 2, 3, 4)
    qr_b = qr.reshape(B, nb, Q_BLOCK, MLA_HEADS, MLA_ROPE).transpose(1, 0, 2, 3, 4)

    def attend(blk):
        qn_i, qr_i = blk
        s = jnp.einsum('bqhd,bkhd->bhqk', qn_i, kn) + jnp.einsum('bqhd,bkd->bhqk', qr_i, kr)
        p = jax.nn.softmax(s.astype(jnp.float32) * scale, axis=-1)
        return jnp.einsum('bhqk,bkhd->bqhd', p.astype(v.dtype), v)

    o = lax.map(attend, (qn_b, qr_b))
    o = o.transpose(1, 0, 2, 3, 4).reshape(B, S, D_BRANCH)
    return (o * jax.nn.silu(z)) @ w_out


def setup_inputs(seed: int = 0) -> dict:
    key = jax.random.key(seed)
    ks = jax.random.split(key, 16)
    nrm = jax.random.normal
    f32 = jnp.float32
    x = nrm(ks[0], (BATCH, SEQ, D_MODEL), f32)
    offsets = jax.random.randint(ks[1], (BATCH, 1), 0, 4096, dtype=jnp.int32)
    positions = offsets + jnp.arange(SEQ, dtype=jnp.int32)[None, :]
    ln_g = 1.0 + 0.02 * nrm(ks[2], (DEPTH, D_MODEL), f32)
    ln_b = 0.02 * nrm(ks[3], (DEPTH, D_MODEL), f32)
    gla_w_in = nrm(ks[4], (N_GLA, D_MODEL, GLA_IN), f32) * D_MODEL ** -0.5
    gla_w_gate = nrm(ks[5], (N_GLA, 2, GLA_GATE_RANK, GLA_HEADS * GLA_DK), f32) * GLA_GATE_RANK ** -0.5
    gla_b_gate = 0.5 * nrm(ks[6], (N_GLA, 2, GLA_HEADS * GLA_DK), f32)
    gla_gn_g = 1.0 + 0.02 * nrm(ks[7], (N_GLA, D_BRANCH), f32)
    gla_w_out = nrm(ks[8], (N_GLA, D_BRANCH, D_MODEL), f32) * (D_BRANCH ** -0.5) * BETA
    mla_w_in = nrm(ks[9], (N_MLA, D_MODEL, MLA_IN), f32) * D_MODEL ** -0.5
    mla_q_norm_g = 1.0 + 0.02 * nrm(ks[10], (N_MLA, MLA_Q_RANK), f32)
    mla_kv_norm_g = 1.0 + 0.02 * nrm(ks[11], (N_MLA, MLA_KV_RANK), f32)
    mla_w_uq = nrm(ks[12], (N_MLA, MLA_Q_RANK, MLA_HEADS * (MLA_NOPE + MLA_ROPE)), f32) * MLA_Q_RANK ** -0.5
    mla_w_ukv = nrm(ks[13], (N_MLA, MLA_KV_RANK, MLA_HEADS * (MLA_NOPE + MLA_DV)), f32) * MLA_KV_RANK ** -0.5
    mla_w_out = nrm(ks[14], (N_MLA, D_BRANCH, D_MODEL), f32) * (D_BRANCH ** -0.5) * BETA
    return {"x": x, "positions": positions, "ln_g": ln_g, "ln_b": ln_b,
            "gla_w_in": gla_w_in, "gla_w_gate": gla_w_gate, "gla_b_gate": gla_b_gate,
            "gla_gn_g": gla_gn_g, "gla_w_out": gla_w_out,
            "mla_w_in": mla_w_in, "mla_q_norm_g": mla_q_norm_g, "mla_kv_norm_g": mla_kv_norm_g,
            "mla_w_uq": mla_w_uq, "mla_w_ukv": mla_w_ukv, "mla_w_out": mla_w_out}


def reference(x, positions, ln_g, ln_b, gla_w_in, gla_w_gate, gla_b_gate, gla_gn_g, gla_w_out,
              mla_w_in, mla_q_norm_g, mla_kv_norm_g, mla_w_uq, mla_w_ukv, mla_w_out):
    cos, sin = rope_tables(positions)
    for i in range(DEPTH):
        j = i // N_MIXERS
        if i % N_MIXERS == 0:
            y = gla_mixer(x, gla_w_in[j], gla_w_gate[j], gla_b_gate[j], gla_gn_g[j], gla_w_out[j])
        else:
            y = mla_mixer(x, cos, sin, mla_w_in[j], mla_q_norm_g[j], mla_kv_norm_g[j],
                          mla_w_uq[j], mla_w_ukv[j], mla_w_out[j])
        x = layer_norm(ALPHA * x + y.astype(x.dtype), ln_g[i], ln_b[i])
    return x
```

```cpp
#include <hip/hip_runtime.h>
#include <hip/hip_cooperative_groups.h>
#include <cstdio>
#include <cstdint>
namespace cg = cooperative_groups;

#define LAS __attribute__((address_space(3)))
typedef unsigned short bf16_t;
typedef short bf16x8 __attribute__((ext_vector_type(8)));
typedef short s16x4 __attribute__((ext_vector_type(4)));
typedef float f32x4 __attribute__((ext_vector_type(4)));
typedef float f32x2 __attribute__((ext_vector_type(2)));
typedef float f32x16 __attribute__((ext_vector_type(16)));
typedef unsigned u32x4 __attribute__((ext_vector_type(4)));
typedef unsigned u32x2 __attribute__((ext_vector_type(2)));

constexpr int T = 65536, DM = 1024, SEQ = 2048, NBATCH = 32;
constexpr int TH = T / 2;
constexpr float ALPHA = 1.6817928305074290f;
constexpr float EPS = 1e-5f;
constexpr int GLA_NPAD = 5376, MLA_NPAD = 2816;
constexpr int LDS_BYTES = 143360;

constexpr size_t MiB = 1048576;
constexpr size_t W_GIN = 0, W_GIN_SZ = (size_t)GLA_NPAD * 1024 * 2;
constexpr size_t W_GOUT = W_GIN + 2 * W_GIN_SZ, W_OUT_SZ = (size_t)1024 * 2048 * 2;
constexpr size_t W_MIN = W_GOUT + 2 * W_OUT_SZ, W_MIN_SZ = (size_t)MLA_NPAD * 1024 * 2;
constexpr size_t W_MUQ = W_MIN + 2 * W_MIN_SZ, W_MUQ_SZ = (size_t)3072 * 384 * 2;
constexpr size_t W_MUKV = W_MUQ + 2 * W_MUQ_SZ, W_MUKV_SZ = (size_t)4096 * 256 * 2;
constexpr size_t W_MOUT = W_MUKV + 2 * W_MUKV_SZ;
static_assert(W_MOUT + 2 * W_OUT_SZ <= 64 * MiB, "weights region");
constexpr size_t WS_XB = 64 * MiB;
constexpr size_t WS_OFW = 64 * MiB, WS_GQK = 320 * MiB, WS_GV = 448 * MiB, WS_GZ = 704 * MiB, WS_GLR = 960 * MiB;
constexpr size_t WS_MZ = 192 * MiB, WS_QH = 448 * MiB, WS_KNH = 640 * MiB, WS_VH = 768 * MiB, WS_CQ = 896 * MiB, WS_CKV = 944 * MiB,
                 WS_KRR = 976 * MiB, WS_KRO = 992 * MiB, WS_RQ = 1000 * MiB, WS_RKV = 1000 * MiB + 262144;
constexpr size_t WS_COS = 1001 * MiB, WS_SIN = 1009 * MiB, WS_BAR = 1017 * MiB, WS_STATS = 1017 * MiB + 65536, WS_XCH = 1018 * MiB, WS_END = 1022 * MiB;
constexpr int LDS_ST_OFF = 143344;

struct Params {
    const float* x; const int* pos; const float* ln_g; const float* ln_b;
    const float* gla_w_in; const float* gla_w_gate; const float* gla_b_gate; const float* gla_gn_g; const float* gla_w_out;
    const float* mla_w_in; const float* mla_qn_g; const float* mla_kvn_g; const float* mla_w_uq; const float* mla_w_ukv; const float* mla_w_out;
    float* out; unsigned char* ws;
    int ph_lo, ph_hi;
};

__device__ __forceinline__ unsigned cvt_pk_bf16(float lo, float hi) { unsigned r; asm volatile("v_cvt_pk_bf16_f32 %0, %1, %2" : "=v"(r) : "v"(lo), "v"(hi)); return r; }
__device__ __forceinline__ float bf2f(unsigned short b) { return __uint_as_float(((unsigned)b) << 16); }
__device__ __forceinline__ float bflo(unsigned w) { return __uint_as_float(w << 16); }
__device__ __forceinline__ float bfhi(unsigned w) { return __uint_as_float(w & 0xffff0000u); }
__device__ __forceinline__ float silu_f(float z) { return z / (1.f + __expf(-z)); }
__device__ __forceinline__ float silu_fast(float z) { return z * __builtin_amdgcn_rcpf(1.f + __expf(-z)); }
__device__ __forceinline__ float wave_sum(float v) {
#pragma unroll
    for (int o = 32; o > 0; o >>= 1) v += __shfl_xor(v, o, 64);
    return v;
}

__device__ __forceinline__ int opaque_lane() { int l = __builtin_amdgcn_mbcnt_hi(~0u, __builtin_amdgcn_mbcnt_lo(~0u, 0u)); asm volatile("" : "+v"(l)); return l; }
__device__ __forceinline__ int opaque_tid(int wv) { return wv * 64 + opaque_lane(); }
namespace pg8 {
constexpr int BM = 256, BK = 64, HALF = 128, HTB = HALF * BK * 2, STAGE_BYTES = 8 * HTB, NXCD = 8, WGM = 8;
__host__ __device__ __forceinline__ int lds_byte(int r, int c) { const int st = (r >> 4) * 2 + (c >> 5), rr = r & 15, cc = c & 31, ob = rr * 64 + cc * 2; return st * 1024 + (ob ^ (((ob >> 9) & 1) << 5)); }
__host__ __device__ __forceinline__ void stage_rc(int b, int& R, int& C) { const int st = b / 1024, sb = b % 1024, swz = sb ^ (((sb >> 9) & 1) << 5); R = (st >> 1) * 16 + swz / 64; C = (st & 1) * 32 + (swz % 64) / 2; }
__host__ __device__ __forceinline__ int perm32(int rho) { const int n = rho >> 4, i = rho & 15; return 8 * (i >> 2) + 4 * n + (i & 3); }
struct Unit { int pm, pn; };
struct Gemm { const bf16_t* A; const bf16_t* Bt; int M, N, K; };
struct StaticOrder {
    int nM, nN, nwg, G, c;
    __device__ void init(int M, int N, int G_, int c_) { nM = M / BM; nN = N / BM; nwg = nM * nN; G = G_; c = c_; }
    __device__ bool next(int i, Unit& u) const {
        const long L = (long)i * G + c; if (L >= nwg) return false;
        int wgid = (int)L; { const int q = nwg / NXCD, r = nwg % NXCD, xcd = wgid % NXCD, off = wgid / NXCD; wgid = (xcd < r ? xcd * (q + 1) : r * (q + 1) + (xcd - r) * q) + off; }
        const int nig = WGM * nN, gid = wgid / nig, fm = gid * WGM, gsz = (nM - fm) < WGM ? (nM - fm) : WGM;
        u.pm = fm + ((wgid % nig) % gsz); u.pn = (wgid % nig) / gsz; return true;
    }
};

template <class Epi>
__device__ __forceinline__ void gemm_phase(LAS unsigned char* lds, const Gemm g, const StaticOrder& S, const Epi& E, int wv) {
    const int tid = opaque_tid(wv), wid = wv, lane = tid & 63, wr = wid >> 2, wc = wid & 3, fr = lane & 15, fq = lane >> 4;
    const int K = g.K, nt = K / BK;
    unsigned voffA[2], voffB[2];
#pragma unroll
    for (int i = 0; i < 2; ++i) { int R, C; stage_rc(tid * 16 + i * 8192, R, C); const int Rb = Epi::PERM ? ((R & ~31) + perm32(R & 31)) : R;
        voffA[i] = (unsigned)(R * K + C) * 2u; voffB[i] = (unsigned)(Rb * K + C) * 2u; }
    const size_t kstep = (size_t)(BK * 2);
    const size_t hstep = (size_t)HALF * K * 2;
    const size_t tstep = 2 * hstep;
    const unsigned ldsw = (unsigned)wid * 1024u;
    const int aoff = lds_byte(wr * 64 + fr, fq * 8), boff = lds_byte(wc * 32 + fr, fq * 8);
#define PG8_SA(b, h) (((b) * 2 + (h)) * HTB)
#define PG8_SB(b, h) ((4 + (b) * 2 + (h)) * HTB)
#define PG8_STAGE(bufoff, gbase, voff) do { _Pragma("unroll") for (int _i = 0; _i < 2; ++_i) \
        __builtin_amdgcn_global_load_lds((const unsigned*)((const char*)(gbase) + (voff)[_i]), (LAS unsigned*)(lds + (bufoff) + ldsw + _i * 8192), 16, 0, 0); } while (0)
#define PG8_LDA(dst, b, h) do { _Pragma("unroll") for (int m = 0; m < 4; ++m) _Pragma("unroll") for (int k = 0; k < 2; ++k) dst[m][k] = *(const LAS bf16x8*)(lds + PG8_SA(b, h) + aoff + m * 2048 + k * 1024); } while (0)
#define PG8_LDB(dst, b, h) do { _Pragma("unroll") for (int n = 0; n < 2; ++n) _Pragma("unroll") for (int k = 0; k < 2; ++k) dst[n][k] = *(const LAS bf16x8*)(lds + PG8_SB(b, h) + boff + n * 2048 + k * 1024); } while (0)
#define PG8_MMA(ai, bj, At, Bt) do { __builtin_amdgcn_s_setprio(1); _Pragma("unroll") for (int m = 0; m < 4; ++m) _Pragma("unroll") for (int n = 0; n < 2; ++n) _Pragma("unroll") for (int k = 0; k < 2; ++k) \
        acc[ai][bj][m][n] = __builtin_amdgcn_mfma_f32_16x16x32_bf16(Bt[n][k], At[m][k], acc[ai][bj][m][n], 0, 0, 0); __builtin_amdgcn_s_setprio(0); } while (0)
#define PG8_WAIT_V(n) asm volatile("s_waitcnt vmcnt(" #n ")" ::: "memory")
#define PG8_WAIT_L(n) asm volatile("s_waitcnt lgkmcnt(" #n ")" ::: "memory")
#define PG8_BAR __builtin_amdgcn_s_barrier()
#define PG8_SCHED __builtin_amdgcn_sched_barrier(0)
    Unit cur, nxt; int ui = 0;
    if (!S.next(0, cur)) return;
    f32x4 acc[2][2][4][2];
#pragma unroll
    for (int a = 0; a < 2; ++a)
#pragma unroll
        for (int b = 0; b < 2; ++b)
#pragma unroll
            for (int m = 0; m < 4; ++m)
#pragma unroll
                for (int n = 0; n < 2; ++n) acc[a][b][m][n] = (f32x4){0.f, 0.f, 0.f, 0.f};
    bf16x8 At[4][2], B0[2][2], B1[2][2];
    const char* cA = (const char*)g.A + (size_t)cur.pm * tstep; const char* cB = (const char*)g.Bt + (size_t)cur.pn * tstep;
    PG8_STAGE(PG8_SB(0, 0), cB, voffB); PG8_STAGE(PG8_SA(0, 0), cA, voffA); PG8_STAGE(PG8_SB(0, 1), cB + hstep, voffB); PG8_STAGE(PG8_SA(0, 1), cA + hstep, voffA);
    if (wr == 1) PG8_BAR;
    PG8_WAIT_V(4); PG8_BAR;
    PG8_STAGE(PG8_SB(1, 0), cB + kstep, voffB); PG8_STAGE(PG8_SA(1, 0), cA + kstep, voffA); PG8_STAGE(PG8_SB(1, 1), cB + hstep + kstep, voffB);
    PG8_WAIT_V(6); PG8_BAR;
    for (;;) {
        const bool has_next = S.next(ui + 1, nxt);
        const char* nA = has_next ? (const char*)g.A + (size_t)nxt.pm * tstep : cA; const char* nB = has_next ? (const char*)g.Bt + (size_t)nxt.pn * tstep : cB;
        for (int t = 0; t < nt; t += 2) {
            const bool last = (t == nt - 2);
            const char* a1 = cA + (size_t)(t + 1) * kstep;
            const char* a2 = last ? nA : cA + (size_t)(t + 2) * kstep; const char* b2 = last ? nB : cB + (size_t)(t + 2) * kstep;
            const char* a3 = a2 + kstep; const char* b3 = b2 + kstep;
            PG8_LDB(B0, 0, 0); PG8_SCHED; PG8_LDA(At, 0, 0); PG8_STAGE(PG8_SA(1, 1), a1 + hstep, voffA);
            PG8_WAIT_L(8); PG8_BAR; PG8_WAIT_L(0); PG8_MMA(0, 0, At, B0); PG8_BAR; PG8_SCHED;
            PG8_LDB(B1, 0, 1); PG8_STAGE(PG8_SB(0, 0), b2, voffB);
            PG8_BAR; PG8_WAIT_L(0); PG8_MMA(0, 1, At, B1); PG8_BAR;
            PG8_LDA(At, 0, 1); PG8_STAGE(PG8_SA(0, 0), a2, voffA);
            PG8_BAR; PG8_WAIT_L(0); PG8_MMA(1, 0, At, B0); PG8_BAR; PG8_SCHED;
            PG8_STAGE(PG8_SB(0, 1), b2 + hstep, voffB);
            PG8_WAIT_V(6); PG8_BAR; PG8_MMA(1, 1, At, B1); PG8_BAR;
            PG8_LDB(B0, 1, 0); PG8_SCHED; PG8_LDA(At, 1, 0); PG8_STAGE(PG8_SA(0, 1), a2 + hstep, voffA);
            PG8_WAIT_L(8); PG8_BAR; PG8_WAIT_L(0); PG8_MMA(0, 0, At, B0); PG8_BAR; PG8_SCHED;
            PG8_LDB(B1, 1, 1); PG8_STAGE(PG8_SB(1, 0), b3, voffB);
            PG8_BAR; PG8_WAIT_L(0); PG8_MMA(0, 1, At, B1); PG8_BAR;
            PG8_LDA(At, 1, 1); PG8_STAGE(PG8_SA(1, 0), a3, voffA);
            PG8_BAR; PG8_WAIT_L(0); PG8_MMA(1, 0, At, B0); PG8_BAR; PG8_SCHED;
            PG8_STAGE(PG8_SB(1, 1), b3 + hstep, voffB);
            PG8_WAIT_V(6); PG8_BAR; PG8_MMA(1, 1, At, B1); PG8_BAR;
        }
        E(acc, cur, wv);
        if (!has_next) break;
#pragma unroll
        for (int a = 0; a < 2; ++a)
#pragma unroll
            for (int b = 0; b < 2; ++b)
#pragma unroll
                for (int m = 0; m < 4; ++m)
#pragma unroll
                    for (int n = 0; n < 2; ++n) acc[a][b][m][n] = (f32x4){0.f, 0.f, 0.f, 0.f};
        cur = nxt; cA = nA; cB = nB; ++ui;
    }
    PG8_WAIT_V(0);
    if (wr == 0) PG8_BAR;
    PG8_BAR;
#undef PG8_SA
#undef PG8_SB
#undef PG8_STAGE
#undef PG8_LDA
#undef PG8_LDB
#undef PG8_MMA
#undef PG8_WAIT_V
#undef PG8_WAIT_L
#undef PG8_BAR
#undef PG8_SCHED
}

typedef f32x4 Acc[2][2][4][2];
__device__ __forceinline__ void store8_bf16(bf16_t* p, f32x4 v0, f32x4 v1, float s) {
    u32x4 w = {cvt_pk_bf16(v0[0] * s, v0[1] * s), cvt_pk_bf16(v0[2] * s, v0[3] * s), cvt_pk_bf16(v1[0] * s, v1[1] * s), cvt_pk_bf16(v1[2] * s, v1[3] * s)};
    *(u32x4*)p = w;
}
__device__ __forceinline__ void tile_store_bf16(const Acc& acc, bf16_t* base, int ld, int pm, int wr, int wc, int fr, int fq, float s) {
    const int row0 = pm * BM + wr * 64 + fr, col0 = wc * 32 + 8 * fq;
#pragma unroll
    for (int ai = 0; ai < 2; ++ai)
#pragma unroll
        for (int m = 0; m < 4; ++m) { bf16_t* rowp = base + (size_t)(row0 + ai * HALF + m * 16) * ld + col0;
#pragma unroll
            for (int bj = 0; bj < 2; ++bj) store8_bf16(rowp + bj * HALF, acc[ai][bj][m][0], acc[ai][bj][m][1], s); }
}
struct EpiGlaIn {
    static constexpr bool PERM = true;
    bf16_t* QK; bf16_t* V; bf16_t* Z; float* GLR;
    __device__ __forceinline__ void operator()(const Acc& acc, const Unit& u, int wv) const {
        const int wr = wv >> 2, wc = wv & 3, ln_ = opaque_lane(), fr = ln_ & 15, fq = ln_ >> 4;
        const int pn = u.pn;
        if (pn < 4) tile_store_bf16(acc, QK + pn * 256, 1024, u.pm, wr, wc, fr, fq, pn < 2 ? 0.08838834764831845f : 1.f);
        else if (pn < 12) tile_store_bf16(acc, V + (pn - 4) * 256, 2048, u.pm, wr, wc, fr, fq, 1.f);
        else if (pn < 20) tile_store_bf16(acc, Z + (pn - 12) * 256, 2048, u.pm, wr, wc, fr, fq, 1.f);
        else if (wc == 0) {
            const int row0 = u.pm * BM + wr * 64 + fr;
#pragma unroll
            for (int ai = 0; ai < 2; ++ai)
#pragma unroll
                for (int m = 0; m < 4; ++m) { float* rowp = GLR + (size_t)(row0 + ai * HALF + m * 16) * 32 + 8 * fq;
                    *(f32x4*)rowp = acc[ai][0][m][0]; *(f32x4*)(rowp + 4) = acc[ai][0][m][1]; }
        }
    }
};
__device__ __forceinline__ float sumsq8(f32x4 a, f32x4 b) { return a[0] * a[0] + a[1] * a[1] + a[2] * a[2] + a[3] * a[3] + b[0] * b[0] + b[1] * b[1] + b[2] * b[2] + b[3] * b[3]; }
struct EpiMlaIn {
    static constexpr bool PERM = true;
    bf16_t* Z; bf16_t* CKV; bf16_t* CQ; bf16_t* KRO; float* SSQ_Q; float* SSQ_KV; const float* COS; const float* SIN;
    __device__ __forceinline__ void operator()(const Acc& acc, const Unit& u, int wv) const {
        const int wr = wv >> 2, wc = wv & 3, ln_ = opaque_lane(), fr = ln_ & 15, fq = ln_ >> 4;
        const int pn = u.pn;
        if (pn < 8) { tile_store_bf16(acc, Z + pn * 256, 2048, u.pm, wr, wc, fr, fq, 1.f); return; }
        const int row0 = u.pm * BM + wr * 64 + fr, col0 = wc * 32 + 8 * fq;
#pragma unroll
        for (int ai = 0; ai < 2; ++ai)
#pragma unroll
            for (int m = 0; m < 4; ++m) { const size_t row = (size_t)(row0 + ai * HALF + m * 16);
                float ss;
                if (pn == 8) { bf16_t* rp = CKV + row * 256 + col0; store8_bf16(rp, acc[ai][0][m][0], acc[ai][0][m][1], 1.f); store8_bf16(rp + HALF, acc[ai][1][m][0], acc[ai][1][m][1], 1.f);
                    ss = sumsq8(acc[ai][0][m][0], acc[ai][0][m][1]) + sumsq8(acc[ai][1][m][0], acc[ai][1][m][1]); }
                else if (pn == 9) { bf16_t* rp = CQ + row * 384 + col0; store8_bf16(rp, acc[ai][0][m][0], acc[ai][0][m][1], 1.f); store8_bf16(rp + HALF, acc[ai][1][m][0], acc[ai][1][m][1], 1.f);
                    ss = sumsq8(acc[ai][0][m][0], acc[ai][0][m][1]) + sumsq8(acc[ai][1][m][0], acc[ai][1][m][1]); }
                else { store8_bf16(CQ + row * 384 + 256 + col0, acc[ai][0][m][0], acc[ai][0][m][1], 1.f);
                    ss = sumsq8(acc[ai][0][m][0], acc[ai][0][m][1]);
                    if (wc < 2) { const int i0 = col0 >> 1; const f32x4 cs = *(const f32x4*)(COS + row * 32 + i0), sn = *(const f32x4*)(SIN + row * 32 + i0);
                        const f32x4 v0 = acc[ai][1][m][0], v1 = acc[ai][1][m][1]; f32x4 w0, w1;
                        w0[0] = v0[0] * cs[0] - v0[1] * sn[0]; w0[1] = v0[1] * cs[0] + v0[0] * sn[0];
                        w0[2] = v0[2] * cs[1] - v0[3] * sn[1]; w0[3] = v0[3] * cs[1] + v0[2] * sn[1];
                        w1[0] = v1[0] * cs[2] - v1[1] * sn[2]; w1[1] = v1[1] * cs[2] + v1[0] * sn[2];
                        w1[2] = v1[2] * cs[3] - v1[3] * sn[3]; w1[3] = v1[3] * cs[3] + v1[2] * sn[3];
                        store8_bf16(KRO + row * 64 + col0, w0, w1, 1.f); } }
                { auto r16 = __builtin_amdgcn_permlane16_swap(__float_as_uint(ss), __float_as_uint(ss), false, false); ss = __uint_as_float(r16[0]) + __uint_as_float(r16[1]);
                  auto r32s = __builtin_amdgcn_permlane32_swap(__float_as_uint(ss), __float_as_uint(ss), false, false); ss = __uint_as_float(r32s[0]) + __uint_as_float(r32s[1]); }
                if (fq == 0) atomicAdd((pn == 8 ? SSQ_KV : SSQ_Q) + row, ss);
                __builtin_amdgcn_sched_barrier(0); }
    }
};
struct EpiQup {
    static constexpr bool PERM = true;
    bf16_t* Q; const float* RQ; const float* COS; const float* SIN; int tok0;
    __device__ __forceinline__ void operator()(Acc& acc, const Unit& u, int wv) const {
        const int wr = wv >> 2, wc = wv & 3, ln_ = opaque_lane(), fr = ln_ & 15, fq = ln_ >> 4;
        const int row0 = u.pm * BM + wr * 64 + fr;
        float sc[8];
#pragma unroll
        for (int i = 0; i < 8; ++i) sc[i] = RQ[(size_t)tok0 + row0 + (i >> 2) * HALF + (i & 3) * 16];
#pragma unroll
        for (int i = 0; i < 8; ++i) sc[i] = rsqrtf(sc[i] * (1.f / 384.f) + EPS);
#pragma unroll
        for (int bj = 0; bj < 2; ++bj) {
            const int c = u.pn * 256 + bj * 128 + wc * 32 + 8 * fq, o = c % 192; const bool rope = o >= 128; const int i0 = (o - 128) >> 1;
            if (!rope) {
#pragma unroll
                for (int i = 0; i < 8; ++i) { const int row = row0 + (i >> 2) * HALF + (i & 3) * 16; store8_bf16(Q + (size_t)row * 3072 + c, acc[i >> 2][bj][i & 3][0], acc[i >> 2][bj][i & 3][1], sc[i]); }
            } else {
#pragma unroll
                for (int ai = 0; ai < 2; ++ai) {
                    f32x4 cs[4], sn[4];
#pragma unroll
                    for (int m = 0; m < 4; ++m) { const size_t tok = (size_t)tok0 + row0 + ai * HALF + m * 16; cs[m] = *(const f32x4*)(COS + tok * 32 + i0); sn[m] = *(const f32x4*)(SIN + tok * 32 + i0); }
#pragma unroll
                    for (int m = 0; m < 4; ++m) { const int row = row0 + ai * HALF + m * 16; const float s = sc[ai * 4 + m];
                        const f32x4 v0 = acc[ai][bj][m][0] * s, v1 = acc[ai][bj][m][1] * s; f32x4 w0, w1;
                        w0[0] = v0[0] * cs[m][0] - v0[1] * sn[m][0]; w0[1] = v0[1] * cs[m][0] + v0[0] * sn[m][0];
                        w0[2] = v0[2] * cs[m][1] - v0[3] * sn[m][1]; w0[3] = v0[3] * cs[m][1] + v0[2] * sn[m][1];
                        w1[0] = v1[0] * cs[m][2] - v1[1] * sn[m][2]; w1[1] = v1[1] * cs[m][2] + v1[0] * sn[m][2];
                        w1[2] = v1[2] * cs[m][3] - v1[3] * sn[m][3]; w1[3] = v1[3] * cs[m][3] + v1[2] * sn[m][3];
                        store8_bf16(Q + (size_t)row * 3072 + c, w0, w1, 1.f); }
                    __builtin_amdgcn_sched_barrier(0);
                }
            }
        }
    }
};
struct EpiKVup {
    static constexpr bool PERM = true;
    bf16_t* KN; bf16_t* V; const float* RKV; int tok0;
    __device__ __forceinline__ void operator()(Acc& acc, const Unit& u, int wv) const {
        const int wr = wv >> 2, wc = wv & 3, ln_ = opaque_lane(), fr = ln_ & 15, fq = ln_ >> 4;
        bf16_t* base = u.pn < 8 ? KN + u.pn * 256 : V + (u.pn - 8) * 256;
        const int row0 = u.pm * BM + wr * 64 + fr, col0 = wc * 32 + 8 * fq;
        float sc[8];
#pragma unroll
        for (int i = 0; i < 8; ++i) sc[i] = RKV[(size_t)tok0 + row0 + (i >> 2) * HALF + (i & 3) * 16];
#pragma unroll
        for (int i = 0; i < 8; ++i) sc[i] = rsqrtf(sc[i] * (1.f / 256.f) + EPS);
#pragma unroll
        for (int i = 0; i < 8; ++i) { const int row = row0 + (i >> 2) * HALF + (i & 3) * 16; bf16_t* rowp = base + (size_t)row * 2048 + col0;
#pragma unroll
            for (int bj = 0; bj < 2; ++bj) store8_bf16(rowp + bj * HALF, acc[i >> 2][bj][i & 3][0], acc[i >> 2][bj][i & 3][1], sc[i]); }
    }
};
struct EpiRes {
    static constexpr bool PERM = false;
    float* XRES; const float* XIN; const f32x2* ST; const float* G; const float* B; bool nowrite;
    __device__ __forceinline__ void operator()(const Acc& acc, const Unit& u, int wv) const {
        const int wr = wv >> 2, wc = wv & 3, ln_ = opaque_lane(), fr = ln_ & 15, fq = ln_ >> 4;
        const int row0 = u.pm * BM + wr * 64 + fr, col0 = u.pn * BM + wc * 32 + 4 * fq;
#pragma unroll
        for (int pr = 0; pr < 4; ++pr) {
            f32x4 xi[2][4]; f32x2 st[2];
#pragma unroll
            for (int q = 0; q < 2; ++q) { const int i = pr * 2 + q, row = row0 + (i >> 2) * HALF + (i & 3) * 16; const size_t ro = (size_t)row * 1024 + col0;
                st[q] = (f32x2){0.f, 1.f}; if (ST) st[q] = ST[row];
#pragma unroll
                for (int c4 = 0; c4 < 4; ++c4) xi[q][c4] = *(const f32x4*)(XIN + ro + (c4 >> 1) * HALF + (c4 & 1) * 16); }
#pragma unroll
            for (int q = 0; q < 2; ++q) { const int i = pr * 2 + q, row = row0 + (i >> 2) * HALF + (i & 3) * 16; const size_t ro = (size_t)row * 1024 + col0;
#pragma unroll
                for (int c4 = 0; c4 < 4; ++c4) { const int co = (c4 >> 1) * HALF + (c4 & 1) * 16; f32x4 x = xi[q][c4];
                    if (ST) { const f32x4 g = *(const f32x4*)(G + col0 + co), b = *(const f32x4*)(B + col0 + co); x = (x - st[q][0]) * st[q][1] * g + b; }
                    if (!nowrite) *(f32x4*)(XRES + ro + co) = acc[i >> 2][c4 >> 1][i & 3][c4 & 1] + x * ALPHA; } }
            __builtin_amdgcn_sched_barrier(0);
        }
    }
};
}

enum { MAP_ID = 0, MAP_MLAIN = 1, MAP_UQ = 2, MAP_UKV = 3 };
__device__ __forceinline__ int map_col(int mode, int nd, int nsrc) {
    if (mode == MAP_ID) return nd < nsrc ? nd : -1;
    if (mode == MAP_MLAIN) { if (nd < 2048) return 704 + nd; if (nd < 2304) return 384 + (nd - 2048); if (nd < 2688) return nd - 2304; if (nd < 2752) { const int p_ = nd - 2688; return 640 + (p_ >> 1) + ((p_ & 1) ? 32 : 0); } return -1; }
    if (mode == MAP_UQ) { const int h = nd / 192, o = nd % 192; if (o < 128) return h * 192 + o; const int p = o - 128, i = p >> 1; return (p & 1) ? h * 192 + 160 + i : h * 192 + 128 + i; }
    { if (nd < 2048) return (nd >> 7) * 256 + (nd & 127); const int n2 = nd - 2048; return (n2 >> 7) * 256 + 128 + (n2 & 127); }
}
__device__ __forceinline__ void transpose_job(const float* src, bf16_t* dst, int K, int nsrc, int ndst, int mode, const float* rs, float* tile  , int wv) {
    const int tid = opaque_tid(wv), tk = K / 64, tn = ndst / 64, ntiles = tk * tn;
    for (int t = blockIdx.x; t < ntiles; t += gridDim.x) {
        const int k0 = (t % tk) * 64, n0 = (t / tk) * 64;
        const int nn = tid & 63, sc = map_col(mode, n0 + nn, nsrc);
        __syncthreads();
#pragma unroll
        for (int i = 0; i < 8; ++i) { const int kk = (tid >> 6) + 8 * i; float v = 0.f; if (sc >= 0) { v = src[(size_t)(k0 + kk) * nsrc + sc]; if (rs) v *= rs[k0 + kk]; } tile[kk * 65 + nn] = v; }
        __syncthreads();
        const int on = tid >> 3, ok = (tid & 7) * 8;
        float v[8];
#pragma unroll
        for (int i = 0; i < 8; ++i) v[i] = tile[(ok + i) * 65 + on];
        u32x4 w = {cvt_pk_bf16(v[0], v[1]), cvt_pk_bf16(v[2], v[3]), cvt_pk_bf16(v[4], v[5]), cvt_pk_bf16(v[6], v[7])};
        *(u32x4*)(dst + (size_t)(n0 + on) * K + k0 + ok) = w;
    }
}
__device__ __forceinline__ void phase_prep(const __attribute__((address_space(4))) Params* pp, unsigned char* lds, int wv) {
    float* tile = (float*)lds;
    struct { const float* x; const int* pos; const float* gla_w_in; const float* gla_w_out; const float* mla_w_in; const float* mla_qn_g; const float* mla_kvn_g; const float* mla_w_uq; const float* mla_w_ukv; const float* mla_w_out; unsigned char* ws; } p;
    p.x = pp->x; p.pos = pp->pos; p.gla_w_in = pp->gla_w_in; p.gla_w_out = pp->gla_w_out; p.mla_w_in = pp->mla_w_in; p.mla_qn_g = pp->mla_qn_g; p.mla_kvn_g = pp->mla_kvn_g; p.mla_w_uq = pp->mla_w_uq; p.mla_w_ukv = pp->mla_w_ukv; p.mla_w_out = pp->mla_w_out; p.ws = pp->ws;
    unsigned char* ws = p.ws;
    const size_t gtid = (size_t)blockIdx.x * 512 + opaque_tid(wv), gsz = (size_t)gridDim.x * 512;
    for (size_t i = gtid; i < (size_t)T * DM / 8; i += gsz) {
        const f32x4 a = *(const f32x4*)(p.x + i * 8), b = *(const f32x4*)(p.x + i * 8 + 4);
        u32x4 w = {cvt_pk_bf16(a[0], a[1]), cvt_pk_bf16(a[2], a[3]), cvt_pk_bf16(b[0], b[1]), cvt_pk_bf16(b[2], b[3])};
        *(u32x4*)(ws + WS_XB + i * 16) = w;
    }
    for (size_t i = gtid; i < (size_t)(MiB / 16); i += gsz) *(u32x4*)(ws + WS_RQ + i * 16) = (u32x4){0u, 0u, 0u, 0u};
    for (size_t i = gtid; i < (size_t)T * 32; i += gsz) {
        const int tok = (int)(i >> 5), f = (int)(i & 31);
        const float inv = 1.0f / powf(10000.0f, (float)(2 * f) / 64.0f);
        const float ang = (float)p.pos[tok] * inv;
        ((float*)(ws + WS_COS))[i] = cosf(ang); ((float*)(ws + WS_SIN))[i] = sinf(ang);
    }
    for (int j = 0; j < 2; ++j) {
        transpose_job(p.gla_w_in + (size_t)j * 1024 * 5152, (bf16_t*)(ws + W_GIN + j * W_GIN_SZ), 1024, 5152, GLA_NPAD, MAP_ID, nullptr, tile, wv);
        transpose_job(p.gla_w_out + (size_t)j * 2048 * 1024, (bf16_t*)(ws + W_GOUT + j * W_OUT_SZ), 2048, 1024, 1024, MAP_ID, nullptr, tile, wv);
        transpose_job(p.mla_w_in + (size_t)j * 1024 * 2752, (bf16_t*)(ws + W_MIN + j * W_MIN_SZ), 1024, 2752, MLA_NPAD, MAP_MLAIN, nullptr, tile, wv);
        transpose_job(p.mla_w_uq + (size_t)j * 384 * 3072, (bf16_t*)(ws + W_MUQ + j * W_MUQ_SZ), 384, 3072, 3072, MAP_UQ, p.mla_qn_g + j * 384, tile, wv);
        transpose_job(p.mla_w_ukv + (size_t)j * 256 * 4096, (bf16_t*)(ws + W_MUKV + j * W_MUKV_SZ), 256, 4096, 4096, MAP_UKV, p.mla_kvn_g + j * 256, tile, wv);
        transpose_job(p.mla_w_out + (size_t)j * 2048 * 1024, (bf16_t*)(ws + W_MOUT + j * W_OUT_SZ), 2048, 1024, 1024, MAP_ID, nullptr, tile, wv);
    }
    __syncthreads();
}

__device__ __forceinline__ void phase_ln(float* xres, bf16_t* xb, f32x2* stats, const float* g, const float* b, int wv, bool nowrite, bool final_) {
    const int tid = opaque_tid(wv); const int lane = tid & 63, gw = blockIdx.x * 8 + (tid >> 6), nw = gridDim.x * 8;
    f32x4 gv[4], bv[4];
#pragma unroll
    for (int i = 0; i < 4; ++i) { gv[i] = *(const f32x4*)(g + i * 256 + lane * 4); bv[i] = *(const f32x4*)(b + i * 256 + lane * 4); }
    for (int row0 = gw; row0 < T; row0 += 4 * nw) {
        f32x4 v[4][4];
#pragma unroll
        for (int u = 0; u < 4; ++u) { const float* rp = xres + (size_t)(row0 + u * nw) * 1024;
#pragma unroll
            for (int i = 0; i < 4; ++i) v[u][i] = *(const f32x4*)(rp + i * 256 + lane * 4); }
#pragma unroll
        for (int u = 0; u < 4; ++u) {
            const int row = row0 + u * nw; float* rp = xres + (size_t)row * 1024;
            float s = 0.f;
#pragma unroll
            for (int i = 0; i < 4; ++i) s += v[u][i][0] + v[u][i][1] + v[u][i][2] + v[u][i][3];
            const float mu = wave_sum(s) * (1.f / 1024.f);
            float q = 0.f;
#pragma unroll
            for (int i = 0; i < 4; ++i) { v[u][i] = v[u][i] - mu; q += v[u][i][0] * v[u][i][0] + v[u][i][1] * v[u][i][1] + v[u][i][2] * v[u][i][2] + v[u][i][3] * v[u][i][3]; }
            const float rstd = rsqrtf(wave_sum(q) * (1.f / 1024.f) + EPS);
            if (!final_ && lane == 0 && !nowrite) stats[row] = (f32x2){mu, rstd};
#pragma unroll
            for (int i = 0; i < 4; ++i) { const f32x4 y = v[u][i] * rstd * gv[i] + bv[i]; if (!nowrite) { if (final_) *(f32x4*)(rp + i * 256 + lane * 4) = y;
                else { u32x2 w = {cvt_pk_bf16(y[0], y[1]), cvt_pk_bf16(y[2], y[3])}; *(u32x2*)(xb + (size_t)row * 1024 + i * 256 + lane * 4) = w; } } }
        }
    }
}

__device__ __forceinline__ void phase_gla_gate(const bf16_t* O, bf16_t* Z, const float* gn, int wv, bool nowrite) {
    const int tid = opaque_tid(wv); const int lane = tid & 63, h = wv & 3;
    const f32x4 g0 = *(const f32x4*)(gn + h * 512 + lane * 8), g1 = *(const f32x4*)(gn + h * 512 + lane * 8 + 4);
    const int rw = blockIdx.x * 2 + (wv >> 2), nrw = gridDim.x * 2;
    for (int row0 = rw; row0 < T; row0 += 4 * nrw) {
        u32x4 ov[4], zv[4];
#pragma unroll
        for (int u = 0; u < 4; ++u) { const size_t off = (size_t)(row0 + u * nrw) * 2048 + h * 512 + lane * 8; ov[u] = *(const u32x4*)(O + off); zv[u] = *(const u32x4*)(Z + off); }
#pragma unroll
        for (int u = 0; u < 4; ++u) {
            const size_t off = (size_t)(row0 + u * nrw) * 2048 + h * 512 + lane * 8;
            float o[8], z[8];
#pragma unroll
            for (int i = 0; i < 4; ++i) { o[2 * i] = bflo(ov[u][i]); o[2 * i + 1] = bfhi(ov[u][i]); z[2 * i] = bflo(zv[u][i]); z[2 * i + 1] = bfhi(zv[u][i]); }
            float ss = 0.f;
#pragma unroll
            for (int i = 0; i < 8; ++i) ss += o[i] * o[i];
            const float r = rsqrtf(wave_sum(ss) * (1.f / 512.f) + EPS);
            float y[8];
#pragma unroll
            for (int i = 0; i < 8; ++i) y[i] = o[i] * r * (i < 4 ? g0[i] : g1[i - 4]) * silu_f(z[i]);
            u32x4 w = {cvt_pk_bf16(y[0], y[1]), cvt_pk_bf16(y[2], y[3]), cvt_pk_bf16(y[4], y[5]), cvt_pk_bf16(y[6], y[7])};
            if (!nowrite) *(u32x4*)(Z + off) = w;
        }
    }
}

__device__ __forceinline__ void phase_mla_stats(const bf16_t* CQ, const bf16_t* CKV, const float* KRR, bf16_t* KRO, float* RQ, float* RKV, const float* COS, const float* SIN, int wv) {
    const int tid = opaque_tid(wv); const int lane = tid & 63, gw = blockIdx.x * 8 + (tid >> 6), nw = gridDim.x * 8;
    for (int row = gw; row < T; row += nw) {
        float sq = 0.f, sk = 0.f;
        if (lane < 48) { const u32x4 v = *(const u32x4*)(CQ + (size_t)row * 384 + lane * 8);
#pragma unroll
            for (int i = 0; i < 4; ++i) { const float a = bflo(v[i]), b = bfhi(v[i]); sq += a * a + b * b; } }
        if (lane < 32) { const u32x4 v = *(const u32x4*)(CKV + (size_t)row * 256 + lane * 8);
#pragma unroll
            for (int i = 0; i < 4; ++i) { const float a = bflo(v[i]), b = bfhi(v[i]); sk += a * a + b * b; } }
        sq = wave_sum(sq); sk = wave_sum(sk);
        if (lane == 0) { RQ[row] = rsqrtf(sq * (1.f / 384.f) + EPS); RKV[row] = rsqrtf(sk * (1.f / 256.f) + EPS); }
        if (lane < 32) { const float x1 = KRR[(size_t)row * 64 + lane], x2 = KRR[(size_t)row * 64 + 32 + lane];
            const float c = COS[(size_t)row * 32 + lane], s = SIN[(size_t)row * 32 + lane];
            *(unsigned*)(KRO + (size_t)row * 64 + 2 * lane) = cvt_pk_bf16(x1 * c - x2 * s, x2 * c + x1 * s); }
    }
}

namespace att {
constexpr int NW = 8, QBLK = 32, KVBLK = 64;
constexpr int LDQ = 3072, LDK = 2048, LDR = 64, LDZ = 2048;
constexpr float SCALE = 0.07216878364870322f;
constexpr float THR = 8.f;
constexpr int SHM_V = 16384, SHM_K = 16384, SHM_R = 8192;
constexpr int OFF_V = 0, OFF_K = 2 * SHM_V, OFF_R = OFF_K + 2 * SHM_K, OFF_WS = OFF_R + 2 * SHM_R, OFF_QR = OFF_WS + 2048;
#define KSWZ(row, colB) ((row) * 256 + ((colB) ^ (((row) & 7) << 4)))
#define RSWZ(row, colB) ((row) * 128 + ((colB) ^ ((((row) >> 1) & 7) << 4)))
#define SBAR() __builtin_amdgcn_sched_barrier(0)
__device__ __forceinline__ int crow(int r, int hi) { return (r & 3) + 8 * (r >> 2) + 4 * hi; }
__device__ __forceinline__ void partialSM(f32x16& p0, f32x16& p1, float& m_reg, float& mn, float& alpha) {
    constexpr float C = SCALE * 1.4426950408889634f;
    float pmax = p0[0];
#pragma unroll
    for (int r = 1; r < 16; ++r) pmax = fmaxf(pmax, p0[r]);
#pragma unroll
    for (int r = 0; r < 16; ++r) pmax = fmaxf(pmax, p1[r]);
    { auto rr = __builtin_amdgcn_permlane32_swap(__float_as_uint(pmax), __float_as_uint(pmax), false, false);
      pmax = fmaxf(__uint_as_float(rr[0]), __uint_as_float(rr[1])); }
    if (__builtin_expect(__all(pmax - m_reg <= THR / SCALE), 1)) { mn = m_reg; alpha = 1.f; }
    else { mn = fmaxf(m_reg, pmax); alpha = __builtin_amdgcn_exp2f((m_reg - mn) * C); m_reg = mn; }
    const float mnC = -mn * C;
#pragma unroll
    for (int r = 0; r < 16; ++r) p0[r] = fmaf(p0[r], C, mnC);
#pragma unroll
    for (int r = 0; r < 16; ++r) p1[r] = fmaf(p1[r], C, mnC);
#pragma unroll
    for (int r = 0; r < 16; ++r) p0[r] = __builtin_amdgcn_exp2f(p0[r]);
}
__device__ __forceinline__ void finishSM(f32x16& p0, f32x16& p1, float alpha, float& l_reg, bf16x8& pa0, bf16x8& pa1, bf16x8& pa2, bf16x8& pa3) {
#pragma unroll
    for (int r = 0; r < 16; ++r) p1[r] = __builtin_amdgcn_exp2f(p1[r]);
    float ps = 0;
#pragma unroll
    for (int r = 0; r < 16; ++r) ps += p0[r];
#pragma unroll
    for (int r = 0; r < 16; ++r) ps += p1[r];
    { auto rr = __builtin_amdgcn_permlane32_swap(__float_as_uint(ps), __float_as_uint(ps), false, false);
      ps = __uint_as_float(rr[0]) + __uint_as_float(rr[1]); }
    l_reg = l_reg * alpha + ps;
#define PK4(P, BASE, OUT) do { unsigned a0 = cvt_pk_bf16(P[BASE + 0], P[BASE + 1]), a1 = cvt_pk_bf16(P[BASE + 2], P[BASE + 3]);   \
    unsigned b0 = cvt_pk_bf16(P[BASE + 4], P[BASE + 5]), b1 = cvt_pk_bf16(P[BASE + 6], P[BASE + 7]);                              \
    auto r0 = __builtin_amdgcn_permlane32_swap(a0, b0, false, false); auto r1 = __builtin_amdgcn_permlane32_swap(a1, b1, false, false); \
    u32x4 w = {r0[0], r1[0], r0[1], r1[1]}; OUT = *reinterpret_cast<bf16x8*>(&w); } while (0)
    PK4(p0, 0, pa0); PK4(p0, 8, pa1); PK4(p1, 0, pa2); PK4(p1, 8, pa3);
#undef PK4
}
__device__ __forceinline__ void qkt(f32x16& p0, f32x16& p1, const char* Ks, const char* Rs, const bf16x8* qr, const char* Qp, int r32, int hi) {
    p0 = f32x16{}; p1 = f32x16{};
#pragma unroll
    for (int d0 = 0; d0 < 8; ++d0) { const int cb = (d0 * 16 + hi * 8) * 2;
        const bf16x8 b0 = *reinterpret_cast<const bf16x8*>(Ks + KSWZ(r32, cb));
        const bf16x8 b1 = *reinterpret_cast<const bf16x8*>(Ks + KSWZ(32 + r32, cb));
        p0 = __builtin_amdgcn_mfma_f32_32x32x16_bf16(b0, qr[d0], p0, 0, 0, 0);
        p1 = __builtin_amdgcn_mfma_f32_32x32x16_bf16(b1, qr[d0], p1, 0, 0, 0); }
#pragma unroll
    for (int d0 = 0; d0 < 4; ++d0) { const int cb = (d0 * 16 + hi * 8) * 2;
        const bf16x8 b0 = *reinterpret_cast<const bf16x8*>(Rs + RSWZ(r32, cb));
        const bf16x8 b1 = *reinterpret_cast<const bf16x8*>(Rs + RSWZ(32 + r32, cb));
        const bf16x8 qq = *reinterpret_cast<const bf16x8*>(Qp + RSWZ(r32, cb));
        p0 = __builtin_amdgcn_mfma_f32_32x32x16_bf16(b0, qq, p0, 0, 0, 0);
        p1 = __builtin_amdgcn_mfma_f32_32x32x16_bf16(b1, qq, p1, 0, 0, 0); }
}
__device__ __forceinline__ int v_st(int k, int c) { const int kk = (k & ~0xC) | ((k & 4) << 1) | ((k & 8) >> 1); return ((kk >> 3) * 4 + (c >> 5)) * 512 + ((kk & 7) * 32 + (c & 31)) * 2; }
__device__ __forceinline__ int v_rd_base(int lane) { return ((lane & 3) << 3) | (((lane >> 2) & 3) << 6) | (((lane >> 4) & 1) << 5) | (((lane >> 5) & 1) << 8); }
constexpr int v_rd_off(int d0, int ks, int half) { return d0 * 512 + ks * 4096 + half * 2048; }
template <int OFF> __device__ __forceinline__ s16x4 tr_read(int vb) {
    s16x4 r; asm volatile("ds_read_b64_tr_b16 %0, %1 offset:%2" : "=&v"(r) : "v"(vb), "i"(OFF) : "memory"); return r;
}
template <int D0> __device__ __forceinline__ void pv_one(f32x16& od, int vb, bf16x8 pa0, bf16x8 pa1, bf16x8 pa2, bf16x8 pa3) {
    const s16x4 l0 = tr_read<v_rd_off(D0, 0, 0)>(vb), h0 = tr_read<v_rd_off(D0, 0, 1)>(vb), l1 = tr_read<v_rd_off(D0, 1, 0)>(vb), h1 = tr_read<v_rd_off(D0, 1, 1)>(vb);
    const s16x4 l2 = tr_read<v_rd_off(D0, 2, 0)>(vb), h2 = tr_read<v_rd_off(D0, 2, 1)>(vb), l3 = tr_read<v_rd_off(D0, 3, 0)>(vb), h3 = tr_read<v_rd_off(D0, 3, 1)>(vb);
    asm volatile("s_waitcnt lgkmcnt(0)" ::: "memory"); SBAR();
#define PK(L, H) (bf16x8){L[0], L[1], L[2], L[3], H[0], H[1], H[2], H[3]}
    od = __builtin_amdgcn_mfma_f32_32x32x16_bf16(pa0, PK(l0, h0), od, 0, 0, 0);
    od = __builtin_amdgcn_mfma_f32_32x32x16_bf16(pa1, PK(l1, h1), od, 0, 0, 0);
    od = __builtin_amdgcn_mfma_f32_32x32x16_bf16(pa2, PK(l2, h2), od, 0, 0, 0);
    od = __builtin_amdgcn_mfma_f32_32x32x16_bf16(pa3, PK(l3, h3), od, 0, 0, 0);
#undef PK
}
__device__ __forceinline__ void pv_d0(f32x16* o, int vb, bf16x8 pa0, bf16x8 pa1, bf16x8 pa2, bf16x8 pa3) {
    pv_one<0>(o[0], vb, pa0, pa1, pa2, pa3); pv_one<1>(o[1], vb, pa0, pa1, pa2, pa3); pv_one<2>(o[2], vb, pa0, pa1, pa2, pa3); pv_one<3>(o[3], vb, pa0, pa1, pa2, pa3);
}
__device__ __forceinline__ void attn_body(const bf16_t* __restrict__ Qb, const bf16_t* __restrict__ Kh, const bf16_t* __restrict__ Vh, const bf16_t* __restrict__ Rh,
                                          bf16_t* __restrict__ Zb, int seq, char* lds, int wv, bool nowrite) {
    const int tid = opaque_tid(wv), wid = wv, lane = tid & 63, r32 = lane & 31, hi = lane >> 5;
    char* V_lds = lds + OFF_V; char* K_lds = lds + OFF_K; char* R_lds = lds + OFF_R;
    float* ws = (float*)(lds + OFF_WS) + wid * 64; float* li_l = ws; float* al_l = ws + 32;
    float m_reg = -1e30f, l_reg = 0; f32x16 o[4] = {}; bf16x8 qr[8];
    const bf16_t* Qw = Qb + (long)(wid * QBLK + r32) * LDQ + hi * 8;
    char* Qp = lds + OFF_QR + wid * 4096;
#pragma unroll
    for (int d0 = 0; d0 < 8; ++d0) qr[d0] = *reinterpret_cast<const bf16x8*>(Qw + d0 * 16);
#pragma unroll
    for (int d0 = 0; d0 < 4; ++d0) *reinterpret_cast<bf16x8*>(Qp + RSWZ(r32, (d0 * 16 + hi * 8) * 2)) = *reinterpret_cast<const bf16x8*>(Qw + 128 + d0 * 16);
    const int sr = tid >> 4, sc = (tid & 15) * 8, vst0 = v_st(sr, sc), vst1 = v_st(32 + sr, sc);
    const int rr = tid >> 3, rc = (tid & 7) * 8;
    const int vb0 = (int)(uintptr_t)(LAS char*)V_lds + v_rd_base(lane);
    bf16x8 vs0, vs1, ks0, ks1, rs0;
#define SLOAD(k0) do { vs0 = *reinterpret_cast<const bf16x8*>(&Vh[(long)((k0) + sr) * LDK + sc]); vs1 = *reinterpret_cast<const bf16x8*>(&Vh[(long)((k0) + 32 + sr) * LDK + sc]); \
    ks0 = *reinterpret_cast<const bf16x8*>(&Kh[(long)((k0) + sr) * LDK + sc]); ks1 = *reinterpret_cast<const bf16x8*>(&Kh[(long)((k0) + 32 + sr) * LDK + sc]); \
    rs0 = *reinterpret_cast<const bf16x8*>(&Rh[(long)((k0) + rr) * LDR + rc]); } while (0)
#define SWRITE(b) do { *(bf16x8*)(V_lds + (b) * SHM_V + vst0) = vs0; *(bf16x8*)(V_lds + (b) * SHM_V + vst1) = vs1; const int kc = sc * 2; \
    *(bf16x8*)(K_lds + (b) * SHM_K + KSWZ(sr, kc)) = ks0; *(bf16x8*)(K_lds + (b) * SHM_K + KSWZ(32 + sr, kc)) = ks1; \
    *(bf16x8*)(R_lds + (b) * SHM_R + RSWZ(rr, rc * 2)) = rs0; } while (0)
#define SWAIT() asm volatile("s_waitcnt vmcnt(0)" ::: "memory")
#define RESC(a) do { if (__any((a) < 1.f)) { if (hi == 0) al_l[r32] = (a); asm volatile("s_waitcnt lgkmcnt(0)" ::: "memory"); \
    _Pragma("unroll") for (int d = 0; d < 4; ++d) _Pragma("unroll") for (int r = 0; r < 16; ++r) o[d][r] *= al_l[crow(r, hi)]; } } while (0)
    f32x16 pA0, pA1, pB0, pB1; float mnA, mnB, alA, alB; bf16x8 pa0, pa1, pa2, pa3; const int NT = seq / KVBLK;
    SLOAD(0); SWAIT(); SWRITE(0); __syncthreads();
    qkt(pA0, pA1, K_lds, R_lds, qr, Qp, r32, hi); partialSM(pA0, pA1, m_reg, mnA, alA);
    SLOAD(KVBLK);
    SWAIT(); SWRITE(1); __syncthreads();
    for (int j = 1; j + 1 < NT; j += 2) {
        SBAR(); qkt(pB0, pB1, K_lds + SHM_K, R_lds + SHM_R, qr, Qp, r32, hi);
        finishSM(pA0, pA1, alA, l_reg, pa0, pa1, pa2, pa3); SBAR();
        SLOAD((j + 1) * KVBLK); SBAR();
        pv_d0(o, vb0, pa0, pa1, pa2, pa3); partialSM(pB0, pB1, m_reg, mnB, alB);
        __syncthreads(); SWAIT(); SWRITE(0);
        RESC(alB); __syncthreads();
        SBAR(); qkt(pA0, pA1, K_lds, R_lds, qr, Qp, r32, hi);
        finishSM(pB0, pB1, alB, l_reg, pa0, pa1, pa2, pa3); SBAR();
        SLOAD((j + 2) * KVBLK); SBAR();
        pv_d0(o, vb0 + SHM_V, pa0, pa1, pa2, pa3); partialSM(pA0, pA1, m_reg, mnA, alA);
        __syncthreads(); SWAIT(); SWRITE(1);
        RESC(alA); __syncthreads();
    }
    SBAR(); qkt(pB0, pB1, K_lds + SHM_K, R_lds + SHM_R, qr, Qp, r32, hi);
    finishSM(pA0, pA1, alA, l_reg, pa0, pa1, pa2, pa3); SBAR();
    pv_d0(o, vb0, pa0, pa1, pa2, pa3); partialSM(pB0, pB1, m_reg, mnB, alB);
    __syncthreads(); RESC(alB);
    finishSM(pB0, pB1, alB, l_reg, pa0, pa1, pa2, pa3); SBAR();
    pv_d0(o, vb0 + SHM_V, pa0, pa1, pa2, pa3);
    if (hi == 0) li_l[r32] = l_reg; asm volatile("s_waitcnt lgkmcnt(0)" ::: "memory");
    float rli[16];
#pragma unroll
    for (int r = 0; r < 16; ++r) rli[r] = __builtin_amdgcn_rcpf(li_l[crow(r, hi)]);
    bf16_t* Zw = Zb + (long)(wid * QBLK + 4 * hi) * LDZ + r32;
    unsigned short zq[16][4];
#pragma unroll
    for (int r = 0; r < 16; ++r)
#pragma unroll
        for (int d0 = 0; d0 < 4; ++d0) zq[r][d0] = Zw[(long)((r & 3) + 8 * (r >> 2)) * LDZ + d0 * 32];
    asm volatile("s_waitcnt vmcnt(0)" ::: "memory"); SBAR();
#pragma unroll
    for (int r = 0; r < 16; ++r) {
#pragma unroll
        for (int d0 = 0; d0 < 4; ++d0) { const float z = bf2f(zq[r][d0]);
            if (!nowrite) Zw[(long)((r & 3) + 8 * (r >> 2)) * LDZ + d0 * 32] = (bf16_t)(cvt_pk_bf16(o[d0][r] * rli[r] * silu_f(z), 0.f) & 0xffffu); } }
    __syncthreads();
#undef SLOAD
#undef SWRITE
#undef SWAIT
#undef RESC
}
__device__ __forceinline__ void phase_attn(const bf16_t* QH, const bf16_t* KNH, const bf16_t* VH, const bf16_t* KRO, bf16_t* Z, int half, char* lds, int wv, bool nowrite) {
    const int c = blockIdx.x, G = gridDim.x;
    const int per = 2048 / G;
    for (int i = 0; i < per; ++i) {
        int bh, qb;
        if (G == 256) { const int xcd = c & 7, slot = c >> 3; bh = i * 32 + xcd * 4 + (slot >> 3); qb = slot & 7; }
        else { const int u = i * G + c; bh = u >> 3; qb = u & 7; }
        const int bl = bh >> 4, h = bh & 15;
        const size_t lrow = (size_t)bl * SEQ, grow = (size_t)half * TH + lrow;
        attn_body(QH + (lrow + qb * 256) * LDQ + h * 192, KNH + lrow * LDK + h * 128, VH + lrow * LDK + h * 128, KRO + grow * 64,
                  Z + (grow + qb * 256) * LDZ + h * 128, SEQ, lds, wv, nowrite);
    }
}
}

#ifndef SC_MASK
#define SC_MASK 0xFFFF
#endif
#define SCB(i) do { if (SC_MASK & (1 << (i))) __builtin_amdgcn_sched_barrier(0); } while (0)
namespace scan {
constexpr int QE_ST = 272, KE_ST = 320, P_ST = 144, V_ST = 576, BC_ST = 528;
constexpr int OFF_QE = 0, OFF_KE = OFF_QE + 64 * QE_ST, OFF_P = OFF_KE + 64 * KE_ST, OFF_V = OFF_P + 64 * P_ST, OFF_BC = OFF_V + 64 * V_ST,
              OFF_GLR = OFF_BC + 64 * BC_ST, OFF_PART = OFF_GLR + 4096, OFF_EBT = OFF_PART + 2048, OFF_WG = OFF_EBT + 512, OFF_SSQW = OFF_WG + 8192, OFF_RN = OFF_SSQW + 2048, OFF_G = OFF_RN + 256, OFF_END = OFF_G + 1024;
static_assert(OFF_END <= LDS_BYTES, "scan LDS");
template <int OFF> __device__ __forceinline__ s16x4 tr_read(int vb) {
    s16x4 r; asm volatile("ds_read_b64_tr_b16 %0, %1 offset:%2" : "=&v"(r) : "v"(vb), "i"(OFF) : "memory"); return r;
}
#define PK8(L, H) (bf16x8){L[0], L[1], L[2], L[3], H[0], H[1], H[2], H[3]}
#define LAUNDER(t) const int t = opaque_tid(wv)
__device__ __forceinline__ void phase_scan(const bf16_t* QK, const bf16_t* V, const float* GLR, bf16_t* OFW, const float* wgate, const float* bgate, char* lds, int wv,
                                           bf16_t* Z, const float* gn, unsigned long long* X, unsigned tag) {
    const int wid = wv;
    for (int item = blockIdx.x; item < 256; item += gridDim.x) {
        const int b = item >> 3, h = (item >> 1) & 3, vh = item & 1;
        __syncthreads();
        { LAUNDER(t); if (t < 256) *(float*)(lds + OFF_G + t * 4) = gn[h * 512 + vh * 256 + t]; }
        for (int dir = 0; dir < 2; ++dir) {
            __syncthreads();
            float bgv; float wgb[8];
            { LAUNDER(t); const int ln = t & 63, r32_ = ln & 31, hi_ = ln >> 5, db_ = wid & 3;
#pragma unroll
              for (int kk = 0; kk < 8; ++kk) wgb[kk] = wgate[((size_t)dir * 16 + 2 * kk + hi_) * 512 + h * 128 + db_ * 32 + r32_];
              bgv = bgate[(size_t)dir * 512 + h * 128 + db_ * 32 + r32_]; }
            f32x16 S[4];
#pragma unroll
            for (int i = 0; i < 4; ++i) S[i] = f32x16{};
            bf16x8 rq[2], rk[2], rv[4]; f32x2 rg;
#define CLOAD_QK(n) do { LAUNDER(t_); const unsigned qo_ = (unsigned)((t_ >> 4) * 1024 + (t_ & 15) * 8) * 2u; const size_t t0_ = (size_t)b * SEQ + (size_t)(n) * 64; const char* qb_ = (const char*)QK + (t0_ * 1024 + h * 128) * 2; \
    rq[0] = *(const bf16x8*)(qb_ + qo_); rq[1] = *(const bf16x8*)(qb_ + 65536 + qo_); rk[0] = *(const bf16x8*)(qb_ + 1024 + qo_); rk[1] = *(const bf16x8*)(qb_ + 1024 + 65536 + qo_); } while (0)
#define CLOAD_VG(n) do { LAUNDER(t_); const unsigned vo_ = (unsigned)((t_ >> 5) * 2048 + (t_ & 31) * 8) * 2u, go_ = (unsigned)((t_ >> 3) * 32 + (t_ & 7) * 2) * 4u; const size_t t0_ = (size_t)b * SEQ + (size_t)(n) * 64; \
    const char* vb_ = (const char*)V + (t0_ * 2048 + h * 512 + vh * 256) * 2; const char* gb_ = (const char*)GLR + (t0_ * 32 + dir * 16) * 4; \
    _Pragma("unroll") for (int i = 0; i < 4; ++i) rv[i] = *(const bf16x8*)(vb_ + (size_t)i * 65536 + vo_); \
    rg = *(const f32x2*)(gb_ + go_); } while (0)
            CLOAD_QK(dir == 0 ? 0 : 31); CLOAD_VG(dir == 0 ? 0 : 31);
#define LBAR() do { asm volatile("s_waitcnt lgkmcnt(0)" ::: "memory"); __builtin_amdgcn_s_barrier(); asm volatile("" ::: "memory"); } while (0)
#define STAGE_VG() do { LAUNDER(t_); const int vr = t_ >> 5, vc = (t_ & 31) * 8, gr = t_ >> 3, gc = (t_ & 7) * 2; \
    _Pragma("unroll") for (int i = 0; i < 4; ++i) *(bf16x8*)(lds + OFF_V + (vr + 16 * i) * V_ST + vc * 2) = rv[i]; \
    *(f32x2*)(lds + OFF_GLR + gr * 64 + gc * 4) = rg; } while (0)
#define XSLOT(nc, half_) (X + ((((size_t)(b * 4 + h) * 32 + (nc)) * 2 + (half_)) * 64))
#define GN_PUBLISH(nc) do { if (wid == 0) { LAUNDER(t_); const int ln_ = t_ & 63; float own_ = 0.f; \
    _Pragma("unroll") for (int w_ = 0; w_ < 8; ++w_) own_ += *(const float*)(lds + OFF_SSQW + (w_ * 64 + ln_) * 4); hown = own_; \
    const unsigned long long g_ = ((unsigned long long)tag << 32) | (unsigned long long)__float_as_uint(own_); \
    __hip_atomic_store(XSLOT(nc, vh) + ln_, g_, __ATOMIC_RELAXED, __HIP_MEMORY_SCOPE_AGENT); } } while (0)
#define GN_POLL(nc) do { if (wid == 0) { LAUNDER(t_); const int ln_ = t_ & 63; unsigned long long g_ = 0ull; unsigned sp_ = 0u; \
    for (;;) { g_ = __hip_atomic_load(XSLOT(nc, vh ^ 1) + ln_, __ATOMIC_RELAXED, __HIP_MEMORY_SCOPE_AGENT); if ((unsigned)(g_ >> 32) == tag || ++sp_ > (1u << 22)) break; __builtin_amdgcn_s_sleep(1); } \
    const float tot_ = hown + __uint_as_float((unsigned)g_); *(float*)(lds + OFF_RN + ln_ * 4) = rsqrtf(tot_ * (1.f / 512.f) + EPS); } } while (0)
#define GN_FINAL(nc) do { LAUNDER(t_); const int ln_ = t_ & 63; const float r_ = *(const float*)(lds + OFF_RN + ln_ * 4); \
    bf16_t* zr_ = Z + ((size_t)b * SEQ + (size_t)(nc) * 64 + ln_) * 2048 + h * 512 + vh * 256 + wid * 32; \
    _Pragma("unroll") for (int j_ = 0; j_ < 4; ++j_) { const f32x4 g0_ = *(const f32x4*)(lds + OFF_G + (wid * 32 + j_ * 8) * 4), g1_ = *(const f32x4*)(lds + OFF_G + (wid * 32 + j_ * 8 + 4) * 4); \
        const f32x4 a_ = hs[2 * j_], c_ = hs[2 * j_ + 1]; const u32x4 z_ = hz[j_]; \
        u32x4 w_ = {cvt_pk_bf16(a_[0] * r_ * g0_[0] * silu_fast(bflo(z_[0])), a_[1] * r_ * g0_[1] * silu_fast(bfhi(z_[0]))), cvt_pk_bf16(a_[2] * r_ * g0_[2] * silu_fast(bflo(z_[1])), a_[3] * r_ * g0_[3] * silu_fast(bfhi(z_[1]))), \
                    cvt_pk_bf16(c_[0] * r_ * g1_[0] * silu_fast(bflo(z_[2])), c_[1] * r_ * g1_[1] * silu_fast(bfhi(z_[2]))), cvt_pk_bf16(c_[2] * r_ * g1_[2] * silu_fast(bflo(z_[3])), c_[3] * r_ * g1_[3] * silu_fast(bfhi(z_[3])))}; \
        *(u32x4*)(zr_ + j_ * 8) = w_; __builtin_amdgcn_sched_barrier(0); } } while (0)
            STAGE_VG();
            CLOAD_VG(dir == 0 ? 1 : 30);
            LBAR();
            for (int step = 0; step < 32; ++step) {
                const int n = dir == 0 ? step : 31 - step;
                const size_t t0 = (size_t)b * SEQ + (size_t)n * 64;
                {
                    LAUNDER(t); const int ln = t & 63, r32 = ln & 31, hi = ln >> 5, cb = wid >> 2, db = wid & 3, d = db * 32 + r32;
                    f32x4 ar[4];
#pragma unroll
                    for (int i = 0; i < 4; ++i) ar[i] = *(const f32x4*)(lds + OFF_GLR + (cb * 32 + r32) * 64 + i * 16);
                    asm volatile("s_waitcnt lgkmcnt(0)" ::: "memory"); __builtin_amdgcn_sched_barrier(0);
                    f32x16 pa;
#pragma unroll
                    for (int r = 0; r < 16; ++r) pa[r] = bgv;
#pragma unroll
                    for (int kk = 0; kk < 8; ++kk) { const float a = hi ? ar[kk >> 1][2 * (kk & 1) + 1] : ar[kk >> 1][2 * (kk & 1)];
                        pa = __builtin_amdgcn_mfma_f32_32x32x2f32(a, wgb[kk], pa, 0, 0, 0); }
                    float lgv[16], pl[16];
#pragma unroll
                    for (int r = 0; r < 16; ++r) { const float pre = pa[r]; lgv[r] = -(fmaxf(-pre, 0.f) + __logf(1.f + __expf(-fabsf(pre)))) * (0.0625f * 1.4426950408889634f); }
#pragma unroll
                    for (int k = 0; k < 4; ++k) { pl[4 * k] = lgv[4 * k]; pl[4 * k + 1] = pl[4 * k] + lgv[4 * k + 1]; pl[4 * k + 2] = pl[4 * k + 1] + lgv[4 * k + 2]; pl[4 * k + 3] = pl[4 * k + 2] + lgv[4 * k + 3]; }
#pragma unroll
                    for (int k = 0; k < 4; ++k) *(float*)(lds + OFF_P + ((cb * 8 + 2 * k + hi) * 128 + d) * 4) = pl[4 * k + 3];
                    LBAR();
                    float gsv[16];
#pragma unroll
                    for (int g = 0; g < 16; ++g) gsv[g] = *(const float*)(lds + OFF_P + (g * 128 + d) * 4);
                    asm volatile("s_waitcnt lgkmcnt(0)" ::: "memory"); __builtin_amdgcn_sched_barrier(0);
                    float ex[16]; float run = 0.f;
#pragma unroll
                    for (int g = 0; g < 16; ++g) { ex[g] = run; run += gsv[g]; }
                    const float tot = run;
#pragma unroll
                    for (int k = 0; k < 4; ++k) { const float e0 = cb ? ex[8 + 2 * k] : ex[2 * k], e1 = cb ? ex[8 + 2 * k + 1] : ex[2 * k + 1]; const float off = hi ? e1 : e0;
#pragma unroll
                        for (int e = 0; e < 4; ++e) { const int r = 4 * k + e; const float bc = dir == 0 ? off + pl[r] : tot - (off + pl[r] - lgv[r]);
                            *(float*)(lds + OFF_BC + (cb * 32 + e + 8 * k + 4 * hi) * BC_ST + d * 4) = bc; } }
                    if (cb == 0 && hi == 0) *(float*)(lds + OFF_EBT + d * 4) = __builtin_amdgcn_exp2f(tot);
                }
                LBAR();
                { LAUNDER(t); const int sr = t >> 4, sc = (t & 15) * 8;
#pragma unroll
                  for (int i = 0; i < 2; ++i) { const int row = sr + 32 * i;
                    const f32x4 b0 = *(const f32x4*)(lds + OFF_BC + row * BC_ST + sc * 4), b1 = *(const f32x4*)(lds + OFF_BC + row * BC_ST + sc * 4 + 16);
                    const bf16x8 qv = rq[i], kv = rk[i];
                    float qf[8], kf[8];
#pragma unroll
                    for (int e = 0; e < 8; ++e) { const float bb = e < 4 ? b0[e] : b1[e - 4]; const float eb = __builtin_amdgcn_exp2f(bb), ei = __builtin_amdgcn_exp2f(-bb);
                        qf[e] = bf2f((unsigned short)qv[e]) * eb; kf[e] = bf2f((unsigned short)kv[e]) * ei; }
                    u32x4 qw = {cvt_pk_bf16(qf[0], qf[1]), cvt_pk_bf16(qf[2], qf[3]), cvt_pk_bf16(qf[4], qf[5]), cvt_pk_bf16(qf[6], qf[7])};
                    u32x4 kw = {cvt_pk_bf16(kf[0], kf[1]), cvt_pk_bf16(kf[2], kf[3]), cvt_pk_bf16(kf[4], kf[5]), cvt_pk_bf16(kf[6], kf[7])};
                    *(u32x4*)(lds + OFF_QE + row * QE_ST + sc * 2) = qw; *(u32x4*)(lds + OFF_KE + row * KE_ST + sc * 2) = kw; } }
                if (step + 1 < 32) { const int nn = dir == 0 ? step + 1 : 30 - step; CLOAD_QK(nn); }
                u32x4 pf[4];
                bf16_t* orow;
                { LAUNDER(t); const int ln = t & 63; orow = OFW + ((((size_t)item * 32 + n) * 8 + wid) * 256 + ln) * 8; }
                if (dir == 1) {
#pragma unroll
                    for (int j = 0; j < 4; ++j) pf[j] = *(const u32x4*)(orow + j * 512);
                }
                LBAR();
                { LAUNDER(t); const int fr = t & 15, fq = (t >> 4) & 3;
#pragma unroll
                  for (int tt = 0; tt < 2; ++tt) { const int tl = wid * 2 + tt, it = tl >> 2, jt = tl & 3;
                    f32x4 pc = {0.f, 0.f, 0.f, 0.f};
                    bf16x8 af[4], bfg[4];
#pragma unroll
                    for (int ks = 0; ks < 4; ++ks) {
                        af[ks] = *(const bf16x8*)(lds + OFF_KE + (jt * 16 + fr) * KE_ST + (ks * 32 + fq * 8) * 2);
                        bfg[ks] = *(const bf16x8*)(lds + OFF_QE + (it * 16 + fr) * QE_ST + (ks * 32 + fq * 8) * 2); }
                    asm volatile("s_waitcnt lgkmcnt(0)" ::: "memory"); SCB(1);
#pragma unroll
                    for (int ks = 0; ks < 4; ++ks) pc = __builtin_amdgcn_mfma_f32_16x16x32_bf16(af[ks], bfg[ks], pc, 0, 0, 0);
                    const int ii = it * 16 + fr, j0 = jt * 16 + fq * 4;
                    float pm[4];
#pragma unroll
                    for (int e = 0; e < 4; ++e) pm[e] = (dir == 0 ? (j0 + e <= ii) : (j0 + e >= ii)) ? pc[e] : 0.f;
                    u32x2 pw = {cvt_pk_bf16(pm[0], pm[1]), cvt_pk_bf16(pm[2], pm[3])};
                    *(u32x2*)(lds + OFF_P + ii * P_ST + j0 * 2) = pw; } }
                bf16x8 vf[4];
                f32x16 o0 = f32x16{}, o1 = f32x16{};
                {
                    LAUNDER(t); const int ln = t & 63, hi = ln >> 5, r32 = ln & 31, m16 = ln & 15, g16 = (ln >> 4) & 1;
                    const int ldsb = (int)(uintptr_t)(LAS char*)lds;
                    const int trv = ldsb + OFF_V + (8 * hi + (m16 >> 2)) * V_ST + (wid * 32 + 16 * g16 + 4 * (m16 & 3)) * 2;
                    const int trk = ldsb + OFF_KE + (8 * hi + (m16 >> 2)) * KE_ST + (16 * g16 + 4 * (m16 & 3)) * 2;
                    {
                    const s16x4 l0 = tr_read<0 * 16 * V_ST>(trv), h0 = tr_read<0 * 16 * V_ST + 4 * V_ST>(trv), l1 = tr_read<1 * 16 * V_ST>(trv), h1 = tr_read<1 * 16 * V_ST + 4 * V_ST>(trv);
                    const s16x4 l2 = tr_read<2 * 16 * V_ST>(trv), h2 = tr_read<2 * 16 * V_ST + 4 * V_ST>(trv), l3 = tr_read<3 * 16 * V_ST>(trv), h3 = tr_read<3 * 16 * V_ST + 4 * V_ST>(trv);
                    asm volatile("s_waitcnt lgkmcnt(0)" ::: "memory"); SCB(2);
                    vf[0] = PK8(l0, h0); vf[1] = PK8(l1, h1); vf[2] = PK8(l2, h2); vf[3] = PK8(l3, h3);
                    }
                    const char* qa = lds + OFF_QE + r32 * QE_ST + 8 * hi;
#pragma unroll
                    for (int db = 0; db < 4; ++db) {
                        s16x4 al[2][2], ah[2][2];
#pragma unroll
                        for (int s = 0; s < 2; ++s) { const int dcol = (db * 32 + 16 * s) * 2;
                            al[s][0] = *(const s16x4*)(qa + dcol); ah[s][0] = *(const s16x4*)(qa + dcol + 16);
                            al[s][1] = *(const s16x4*)(qa + 32 * QE_ST + dcol); ah[s][1] = *(const s16x4*)(qa + 32 * QE_ST + dcol + 16); }
                        bf16x8 bfr[2];
#pragma unroll
                        for (int s = 0; s < 2; ++s) {
                            u32x4 bw = {cvt_pk_bf16(S[db][8 * s + 0], S[db][8 * s + 1]), cvt_pk_bf16(S[db][8 * s + 2], S[db][8 * s + 3]),
                                        cvt_pk_bf16(S[db][8 * s + 4], S[db][8 * s + 5]), cvt_pk_bf16(S[db][8 * s + 6], S[db][8 * s + 7])};
                            bfr[s] = *reinterpret_cast<bf16x8*>(&bw); }
                        asm volatile("s_waitcnt lgkmcnt(0)" ::: "memory"); SCB(3);
#pragma unroll
                        for (int s = 0; s < 2; ++s) {
                            o0 = __builtin_amdgcn_mfma_f32_32x32x16_bf16(PK8(al[s][0], ah[s][0]), bfr[s], o0, 0, 0, 0);
                            o1 = __builtin_amdgcn_mfma_f32_32x32x16_bf16(PK8(al[s][1], ah[s][1]), bfr[s], o1, 0, 0, 0); }
                    }
                    const char* ebp = lds + OFF_EBT + 16 * hi;
#define SUPD(DB) do { \
    const s16x4 l0 = tr_read<(DB) * 64 + 0 * 16 * KE_ST>(trk), h0 = tr_read<(DB) * 64 + 0 * 16 * KE_ST + 4 * KE_ST>(trk), l1 = tr_read<(DB) * 64 + 1 * 16 * KE_ST>(trk), h1 = tr_read<(DB) * 64 + 1 * 16 * KE_ST + 4 * KE_ST>(trk); \
    const s16x4 l2 = tr_read<(DB) * 64 + 2 * 16 * KE_ST>(trk), h2 = tr_read<(DB) * 64 + 2 * 16 * KE_ST + 4 * KE_ST>(trk), l3 = tr_read<(DB) * 64 + 3 * 16 * KE_ST>(trk), h3 = tr_read<(DB) * 64 + 3 * 16 * KE_ST + 4 * KE_ST>(trk); \
    asm volatile("s_waitcnt lgkmcnt(0)" ::: "memory"); SCB(4); \
    S[DB] = __builtin_amdgcn_mfma_f32_32x32x16_bf16(PK8(l0, h0), vf[0], S[DB], 0, 0, 0); \
    S[DB] = __builtin_amdgcn_mfma_f32_32x32x16_bf16(PK8(l1, h1), vf[1], S[DB], 0, 0, 0); \
    S[DB] = __builtin_amdgcn_mfma_f32_32x32x16_bf16(PK8(l2, h2), vf[2], S[DB], 0, 0, 0); \
    S[DB] = __builtin_amdgcn_mfma_f32_32x32x16_bf16(PK8(l3, h3), vf[3], S[DB], 0, 0, 0); \
    _Pragma("unroll") for (int g = 0; g < 4; ++g) { const f32x4 eb = *(const f32x4*)(ebp + ((DB) * 32 + 8 * g) * 4); \
        S[DB][4 * g + 0] *= eb[0]; S[DB][4 * g + 1] *= eb[1]; S[DB][4 * g + 2] *= eb[2]; S[DB][4 * g + 3] *= eb[3]; } asm volatile("" : "+v"(S[DB])); } while (0)
                    SUPD(0); SUPD(1); SUPD(2); SUPD(3);
#undef SUPD
                }
                LBAR();
                if (step + 1 < 32) { STAGE_VG(); if (step + 2 < 32) { const int nn = dir == 0 ? step + 2 : 29 - step; CLOAD_VG(nn); } }

                {
                    LAUNDER(t); const int ln = t & 63, hi = ln >> 5, r32 = ln & 31;
                    const char* pa = lds + OFF_P + r32 * P_ST + 16 * hi;
                    bf16x8 pa0[4], pa1[4];
#pragma unroll
                    for (int ks = 0; ks < 4; ++ks) { pa0[ks] = *(const bf16x8*)(pa + ks * 32); pa1[ks] = *(const bf16x8*)(pa + 32 * P_ST + ks * 32); }
                    asm volatile("s_waitcnt lgkmcnt(0)" ::: "memory"); SCB(5);
#pragma unroll
                    for (int ks = 0; ks < 4; ++ks) {
                        o0 = __builtin_amdgcn_mfma_f32_32x32x16_bf16(pa0[ks], vf[ks], o0, 0, 0, 0);
                        o1 = __builtin_amdgcn_mfma_f32_32x32x16_bf16(pa1[ks], vf[ks], o1, 0, 0, 0);
                    }
                    if (dir == 0) {
#pragma unroll
                        for (int j = 0; j < 4; ++j) {
                            u32x4 w;
                            if (j < 2) w = (u32x4){cvt_pk_bf16(o0[8 * j + 0], o0[8 * j + 1]), cvt_pk_bf16(o0[8 * j + 2], o0[8 * j + 3]), cvt_pk_bf16(o0[8 * j + 4], o0[8 * j + 5]), cvt_pk_bf16(o0[8 * j + 6], o0[8 * j + 7])};
                            else { const int k = j - 2; w = (u32x4){cvt_pk_bf16(o1[8 * k + 0], o1[8 * k + 1]), cvt_pk_bf16(o1[8 * k + 2], o1[8 * k + 3]), cvt_pk_bf16(o1[8 * k + 4], o1[8 * k + 5]), cvt_pk_bf16(o1[8 * k + 6], o1[8 * k + 7])}; }
                            *(u32x4*)(orow + j * 512) = w;
                        }
                    } else {
#pragma unroll
                        for (int j = 0; j < 2; ++j)
#pragma unroll
                            for (int e = 0; e < 4; ++e) { o0[8 * j + 2 * e] += bflo(pf[j][e]); o0[8 * j + 2 * e + 1] += bfhi(pf[j][e]); o1[8 * j + 2 * e] += bflo(pf[2 + j][e]); o1[8 * j + 2 * e + 1] += bfhi(pf[2 + j][e]); }
                        char* ost = lds + (wid < 4 ? OFF_QE + wid * 8192 : OFF_BC + (wid - 4) * 8192);
#pragma unroll
                        for (int r = 0; r < 16; ++r) { const int ic = (r & 3) + 8 * (r >> 2) + 4 * hi;
                            const int sw = ((((r32 >> 2) ^ (ic & 7)) << 4) | ((r32 & 3) << 2));
                            *(float*)(ost + ic * 128 + sw) = o0[r]; *(float*)(ost + (32 + ic) * 128 + sw) = o1[r]; }
                        asm volatile("s_waitcnt lgkmcnt(0)" ::: "memory"); __builtin_amdgcn_sched_barrier(0);
                        f32x4 oa[4], oc[4];
#pragma unroll
                        for (int j = 0; j < 4; ++j) { oa[j] = *(const f32x4*)(ost + ln * 128 + (((2 * j) ^ (ln & 7)) << 4)); oc[j] = *(const f32x4*)(ost + ln * 128 + (((2 * j + 1) ^ (ln & 7)) << 4)); }
                        asm volatile("s_waitcnt lgkmcnt(0)" ::: "memory"); SCB(6);
                        f32x4 hs[8]; u32x4 hz[4]; float hown = 0.f;
                        float ss = 0.f;
#pragma unroll
                        for (int j = 0; j < 4; ++j) {
                            const f32x4 a = oa[j], c = oc[j];
                            ss += a[0] * a[0] + a[1] * a[1] + a[2] * a[2] + a[3] * a[3] + c[0] * c[0] + c[1] * c[1] + c[2] * c[2] + c[3] * c[3];
                            hs[2 * j] = a; hs[2 * j + 1] = c;
                        }
                        *(float*)(lds + OFF_SSQW + (wid * 64 + ln) * 4) = ss;
                        const bf16_t* zr = Z + (t0 + ln) * 2048 + h * 512 + vh * 256 + wid * 32;
#pragma unroll
                        for (int j = 0; j < 4; ++j) hz[j] = *(const u32x4*)(zr + j * 8);
                        LBAR();
                        GN_PUBLISH(n); GN_POLL(n);
                        LBAR();
                        GN_FINAL(n);
                    }
                }
                if (dir == 0) LBAR();
            }
#undef LBAR
#undef STAGE_VG
#undef XSLOT
#undef GN_PUBLISH
#undef GN_POLL
#undef GN_FINAL
#undef CLOAD_QK
#undef CLOAD_VG
        }
    }
}
#undef LAUNDER
#undef PK8
}


#define XB_TMO      128
#define XB_XCNT(j)  (256  + 64 * (j))
#define XB_XSUB(j)  (1280 + 64 * (j))
#define XB_XGEN(j)  (2304 + 64 * (j))
#define XB_TOP      3328
#define XB_TOPGEN   3392
#define XCD_BAR_WORDS 3456
#define XB_SPIN_CAP (1u << 18)
__device__ __forceinline__ unsigned xb_ld(unsigned* p)              { return __hip_atomic_load(p, __ATOMIC_RELAXED, __HIP_MEMORY_SCOPE_AGENT); }
__device__ __forceinline__ unsigned xb_add(unsigned* p, unsigned v) { return __hip_atomic_fetch_add(p, v, __ATOMIC_RELAXED, __HIP_MEMORY_SCOPE_AGENT); }
__device__ __forceinline__ unsigned xb_xcc_id() { return (unsigned)__builtin_amdgcn_s_getreg((3 << 11) | 20) & 0xFu; }
#define XB_SPIN(cond, bar) do { unsigned _sp = 0; while (cond) { __builtin_amdgcn_s_sleep(1); \
    if ((++_sp & 255u) == 0u) { if (xb_ld(&(bar)[XB_TMO])) break; if (_sp > XB_SPIN_CAP) { atomicAdd(&(bar)[XB_TMO], 1u); break; } } } } while (0)
__device__ __forceinline__ void xcd_barrier_complete(unsigned* bar, unsigned x, unsigned& nloc, unsigned& nx) {
    const unsigned G = gridDim.x;
    unsigned sum, cnt, mine, sp = 0u;
    for (;;) {
        sum = 0u; cnt = 0u; mine = 0u;
#pragma unroll
        for (unsigned j = 0; j < 16; ++j) { const unsigned c = xb_ld(&bar[XB_XCNT(j)]); sum += c; cnt += (c > 0u) ? 1u : 0u; mine = (j == x) ? c : mine; }
        if (sum == G) break;
        __builtin_amdgcn_s_sleep(1);
        if ((++sp & 255u) == 0u) { if (xb_ld(&bar[XB_TMO])) break; if (sp > XB_SPIN_CAP) { atomicAdd(&bar[XB_TMO], 1u); break; } }
    }
    nloc = mine > 0u ? mine : 1u; nx = cnt > 0u ? cnt : 1u;
}
__device__ __forceinline__ void xcd_barrier(unsigned* bar, unsigned x, volatile LAS unsigned* st, int wv) {
    asm volatile("s_waitcnt vmcnt(0)" ::: "memory");
    __syncthreads();
    if (wv == 0 && opaque_lane() == 0) {
        __builtin_amdgcn_s_waitcnt(0);
        unsigned nloc = st[0], nx = st[1];
        if (nloc == 0u) { xcd_barrier_complete(bar, x, nloc, nx); st[0] = nloc; st[1] = nx; }
        const unsigned old = xb_add(&bar[XB_XSUB(x)], 1u);
        const unsigned gen = old / nloc;
        if (old + 1u == (gen + 1u) * nloc) {
            __builtin_amdgcn_fence(__ATOMIC_RELEASE, "agent");
            asm volatile("s_waitcnt vmcnt(0)" ::: "memory");
            const unsigned og = xb_add(&bar[XB_TOP], 1u);
            const unsigned tg = og / nx;
            if (og + 1u == (tg + 1u) * nx) xb_add(&bar[XB_TOPGEN], 1u);
            else XB_SPIN(xb_ld(&bar[XB_TOPGEN]) == tg, bar);
            __builtin_amdgcn_fence(__ATOMIC_ACQUIRE, "agent");
            xb_add(&bar[XB_XGEN(x)], 1u);
            asm volatile("s_waitcnt vmcnt(0)" ::: "memory");
        } else {
            XB_SPIN(xb_ld(&bar[XB_XGEN(x)]) == gen, bar);
            __builtin_amdgcn_fence(__ATOMIC_ACQUIRE, "agent");
            asm volatile("s_waitcnt vmcnt(0)" ::: "memory");
        }
    }
    __syncthreads();
}

constexpr int NPHASE = 23;
#ifndef MK_EN
#define MK_EN 0xFFFF
#endif
#ifndef MK_DUP
#define MK_DUP 0
#endif
#define REPS(bit) for (int rep_ = 0, nrep_ = (MK_DUP & (bit)) ? 2 : 1; rep_ < nrep_; ++rep_)
__global__ void __launch_bounds__(512, 2) mk_fwd(Params p) {
    extern __shared__ __attribute__((aligned(16))) unsigned char lds[];
    LAS unsigned char* lds3 = (LAS unsigned char*)lds;
    typedef const __attribute__((address_space(4))) Params* KP;
    const int wv = __builtin_amdgcn_readfirstlane((int)(threadIdx.x >> 6));
    volatile LAS unsigned* bst = (volatile LAS unsigned*)(lds3 + LDS_ST_OFF);
    if (threadIdx.x == 0) { bst[0] = 0u; bst[1] = 0u; }
    __syncthreads();
    const unsigned bx = xb_xcc_id();
    if (threadIdx.x == 0) (void)xb_add(&((unsigned*)(p.ws + WS_BAR))[XB_XCNT(bx)], 1u);
    const int ph_lo = p.ph_lo, ph_hi = p.ph_hi;
    if (ph_lo == 0) {
        KP pp0 = (KP)__builtin_amdgcn_kernarg_segment_ptr();
        if (MK_EN & 1) REPS(1) phase_prep(pp0, lds, wv);
        if (ph_hi > 1) cg::this_grid().sync();
    }
    const int nrounds = (MK_DUP & 4096) ? 2 : 1;
    for (int ph2 = ph_lo > 1 ? ph_lo : 1; ph2 < ph_hi * nrounds; ++ph2) {
        const int ph = ph2 >= ph_hi ? ph2 - ph_hi : ph2;
        if (ph == 0) { KP pp0 = (KP)__builtin_amdgcn_kernarg_segment_ptr(); phase_prep(pp0, lds, wv); xcd_barrier((unsigned*)(p.ws + WS_BAR), xb_xcc_id(), (volatile LAS unsigned*)(lds3 + LDS_ST_OFF), wv); continue; }
        int q = ph; asm volatile("" : "+s"(q));
        KP pp = (KP)__builtin_amdgcn_kernarg_segment_ptr(); asm volatile("" : "+s"(pp));
        unsigned char* ws = pp->ws;
        const int G = gridDim.x, c = blockIdx.x;
        int kind, L = 0, half = 0;
        if (q == 0) kind = 0;
        else { const int pr = (q - 1) / 11, r = (q - 1) % 11;
            if (r < 4) { L = 2 * pr; kind = r == 0 ? 1 : r == 1 ? 2 : r == 2 ? 4 : 5; } else { L = 2 * pr + 1; const int r2 = r - 4;
                if (r2 == 0) kind = 6; else if (r2 < 5) { half = (r2 - 1) >> 1; kind = 8 + ((r2 - 1) & 1); } else kind = r2 == 5 ? 4 : 5; } }
        const int j = L >> 1;
        float* XRES = pp->out;
        bf16_t* XB = (bf16_t*)(ws + WS_XB);
        if (kind == 1) { pg8::Gemm g{XB, (const bf16_t*)(ws + W_GIN + j * W_GIN_SZ), T, GLA_NPAD, 1024}; pg8::StaticOrder S; S.init(T, GLA_NPAD, G, c);
            pg8::EpiGlaIn E{(bf16_t*)(ws + WS_GQK), (bf16_t*)(ws + WS_GV), (bf16_t*)(ws + WS_GZ), (float*)(ws + WS_GLR)}; if (MK_EN & 2) REPS(2) pg8::gemm_phase(lds3, g, S, E, wv); }
        else if (kind == 2) { if (MK_EN & 4) scan::phase_scan((const bf16_t*)(ws + WS_GQK), (const bf16_t*)(ws + WS_GV), (const float*)(ws + WS_GLR), (bf16_t*)(ws + WS_OFW),
                                                              pp->gla_w_gate + (size_t)j * 2 * 16 * 512, pp->gla_b_gate + (size_t)j * 2 * 512, (char*)lds, wv,
                                                              (bf16_t*)(ws + WS_GZ), pp->gla_gn_g + (size_t)j * 2048, (unsigned long long*)(ws + WS_XCH), (unsigned)(j + 1)); }
        else if (kind == 3) { if (MK_EN & 8) REPS(8) phase_gla_gate((const bf16_t*)(ws + WS_OFW), (bf16_t*)(ws + WS_GZ), pp->gla_gn_g + (size_t)j * 2048, wv, rep_ + 1 < nrep_); }
        else if (kind == 4) { const bool gla = (L & 1) == 0; const float* xin = L == 0 ? pp->x : XRES;
            pg8::Gemm g{(const bf16_t*)(ws + (gla ? WS_GZ : WS_MZ)), (const bf16_t*)(ws + (gla ? W_GOUT : W_MOUT) + j * W_OUT_SZ), T, 1024, 2048}; pg8::StaticOrder S; S.init(T, 1024, G, c);
            if (MK_EN & 16) REPS(16) { pg8::EpiRes E{XRES, xin, L == 0 ? (const f32x2*)nullptr : (const f32x2*)(ws + WS_STATS), pp->ln_g + (L - 1) * 1024, pp->ln_b + (L - 1) * 1024, rep_ + 1 < nrep_}; pg8::gemm_phase(lds3, g, S, E, wv); } }
        else if (kind == 5) { if (MK_EN & 1024) REPS(1024) phase_ln(XRES, XB, (f32x2*)(ws + WS_STATS), pp->ln_g + L * 1024, pp->ln_b + L * 1024, wv, rep_ + 1 < nrep_, L == 3); }
        else if (kind == 6) { pg8::Gemm g{XB, (const bf16_t*)(ws + W_MIN + j * W_MIN_SZ), T, MLA_NPAD, 1024}; pg8::StaticOrder S; S.init(T, MLA_NPAD, G, c);
            pg8::EpiMlaIn E{(bf16_t*)(ws + WS_MZ), (bf16_t*)(ws + WS_CKV), (bf16_t*)(ws + WS_CQ), (bf16_t*)(ws + WS_KRO), (float*)(ws + WS_RQ + (size_t)j * 524288), (float*)(ws + WS_RQ + (size_t)j * 524288 + 262144), (const float*)(ws + WS_COS), (const float*)(ws + WS_SIN)}; if (MK_EN & 32) REPS(32) pg8::gemm_phase(lds3, g, S, E, wv); }
        else if (kind == 7) { if (MK_EN & 64) REPS(64) phase_mla_stats((const bf16_t*)(ws + WS_CQ), (const bf16_t*)(ws + WS_CKV), (const float*)(ws + WS_KRR), (bf16_t*)(ws + WS_KRO), (float*)(ws + WS_RQ), (float*)(ws + WS_RKV),
                                                              (const float*)(ws + WS_COS), (const float*)(ws + WS_SIN), wv); }
        else if (kind == 8) {
            { pg8::Gemm g{(const bf16_t*)(ws + WS_CQ) + (size_t)half * TH * 384, (const bf16_t*)(ws + W_MUQ + j * W_MUQ_SZ), TH, 3072, 384}; pg8::StaticOrder S; S.init(TH, 3072, G, c);
              pg8::EpiQup E{(bf16_t*)(ws + WS_QH), (const float*)(ws + WS_RQ + (size_t)j * 524288), (const float*)(ws + WS_COS), (const float*)(ws + WS_SIN), half * TH}; if (MK_EN & 128) REPS(128) pg8::gemm_phase(lds3, g, S, E, wv); }
            { pg8::Gemm g{(const bf16_t*)(ws + WS_CKV) + (size_t)half * TH * 256, (const bf16_t*)(ws + W_MUKV + j * W_MUKV_SZ), TH, 4096, 256}; pg8::StaticOrder S; S.init(TH, 4096, G, c);
              pg8::EpiKVup E{(bf16_t*)(ws + WS_KNH), (bf16_t*)(ws + WS_VH), (const float*)(ws + WS_RQ + (size_t)j * 524288 + 262144), half * TH}; if (MK_EN & 256) REPS(256) pg8::gemm_phase(lds3, g, S, E, wv); }
        }
        else { if (MK_EN & 512) REPS(512) att::phase_attn((const bf16_t*)(ws + WS_QH), (const bf16_t*)(ws + WS_KNH), (const bf16_t*)(ws + WS_VH), (const bf16_t*)(ws + WS_KRO), (bf16_t*)(ws + WS_MZ), half, (char*)lds, wv, rep_ + 1 < nrep_); }
        if (ph2 + 1 < ph_hi * nrounds) REPS(2048) xcd_barrier((unsigned*)(ws + WS_BAR), xb_xcc_id(), (volatile LAS unsigned*)(lds3 + LDS_ST_OFF), wv);
    }
}

#ifndef MK_MULTI
#define MK_MULTI 0
#endif
extern "C" void kernel_launch(void* const* d_in, const int* in_sizes, int n_in, void* d_out, int out_size, void* d_ws, size_t ws_size, hipStream_t stream) {
    static int grid = 0;
    if (grid == 0) {
        if (n_in != 15 || out_size != T * DM || ws_size < WS_END) { fprintf(stderr, "kernel_launch: unexpected shapes n_in %d out %d ws %zu (need %zu)\n", n_in, out_size, ws_size, (size_t)WS_END); grid = -1; return; }
        if (hipFuncSetAttribute((const void*)mk_fwd, hipFuncAttributeMaxDynamicSharedMemorySize, LDS_BYTES) != hipSuccess) { fprintf(stderr, "kernel_launch: hipFuncSetAttribute failed\n"); grid = -1; return; }
        int dev = 0, cus = 0, per_cu = 0;
        hipGetDevice(&dev); hipDeviceGetAttribute(&cus, hipDeviceAttributeMultiprocessorCount, dev);
        hipOccupancyMaxActiveBlocksPerMultiprocessor(&per_cu, (const void*)mk_fwd, 512, LDS_BYTES);
        if (per_cu < 1) { fprintf(stderr, "kernel_launch: occupancy query says %d blocks per CU\n", per_cu); }
        (void)hipGetLastError();
        grid = cus > 0 ? cus : 256;
    }
    if (grid < 0) return;
    Params p{};
    p.x = (const float*)d_in[0]; p.pos = (const int*)d_in[1]; p.ln_g = (const float*)d_in[2]; p.ln_b = (const float*)d_in[3];
    p.gla_w_in = (const float*)d_in[4]; p.gla_w_gate = (const float*)d_in[5]; p.gla_b_gate = (const float*)d_in[6]; p.gla_gn_g = (const float*)d_in[7]; p.gla_w_out = (const float*)d_in[8];
    p.mla_w_in = (const float*)d_in[9]; p.mla_qn_g = (const float*)d_in[10]; p.mla_kvn_g = (const float*)d_in[11]; p.mla_w_uq = (const float*)d_in[12]; p.mla_w_ukv = (const float*)d_in[13]; p.mla_w_out = (const float*)d_in[14];
    p.out = (float*)d_out; p.ws = (unsigned char*)d_ws;
    if (hipMemsetAsync((char*)d_ws + WS_XCH, 0, 4 * MiB, stream) != hipSuccess) { fprintf(stderr, "kernel_launch: memset failed\n"); return; }
    if (hipMemsetAsync((char*)d_ws + WS_BAR, 0, XCD_BAR_WORDS * 4, stream) != hipSuccess) { fprintf(stderr, "kernel_launch: memset failed\n"); return; }
#if MK_MULTI
    for (int ph = 0; ph < NPHASE; ++ph) {
        p.ph_lo = ph; p.ph_hi = ph + 1;
        hipLaunchKernelGGL(mk_fwd, dim3(grid), dim3(512), LDS_BYTES, stream, p);
    }
#else
    p.ph_lo = 0; p.ph_hi = NPHASE;
    void* args[] = {&p};
    hipError_t e = hipLaunchCooperativeKernel((const void*)mk_fwd, dim3(grid), dim3(512), args, LDS_BYTES, stream);
    if (e != hipSuccess) fprintf(stderr, "cooperative launch failed: %s (grid %d)\n", hipGetErrorString(e), grid);
#endif
    const hipError_t le = hipPeekAtLastError();
    if (le != hipSuccess) fprintf(stderr, "kernel_launch: launch failed: %s\n", hipGetErrorName(le));
}
```

```cpp
#include <hip/hip_runtime.h>
#include <hip/hip_cooperative_groups.h>
#include <cstdio>
#include <cstdint>
namespace cg = cooperative_groups;

#define LAS __attribute__((address_space(3)))
typedef unsigned short bf16_t;
typedef short bf16x8 __attribute__((ext_vector_type(8)));
typedef short s16x4 __attribute__((ext_vector_type(4)));
typedef float f32x4 __attribute__((ext_vector_type(4)));
typedef float f32x2 __attribute__((ext_vector_type(2)));
typedef float f32x16 __attribute__((ext_vector_type(16)));
typedef unsigned u32x4 __attribute__((ext_vector_type(4)));
typedef unsigned u32x2 __attribute__((ext_vector_type(2)));

constexpr int T = 65536, DM = 1024, SEQ = 2048, NBATCH = 32;
constexpr int TH = T / 2;
constexpr float ALPHA = 1.6817928305074290f;
constexpr float EPS = 1e-5f;
constexpr int GLA_NPAD = 5376, MLA_NPAD = 2816;
constexpr int LDS_BYTES = 143360;

constexpr size_t MiB = 1048576;
constexpr size_t W_GIN = 0, W_GIN_SZ = (size_t)GLA_NPAD * 1024 * 2;
constexpr size_t W_GOUT = W_GIN + 2 * W_GIN_SZ, W_OUT_SZ = (size_t)1024 * 2048 * 2;
constexpr size_t W_MIN = W_GOUT + 2 * W_OUT_SZ, W_MIN_SZ = (size_t)MLA_NPAD * 1024 * 2;
constexpr size_t W_MUQ = W_MIN + 2 * W_MIN_SZ, W_MUQ_SZ = (size_t)3072 * 384 * 2;
constexpr size_t W_MUKV = W_MUQ + 2 * W_MUQ_SZ, W_MUKV_SZ = (size_t)4096 * 256 * 2;
constexpr size_t W_MOUT = W_MUKV + 2 * W_MUKV_SZ;
static_assert(W_MOUT + 2 * W_OUT_SZ <= 64 * MiB, "weights region");
constexpr size_t WS_XB = 64 * MiB;
constexpr size_t WS_OFW = 64 * MiB, WS_GQK = 320 * MiB, WS_GV = 448 * MiB, WS_GZ = 704 * MiB, WS_GLR = 960 * MiB;
constexpr size_t WS_MZ = 192 * MiB, WS_QH = 448 * MiB, WS_KNH = 640 * MiB, WS_VH = 768 * MiB, WS_CQ = 896 * MiB, WS_CKV = 944 * MiB,
                 WS_KRR = 976 * MiB, WS_KRO = 992 * MiB, WS_RQ = 1000 * MiB, WS_RKV = 1000 * MiB + 262144;
constexpr size_t WS_COS = 1001 * MiB, WS_SIN = 1009 * MiB, WS_BAR = 1017 * MiB, WS_STATS = 1017 * MiB + 65536, WS_XCH = 1018 * MiB, WS_END = 1022 * MiB;
constexpr int LDS_ST_OFF = 143344;

struct Params {
    const float* x; const int* pos; const float* ln_g; const float* ln_b;
    const float* gla_w_in; const float* gla_w_gate; const float* gla_b_gate; const float* gla_gn_g; const float* gla_w_out;
    const float* mla_w_in; const float* mla_qn_g; const float* mla_kvn_g; const float* mla_w_uq; const float* mla_w_ukv; const float* mla_w_out;
    float* out; unsigned char* ws;
    int ph_lo, ph_hi;
};

__device__ __forceinline__ unsigned cvt_pk_bf16(float lo, float hi) { unsigned r; asm volatile("v_cvt_pk_bf16_f32 %0, %1, %2" : "=v"(r) : "v"(lo), "v"(hi)); return r; }
__device__ __forceinline__ float bf2f(unsigned short b) { return __uint_as_float(((unsigned)b) << 16); }
__device__ __forceinline__ float bflo(unsigned w) { return __uint_as_float(w << 16); }
__device__ __forceinline__ float bfhi(unsigned w) { return __uint_as_float(w & 0xffff0000u); }
__device__ __forceinline__ float silu_f(float z) { return z / (1.f + __expf(-z)); }
__device__ __forceinline__ float silu_fast(float z) { return z * __builtin_amdgcn_rcpf(1.f + __expf(-z)); }
__device__ __forceinline__ float wave_sum(float v) {
#pragma unroll
    for (int o = 32; o > 0; o >>= 1) v += __shfl_xor(v, o, 64);
    return v;
}

__device__ __forceinline__ int opaque_lane() { int l = __builtin_amdgcn_mbcnt_hi(~0u, __builtin_amdgcn_mbcnt_lo(~0u, 0u)); asm volatile("" : "+v"(l)); return l; }
__device__ __forceinline__ int opaque_tid(int wv) { return wv * 64 + opaque_lane(); }
namespace pg8 {
constexpr int BM = 256, BK = 64, HALF = 128, HTB = HALF * BK * 2, STAGE_BYTES = 8 * HTB, NXCD = 8, WGM = 8;
__host__ __device__ __forceinline__ int lds_byte(int r, int c) { const int st = (r >> 4) * 2 + (c >> 5), rr = r & 15, cc = c & 31, ob = rr * 64 + cc * 2; return st * 1024 + (ob ^ (((ob >> 9) & 1) << 5)); }
__host__ __device__ __forceinline__ void stage_rc(int b, int& R, int& C) { const int st = b / 1024, sb = b % 1024, swz = sb ^ (((sb >> 9) & 1) << 5); R = (st >> 1) * 16 + swz / 64; C = (st & 1) * 32 + (swz % 64) / 2; }
__host__ __device__ __forceinline__ int perm32(int rho) { const int n = rho >> 4, i = rho & 15; return 8 * (i >> 2) + 4 * n + (i & 3); }
struct Unit { int pm, pn; };
struct Gemm { const bf16_t* A; const bf16_t* Bt; int M, N, K; };
struct StaticOrder {
    int nM, nN, nwg, G, c;
    __device__ void init(int M, int N, int G_, int c_) { nM = M / BM; nN = N / BM; nwg = nM * nN; G = G_; c = c_; }
    __device__ bool next(int i, Unit& u) const {
        const long L = (long)i * G + c; if (L >= nwg) return false;
        int wgid = (int)L; { const int q = nwg / NXCD, r = nwg % NXCD, xcd = wgid % NXCD, off = wgid / NXCD; wgid = (xcd < r ? xcd * (q + 1) : r * (q + 1) + (xcd - r) * q) + off; }
        const int nig = WGM * nN, gid = wgid / nig, fm = gid * WGM, gsz = (nM - fm) < WGM ? (nM - fm) : WGM;
        u.pm = fm + ((wgid % nig) % gsz); u.pn = (wgid % nig) / gsz; return true;
    }
};

template <class Epi>
__device__ __forceinline__ void gemm_phase(LAS unsigned char* lds, const Gemm g, const StaticOrder& S, const Epi& E, int wv) {
    const int tid = opaque_tid(wv), wid = wv, lane = tid & 63, wr = wid >> 2, wc = wid & 3, fr = lane & 15, fq = lane >> 4;
    const int K = g.K, nt = K / BK;
    unsigned voffA[2], voffB[2];
#pragma unroll
    for (int i = 0; i < 2; ++i) { int R, C; stage_rc(tid * 16 + i * 8192, R, C); const int Rb = Epi::PERM ? ((R & ~31) + perm32(R & 31)) : R;
        voffA[i] = (unsigned)(R * K + C) * 2u; voffB[i] = (unsigned)(Rb * K + C) * 2u; }
    const size_t kstep = (size_t)(BK * 2);
    const size_t hstep = (size_t)HALF * K * 2;
    const size_t tstep = 2 * hstep;
    const unsigned ldsw = (unsigned)wid * 1024u;
    const int aoff = lds_byte(wr * 64 + fr, fq * 8), boff = lds_byte(wc * 32 + fr, fq * 8);
#define PG8_SA(b, h) (((b) * 2 + (h)) * HTB)
#define PG8_SB(b, h) ((4 + (b) * 2 + (h)) * HTB)
#define PG8_STAGE(bufoff, gbase, voff) do { _Pragma("unroll") for (int _i = 0; _i < 2; ++_i) \
        __builtin_amdgcn_global_load_lds((const unsigned*)((const char*)(gbase) + (voff)[_i]), (LAS unsigned*)(lds + (bufoff) + ldsw + _i * 8192), 16, 0, 0); } while (0)
#define PG8_LDA(dst, b, h) do { _Pragma("unroll") for (int m = 0; m < 4; ++m) _Pragma("unroll") for (int k = 0; k < 2; ++k) dst[m][k] = *(const LAS bf16x8*)(lds + PG8_SA(b, h) + aoff + m * 2048 + k * 1024); } while (0)
#define PG8_LDB(dst, b, h) do { _Pragma("unroll") for (int n = 0; n < 2; ++n) _Pragma("unroll") for (int k = 0; k < 2; ++k) dst[n][k] = *(const LAS bf16x8*)(lds + PG8_SB(b, h) + boff + n * 2048 + k * 1024); } while (0)
#define PG8_MMA(ai, bj, At, Bt) do { __builtin_amdgcn_s_setprio(1); _Pragma("unroll") for (int m = 0; m < 4; ++m) _Pragma("unroll") for (int n = 0; n < 2; ++n) _Pragma("unroll") for (int k = 0; k < 2; ++k) \
        acc[ai][bj][m][n] = __builtin_amdgcn_mfma_f32_16x16x32_bf16(Bt[n][k], At[m][k], acc[ai][bj][m][n], 0, 0, 0); __builtin_amdgcn_s_setprio(0); } while (0)
#define PG8_WAIT_V(n) asm volatile("s_waitcnt vmcnt(" #n ")" ::: "memory")
#define PG8_WAIT_L(n) asm volatile("s_waitcnt lgkmcnt(" #n ")" ::: "memory")
#define PG8_BAR __builtin_amdgcn_s_barrier()
#define PG8_SCHED __builtin_amdgcn_sched_barrier(0)
    Unit cur, nxt; int ui = 0;
    if (!S.next(0, cur)) return;
    f32x4 acc[2][2][4][2];
#pragma unroll
    for (int a = 0; a < 2; ++a)
#pragma unroll
        for (int b = 0; b < 2; ++b)
#pragma unroll
            for (int m = 0; m < 4; ++m)
#pragma unroll
                for (int n = 0; n < 2; ++n) acc[a][b][m][n] = (f32x4){0.f, 0.f, 0.f, 0.f};
    bf16x8 At[4][2], B0[2][2], B1[2][2];
    const char* cA = (const char*)g.A + (size_t)cur.pm * tstep; const char* cB = (const char*)g.Bt + (size_t)cur.pn * tstep;
    PG8_STAGE(PG8_SB(0, 0), cB, voffB); PG8_STAGE(PG8_SA(0, 0), cA, voffA); PG8_STAGE(PG8_SB(0, 1), cB + hstep, voffB); PG8_STAGE(PG8_SA(0, 1), cA + hstep, voffA);
    if (wr == 1) PG8_BAR;
    PG8_WAIT_V(4); PG8_BAR;
    PG8_STAGE(PG8_SB(1, 0), cB + kstep, voffB); PG8_STAGE(PG8_SA(1, 0), cA + kstep, voffA); PG8_STAGE(PG8_SB(1, 1), cB + hstep + kstep, voffB);
    PG8_WAIT_V(6); PG8_BAR;
    for (;;) {
        const bool has_next = S.next(ui + 1, nxt);
        const char* nA = has_next ? (const char*)g.A + (size_t)nxt.pm * tstep : cA; const char* nB = has_next ? (const char*)g.Bt + (size_t)nxt.pn * tstep : cB;
        for (int t = 0; t < nt; t += 2) {
            const bool last = (t == nt - 2);
            const char* a1 = cA + (size_t)(t + 1) * kstep;
            const char* a2 = last ? nA : cA + (size_t)(t + 2) * kstep; const char* b2 = last ? nB : cB + (size_t)(t + 2) * kstep;
            const char* a3 = a2 + kstep; const char* b3 = b2 + kstep;
            PG8_LDB(B0, 0, 0); PG8_SCHED; PG8_LDA(At, 0, 0); PG8_STAGE(PG8_SA(1, 1), a1 + hstep, voffA);
            PG8_WAIT_L(8); PG8_BAR; PG8_WAIT_L(0); PG8_MMA(0, 0, At, B0); PG8_BAR; PG8_SCHED;
            PG8_LDB(B1, 0, 1); PG8_STAGE(PG8_SB(0, 0), b2, voffB);
            PG8_BAR; PG8_WAIT_L(0); PG8_MMA(0, 1, At, B1); PG8_BAR;
            PG8_LDA(At, 0, 1); PG8_STAGE(PG8_SA(0, 0), a2, voffA);
            PG8_BAR; PG8_WAIT_L(0); PG8_MMA(1, 0, At, B0); PG8_BAR; PG8_SCHED;
            PG8_STAGE(PG8_SB(0, 1), b2 + hstep, voffB);
            PG8_WAIT_V(6); PG8_BAR; PG8_MMA(1, 1, At, B1); PG8_BAR;
            PG8_LDB(B0, 1, 0); PG8_SCHED; PG8_LDA(At, 1, 0); PG8_STAGE(PG8_SA(0, 1), a2 + hstep, voffA);
            PG8_WAIT_L(8); PG8_BAR; PG8_WAIT_L(0); PG8_MMA(0, 0, At, B0); PG8_BAR; PG8_SCHED;
            PG8_LDB(B1, 1, 1); PG8_STAGE(PG8_SB(1, 0), b3, voffB);
            PG8_BAR; PG8_WAIT_L(0); PG8_MMA(0, 1, At, B1); PG8_BAR;
            PG8_LDA(At, 1, 1); PG8_STAGE(PG8_SA(1, 0), a3, voffA);
            PG8_BAR; PG8_WAIT_L(0); PG8_MMA(1, 0, At, B0); PG8_BAR; PG8_SCHED;
            PG8_STAGE(PG8_SB(1, 1), b3 + hstep, voffB);
            PG8_WAIT_V(6); PG8_BAR; PG8_MMA(1, 1, At, B1); PG8_BAR;
        }
        E(acc, cur, wv);
        if (!has_next) break;
#pragma unroll
        for (int a = 0; a < 2; ++a)
#pragma unroll
            for (int b = 0; b < 2; ++b)
#pragma unroll
                for (int m = 0; m < 4; ++m)
#pragma unroll
                    for (int n = 0; n < 2; ++n) acc[a][b][m][n] = (f32x4){0.f, 0.f, 0.f, 0.f};
        cur = nxt; cA = nA; cB = nB; ++ui;
    }
    PG8_WAIT_V(0);
    if (wr == 0) PG8_BAR;
    PG8_BAR;
#undef PG8_SA
#undef PG8_SB
#undef PG8_STAGE
#undef PG8_LDA
#undef PG8_LDB
#undef PG8_MMA
#undef PG8_WAIT_V
#undef PG8_WAIT_L
#undef PG8_BAR
#undef PG8_SCHED
}

typedef f32x4 Acc[2][2][4][2];
__device__ __forceinline__ void store8_bf16(bf16_t* p, f32x4 v0, f32x4 v1, float s) {
    u32x4 w = {cvt_pk_bf16(v0[0] * s, v0[1] * s), cvt_pk_bf16(v0[2] * s, v0[3] * s), cvt_pk_bf16(v1[0] * s, v1[1] * s), cvt_pk_bf16(v1[2] * s, v1[3] * s)};
    *(u32x4*)p = w;
}
__device__ __forceinline__ void tile_store_bf16(const Acc& acc, bf16_t* base, int ld, int pm, int wr, int wc, int fr, int fq, float s) {
    const int row0 = pm * BM + wr * 64 + fr, col0 = wc * 32 + 8 * fq;
#pragma unroll
    for (int ai = 0; ai < 2; ++ai)
#pragma unroll
        for (int m = 0; m < 4; ++m) { bf16_t* rowp = base + (size_t)(row0 + ai * HALF + m * 16) * ld + col0;
#pragma unroll
            for (int bj = 0; bj < 2; ++bj) store8_bf16(rowp + bj * HALF, acc[ai][bj][m][0], acc[ai][bj][m][1], s); }
}
struct EpiGlaIn {
    static constexpr bool PERM = true;
    bf16_t* QK; bf16_t* V; bf16_t* Z; float* GLR;
    __device__ __forceinline__ void operator()(const Acc& acc, const Unit& u, int wv) const {
        const int wr = wv >> 2, wc = wv & 3, ln_ = opaque_lane(), fr = ln_ & 15, fq = ln_ >> 4;
        const int pn = u.pn;
        if (pn < 4) tile_store_bf16(acc, QK + pn * 256, 1024, u.pm, wr, wc, fr, fq, pn < 2 ? 0.08838834764831845f : 1.f);
        else if (pn < 12) tile_store_bf16(acc, V + (pn - 4) * 256, 2048, u.pm, wr, wc, fr, fq, 1.f);
        else if (pn < 20) tile_store_bf16(acc, Z + (pn - 12) * 256, 2048, u.pm, wr, wc, fr, fq, 1.f);
        else if (wc == 0) {
            const int row0 = u.pm * BM + wr * 64 + fr;
#pragma unroll
            for (int ai = 0; ai < 2; ++ai)
#pragma unroll
                for (int m = 0; m < 4; ++m) { float* rowp = GLR + (size_t)(row0 + ai * HALF + m * 16) * 32 + 8 * fq;
                    *(f32x4*)rowp = acc[ai][0][m][0]; *(f32x4*)(rowp + 4) = acc[ai][0][m][1]; }
        }
    }
};
__device__ __forceinline__ float sumsq8(f32x4 a, f32x4 b) { return a[0] * a[0] + a[1] * a[1] + a[2] * a[2] + a[3] * a[3] + b[0] * b[0] + b[1] * b[1] + b[2] * b[2] + b[3] * b[3]; }
struct EpiMlaIn {
    static constexpr bool PERM = true;
    bf16_t* Z; bf16_t* CKV; bf16_t* CQ; bf16_t* KRO; float* SSQ_Q; float* SSQ_KV; const float* COS; const float* SIN;
    __device__ __forceinline__ void operator()(const Acc& acc, const Unit& u, int wv) const {
        const int wr = wv >> 2, wc = wv & 3, ln_ = opaque_lane(), fr = ln_ & 15, fq = ln_ >> 4;
        const int pn = u.pn;
        if (pn < 8) { tile_store_bf16(acc, Z + pn * 256, 2048, u.pm, wr, wc, fr, fq, 1.f); return; }
        const int row0 = u.pm * BM + wr * 64 + fr, col0 = wc * 32 + 8 * fq;
#pragma unroll
        for (int ai = 0; ai < 2; ++ai)
#pragma unroll
            for (int m = 0; m < 4; ++m) { const size_t row = (size_t)(row0 + ai * HALF + m * 16);
                float ss;
                if (pn == 8) { bf16_t* rp = CKV + row * 256 + col0; store8_bf16(rp, acc[ai][0][m][0], acc[ai][0][m][1], 1.f); store8_bf16(rp + HALF, acc[ai][1][m][0], acc[ai][1][m][1], 1.f);
                    ss = sumsq8(acc[ai][0][m][0], acc[ai][0][m][1]) + sumsq8(acc[ai][1][m][0], acc[ai][1][m][1]); }
                else if (pn == 9) { bf16_t* rp = CQ + row * 384 + col0; store8_bf16(rp, acc[ai][0][m][0], acc[ai][0][m][1], 1.f); store8_bf16(rp + HALF, acc[ai][1][m][0], acc[ai][1][m][1], 1.f);
                    ss = sumsq8(acc[ai][0][m][0], acc[ai][0][m][1]) + sumsq8(acc[ai][1][m][0], acc[ai][1][m][1]); }
                else { store8_bf16(CQ + row * 384 + 256 + col0, acc[ai][0][m][0], acc[ai][0][m][1], 1.f);
                    ss = sumsq8(acc[ai][0][m][0], acc[ai][0][m][1]);
                    if (wc < 2) { const int i0 = col0 >> 1; const f32x4 cs = *(const f32x4*)(COS + row * 32 + i0), sn = *(const f32x4*)(SIN + row * 32 + i0);
                        const f32x4 v0 = acc[ai][1][m][0], v1 = acc[ai][1][m][1]; f32x4 w0, w1;
                        w0[0] = v0[0] * cs[0] - v0[1] * sn[0]; w0[1] = v0[1] * cs[0] + v0[0] * sn[0];
                        w0[2] = v0[2] * cs[1] - v0[3] * sn[1]; w0[3] = v0[3] * cs[1] + v0[2] * sn[1];
                        w1[0] = v1[0] * cs[2] - v1[1] * sn[2]; w1[1] = v1[1] * cs[2] + v1[0] * sn[2];
                        w1[2] = v1[2] * cs[3] - v1[3] * sn[3]; w1[3] = v1[3] * cs[3] + v1[2] * sn[3];
                        store8_bf16(KRO + row * 64 + col0, w0, w1, 1.f); } }
                ss += __shfl_xor(ss, 16, 64); ss += __shfl_xor(ss, 32, 64);
                if (fq == 0) atomicAdd((pn == 8 ? SSQ_KV : SSQ_Q) + row, ss);
                __builtin_amdgcn_sched_barrier(0); }
    }
};
struct EpiQup {
    static constexpr bool PERM = true;
    bf16_t* Q; const float* RQ; const float* COS; const float* SIN; int tok0;
    __device__ __forceinline__ void operator()(Acc& acc, const Unit& u, int wv) const {
        const int wr = wv >> 2, wc = wv & 3, ln_ = opaque_lane(), fr = ln_ & 15, fq = ln_ >> 4;
        const int row0 = u.pm * BM + wr * 64 + fr;
        float sc[8];
#pragma unroll
        for (int i = 0; i < 8; ++i) sc[i] = RQ[(size_t)tok0 + row0 + (i >> 2) * HALF + (i & 3) * 16];
#pragma unroll
        for (int i = 0; i < 8; ++i) sc[i] = rsqrtf(sc[i] * (1.f / 384.f) + EPS);
#pragma unroll
        for (int bj = 0; bj < 2; ++bj) {
            const int c = u.pn * 256 + bj * 128 + wc * 32 + 8 * fq, o = c % 192; const bool rope = o >= 128; const int i0 = (o - 128) >> 1;
            if (!rope) {
#pragma unroll
                for (int i = 0; i < 8; ++i) { const int row = row0 + (i >> 2) * HALF + (i & 3) * 16; store8_bf16(Q + (size_t)row * 3072 + c, acc[i >> 2][bj][i & 3][0], acc[i >> 2][bj][i & 3][1], sc[i]); }
            } else {
#pragma unroll
                for (int ai = 0; ai < 2; ++ai) {
                    f32x4 cs[4], sn[4];
#pragma unroll
                    for (int m = 0; m < 4; ++m) { const size_t tok = (size_t)tok0 + row0 + ai * HALF + m * 16; cs[m] = *(const f32x4*)(COS + tok * 32 + i0); sn[m] = *(const f32x4*)(SIN + tok * 32 + i0); }
#pragma unroll
                    for (int m = 0; m < 4; ++m) { const int row = row0 + ai * HALF + m * 16; const float s = sc[ai * 4 + m];
                        const f32x4 v0 = acc[ai][bj][m][0] * s, v1 = acc[ai][bj][m][1] * s; f32x4 w0, w1;
                        w0[0] = v0[0] * cs[m][0] - v0[1] * sn[m][0]; w0[1] = v0[1] * cs[m][0] + v0[0] * sn[m][0];
                        w0[2] = v0[2] * cs[m][1] - v0[3] * sn[m][1]; w0[3] = v0[3] * cs[m][1] + v0[2] * sn[m][1];
                        w1[0] = v1[0] * cs[m][2] - v1[1] * sn[m][2]; w1[1] = v1[1] * cs[m][2] + v1[0] * sn[m][2];
                        w1[2] = v1[2] * cs[m][3] - v1[3] * sn[m][3]; w1[3] = v1[3] * cs[m][3] + v1[2] * sn[m][3];
                        store8_bf16(Q + (size_t)row * 3072 + c, w0, w1, 1.f); }
                    __builtin_amdgcn_sched_barrier(0);
                }
            }
        }
    }
};
struct EpiKVup {
    static constexpr bool PERM = true;
    bf16_t* KN; bf16_t* V; const float* RKV; int tok0;
    __device__ __forceinline__ void operator()(Acc& acc, const Unit& u, int wv) const {
        const int wr = wv >> 2, wc = wv & 3, ln_ = opaque_lane(), fr = ln_ & 15, fq = ln_ >> 4;
        bf16_t* base = u.pn < 8 ? KN + u.pn * 256 : V + (u.pn - 8) * 256;
        const int row0 = u.pm * BM + wr * 64 + fr, col0 = wc * 32 + 8 * fq;
        float sc[8];
#pragma unroll
        for (int i = 0; i < 8; ++i) sc[i] = RKV[(size_t)tok0 + row0 + (i >> 2) * HALF + (i & 3) * 16];
#pragma unroll
        for (int i = 0; i < 8; ++i) sc[i] = rsqrtf(sc[i] * (1.f / 256.f) + EPS);
#pragma unroll
        for (int i = 0; i < 8; ++i) { const int row = row0 + (i >> 2) * HALF + (i & 3) * 16; bf16_t* rowp = base + (size_t)row * 2048 + col0;
#pragma unroll
            for (int bj = 0; bj < 2; ++bj) store8_bf16(rowp + bj * HALF, acc[i >> 2][bj][i & 3][0], acc[i >> 2][bj][i & 3][1], sc[i]); }
    }
};
struct EpiRes {
    static constexpr bool PERM = false;
    float* XRES; const float* XIN; const f32x2* ST; const float* G; const float* B; bool nowrite;
    __device__ __forceinline__ void operator()(const Acc& acc, const Unit& u, int wv) const {
        const int wr = wv >> 2, wc = wv & 3, ln_ = opaque_lane(), fr = ln_ & 15, fq = ln_ >> 4;
        const int row0 = u.pm * BM + wr * 64 + fr, col0 = u.pn * BM + wc * 32 + 4 * fq;
#pragma unroll
        for (int pr = 0; pr < 4; ++pr) {
            f32x4 xi[2][4]; f32x2 st[2];
#pragma unroll
            for (int q = 0; q < 2; ++q) { const int i = pr * 2 + q, row = row0 + (i >> 2) * HALF + (i & 3) * 16; const size_t ro = (size_t)row * 1024 + col0;
                st[q] = (f32x2){0.f, 1.f}; if (ST) st[q] = ST[row];
#pragma unroll
                for (int c4 = 0; c4 < 4; ++c4) xi[q][c4] = *(const f32x4*)(XIN + ro + (c4 >> 1) * HALF + (c4 & 1) * 16); }
#pragma unroll
            for (int q = 0; q < 2; ++q) { const int i = pr * 2 + q, row = row0 + (i >> 2) * HALF + (i & 3) * 16; const size_t ro = (size_t)row * 1024 + col0;
#pragma unroll
                for (int c4 = 0; c4 < 4; ++c4) { const int co = (c4 >> 1) * HALF + (c4 & 1) * 16; f32x4 x = xi[q][c4];
                    if (ST) { const f32x4 g = *(const f32x4*)(G + col0 + co), b = *(const f32x4*)(B + col0 + co); x = (x - st[q][0]) * st[q][1] * g + b; }
                    if (!nowrite) *(f32x4*)(XRES + ro + co) = acc[i >> 2][c4 >> 1][i & 3][c4 & 1] + x * ALPHA; } }
            __builtin_amdgcn_sched_barrier(0);
        }
    }
};
}

enum { MAP_ID = 0, MAP_MLAIN = 1, MAP_UQ = 2, MAP_UKV = 3 };
__device__ __forceinline__ int map_col(int mode, int nd, int nsrc) {
    if (mode == MAP_ID) return nd < nsrc ? nd : -1;
    if (mode == MAP_MLAIN) { if (nd < 2048) return 704 + nd; if (nd < 2304) return 384 + (nd - 2048); if (nd < 2688) return nd - 2304; if (nd < 2752) { const int p_ = nd - 2688; return 640 + (p_ >> 1) + ((p_ & 1) ? 32 : 0); } return -1; }
    if (mode == MAP_UQ) { const int h = nd / 192, o = nd % 192; if (o < 128) return h * 192 + o; const int p = o - 128, i = p >> 1; return (p & 1) ? h * 192 + 160 + i : h * 192 + 128 + i; }
    { if (nd < 2048) return (nd >> 7) * 256 + (nd & 127); const int n2 = nd - 2048; return (n2 >> 7) * 256 + 128 + (n2 & 127); }
}
__device__ __forceinline__ void transpose_job(const float* src, bf16_t* dst, int K, int nsrc, int ndst, int mode, const float* rs, float* tile  , int wv) {
    const int tid = opaque_tid(wv), tk = K / 64, tn = ndst / 64, ntiles = tk * tn;
    for (int t = blockIdx.x; t < ntiles; t += gridDim.x) {
        const int k0 = (t % tk) * 64, n0 = (t / tk) * 64;
        const int nn = tid & 63, sc = map_col(mode, n0 + nn, nsrc);
        __syncthreads();
#pragma unroll
        for (int i = 0; i < 8; ++i) { const int kk = (tid >> 6) + 8 * i; float v = 0.f; if (sc >= 0) { v = src[(size_t)(k0 + kk) * nsrc + sc]; if (rs) v *= rs[k0 + kk]; } tile[kk * 65 + nn] = v; }
        __syncthreads();
        const int on = tid >> 3, ok = (tid & 7) * 8;
        float v[8];
#pragma unroll
        for (int i = 0; i < 8; ++i) v[i] = tile[(ok + i) * 65 + on];
        u32x4 w = {cvt_pk_bf16(v[0], v[1]), cvt_pk_bf16(v[2], v[3]), cvt_pk_bf16(v[4], v[5]), cvt_pk_bf16(v[6], v[7])};
        *(u32x4*)(dst + (size_t)(n0 + on) * K + k0 + ok) = w;
    }
}
__device__ __forceinline__ void phase_prep(const __attribute__((address_space(4))) Params* pp, unsigned char* lds, int wv) {
    float* tile = (float*)lds;
    struct { const float* x; const int* pos; const float* gla_w_in; const float* gla_w_out; const float* mla_w_in; const float* mla_qn_g; const float* mla_kvn_g; const float* mla_w_uq; const float* mla_w_ukv; const float* mla_w_out; unsigned char* ws; } p;
    p.x = pp->x; p.pos = pp->pos; p.gla_w_in = pp->gla_w_in; p.gla_w_out = pp->gla_w_out; p.mla_w_in = pp->mla_w_in; p.mla_qn_g = pp->mla_qn_g; p.mla_kvn_g = pp->mla_kvn_g; p.mla_w_uq = pp->mla_w_uq; p.mla_w_ukv = pp->mla_w_ukv; p.mla_w_out = pp->mla_w_out; p.ws = pp->ws;
    unsigned char* ws = p.ws;
    const size_t gtid = (size_t)blockIdx.x * 512 + opaque_tid(wv), gsz = (size_t)gridDim.x * 512;
    for (size_t i = gtid; i < (size_t)T * DM / 8; i += gsz) {
        const f32x4 a = *(const f32x4*)(p.x + i * 8), b = *(const f32x4*)(p.x + i * 8 + 4);
        u32x4 w = {cvt_pk_bf16(a[0], a[1]), cvt_pk_bf16(a[2], a[3]), cvt_pk_bf16(b[0], b[1]), cvt_pk_bf16(b[2], b[3])};
        *(u32x4*)(ws + WS_XB + i * 16) = w;
    }
    for (size_t i = gtid; i < (size_t)(MiB / 16); i += gsz) *(u32x4*)(ws + WS_RQ + i * 16) = (u32x4){0u, 0u, 0u, 0u};
    for (size_t i = gtid; i < (size_t)T * 32; i += gsz) {
        const int tok = (int)(i >> 5), f = (int)(i & 31);
        const float inv = 1.0f / powf(10000.0f, (float)(2 * f) / 64.0f);
        const float ang = (float)p.pos[tok] * inv;
        ((float*)(ws + WS_COS))[i] = cosf(ang); ((float*)(ws + WS_SIN))[i] = sinf(ang);
    }
    for (int j = 0; j < 2; ++j) {
        transpose_job(p.gla_w_in + (size_t)j * 1024 * 5152, (bf16_t*)(ws + W_GIN + j * W_GIN_SZ), 1024, 5152, GLA_NPAD, MAP_ID, nullptr, tile, wv);
        transpose_job(p.gla_w_out + (size_t)j * 2048 * 1024, (bf16_t*)(ws + W_GOUT + j * W_OUT_SZ), 2048, 1024, 1024, MAP_ID, nullptr, tile, wv);
        transpose_job(p.mla_w_in + (size_t)j * 1024 * 2752, (bf16_t*)(ws + W_MIN + j * W_MIN_SZ), 1024, 2752, MLA_NPAD, MAP_MLAIN, nullptr, tile, wv);
        transpose_job(p.mla_w_uq + (size_t)j * 384 * 3072, (bf16_t*)(ws + W_MUQ + j * W_MUQ_SZ), 384, 3072, 3072, MAP_UQ, p.mla_qn_g + j * 384, tile, wv);
        transpose_job(p.mla_w_ukv + (size_t)j * 256 * 4096, (bf16_t*)(ws + W_MUKV + j * W_MUKV_SZ), 256, 4096, 4096, MAP_UKV, p.mla_kvn_g + j * 256, tile, wv);
        transpose_job(p.mla_w_out + (size_t)j * 2048 * 1024, (bf16_t*)(ws + W_MOUT + j * W_OUT_SZ), 2048, 1024, 1024, MAP_ID, nullptr, tile, wv);
    }
    __syncthreads();
}

__device__ __forceinline__ void phase_ln(float* xres, bf16_t* xb, f32x2* stats, const float* g, const float* b, int wv, bool nowrite, bool final_) {
    const int tid = opaque_tid(wv); const int lane = tid & 63, gw = blockIdx.x * 8 + (tid >> 6), nw = gridDim.x * 8;
    f32x4 gv[4], bv[4];
#pragma unroll
    for (int i = 0; i < 4; ++i) { gv[i] = *(const f32x4*)(g + i * 256 + lane * 4); bv[i] = *(const f32x4*)(b + i * 256 + lane * 4); }
    for (int row0 = gw; row0 < T; row0 += 4 * nw) {
        f32x4 v[4][4];
#pragma unroll
        for (int u = 0; u < 4; ++u) { const float* rp = xres + (size_t)(row0 + u * nw) * 1024;
#pragma unroll
            for (int i = 0; i < 4; ++i) v[u][i] = *(const f32x4*)(rp + i * 256 + lane * 4); }
#pragma unroll
        for (int u = 0; u < 4; ++u) {
            const int row = row0 + u * nw; float* rp = xres + (size_t)row * 1024;
            float s = 0.f;
#pragma unroll
            for (int i = 0; i < 4; ++i) s += v[u][i][0] + v[u][i][1] + v[u][i][2] + v[u][i][3];
            const float mu = wave_sum(s) * (1.f / 1024.f);
            float q = 0.f;
#pragma unroll
            for (int i = 0; i < 4; ++i) { v[u][i] = v[u][i] - mu; q += v[u][i][0] * v[u][i][0] + v[u][i][1] * v[u][i][1] + v[u][i][2] * v[u][i][2] + v[u][i][3] * v[u][i][3]; }
            const float rstd = rsqrtf(wave_sum(q) * (1.f / 1024.f) + EPS);
            if (!final_ && lane == 0 && !nowrite) stats[row] = (f32x2){mu, rstd};
#pragma unroll
            for (int i = 0; i < 4; ++i) { const f32x4 y = v[u][i] * rstd * gv[i] + bv[i]; if (!nowrite) { if (final_) *(f32x4*)(rp + i * 256 + lane * 4) = y;
                else { u32x2 w = {cvt_pk_bf16(y[0], y[1]), cvt_pk_bf16(y[2], y[3])}; *(u32x2*)(xb + (size_t)row * 1024 + i * 256 + lane * 4) = w; } } }
        }
    }
}

__device__ __forceinline__ void phase_gla_gate(const bf16_t* O, bf16_t* Z, const float* gn, int wv, bool nowrite) {
    const int tid = opaque_tid(wv); const int lane = tid & 63, h = wv & 3;
    const f32x4 g0 = *(const f32x4*)(gn + h * 512 + lane * 8), g1 = *(const f32x4*)(gn + h * 512 + lane * 8 + 4);
    const int rw = blockIdx.x * 2 + (wv >> 2), nrw = gridDim.x * 2;
    for (int row0 = rw; row0 < T; row0 += 4 * nrw) {
        u32x4 ov[4], zv[4];
#pragma unroll
        for (int u = 0; u < 4; ++u) { const size_t off = (size_t)(row0 + u * nrw) * 2048 + h * 512 + lane * 8; ov[u] = *(const u32x4*)(O + off); zv[u] = *(const u32x4*)(Z + off); }
#pragma unroll
        for (int u = 0; u < 4; ++u) {
            const size_t off = (size_t)(row0 + u * nrw) * 2048 + h * 512 + lane * 8;
            float o[8], z[8];
#pragma unroll
            for (int i = 0; i < 4; ++i) { o[2 * i] = bflo(ov[u][i]); o[2 * i + 1] = bfhi(ov[u][i]); z[2 * i] = bflo(zv[u][i]); z[2 * i + 1] = bfhi(zv[u][i]); }
            float ss = 0.f;
#pragma unroll
            for (int i = 0; i < 8; ++i) ss += o[i] * o[i];
            const float r = rsqrtf(wave_sum(ss) * (1.f / 512.f) + EPS);
            float y[8];
#pragma unroll
            for (int i = 0; i < 8; ++i) y[i] = o[i] * r * (i < 4 ? g0[i] : g1[i - 4]) * silu_f(z[i]);
            u32x4 w = {cvt_pk_bf16(y[0], y[1]), cvt_pk_bf16(y[2], y[3]), cvt_pk_bf16(y[4], y[5]), cvt_pk_bf16(y[6], y[7])};
            if (!nowrite) *(u32x4*)(Z + off) = w;
        }
    }
}

__device__ __forceinline__ void phase_mla_stats(const bf16_t* CQ, const bf16_t* CKV, const float* KRR, bf16_t* KRO, float* RQ, float* RKV, const float* COS, const float* SIN, int wv) {
    const int tid = opaque_tid(wv); const int lane = tid & 63, gw = blockIdx.x * 8 + (tid >> 6), nw = gridDim.x * 8;
    for (int row = gw; row < T; row += nw) {
        float sq = 0.f, sk = 0.f;
        if (lane < 48) { const u32x4 v = *(const u32x4*)(CQ + (size_t)row * 384 + lane * 8);
#pragma unroll
            for (int i = 0; i < 4; ++i) { const float a = bflo(v[i]), b = bfhi(v[i]); sq += a * a + b * b; } }
        if (lane < 32) { const u32x4 v = *(const u32x4*)(CKV + (size_t)row * 256 + lane * 8);
#pragma unroll
            for (int i = 0; i < 4; ++i) { const float a = bflo(v[i]), b = bfhi(v[i]); sk += a * a + b * b; } }
        sq = wave_sum(sq); sk = wave_sum(sk);
        if (lane == 0) { RQ[row] = rsqrtf(sq * (1.f / 384.f) + EPS); RKV[row] = rsqrtf(sk * (1.f / 256.f) + EPS); }
        if (lane < 32) { const float x1 = KRR[(size_t)row * 64 + lane], x2 = KRR[(size_t)row * 64 + 32 + lane];
            const float c = COS[(size_t)row * 32 + lane], s = SIN[(size_t)row * 32 + lane];
            *(unsigned*)(KRO + (size_t)row * 64 + 2 * lane) = cvt_pk_bf16(x1 * c - x2 * s, x2 * c + x1 * s); }
    }
}

namespace att {
constexpr int NW = 8, QBLK = 32, KVBLK = 64;
constexpr int LDQ = 3072, LDK = 2048, LDR = 64, LDZ = 2048;
constexpr float SCALE = 0.07216878364870322f;
constexpr float THR = 8.f;
constexpr int SHM_V = 16384, SHM_K = 16384, SHM_R = 8192;
constexpr int OFF_V = 0, OFF_K = 2 * SHM_V, OFF_R = OFF_K + 2 * SHM_K, OFF_WS = OFF_R + 2 * SHM_R, OFF_QR = OFF_WS + 2048;
#define KSWZ(row, colB) ((row) * 256 + ((colB) ^ (((row) & 7) << 4)))
#define RSWZ(row, colB) ((row) * 128 + ((colB) ^ ((((row) >> 1) & 7) << 4)))
#define SBAR() __builtin_amdgcn_sched_barrier(0)
__device__ __forceinline__ int crow(int r, int hi) { return (r & 3) + 8 * (r >> 2) + 4 * hi; }
__device__ __forceinline__ void partialSM(f32x16& p0, f32x16& p1, float& m_reg, float& mn, float& alpha) {
    constexpr float C = SCALE * 1.4426950408889634f;
    float pmax = p0[0];
#pragma unroll
    for (int r = 1; r < 16; ++r) pmax = fmaxf(pmax, p0[r]);
#pragma unroll
    for (int r = 0; r < 16; ++r) pmax = fmaxf(pmax, p1[r]);
    { auto rr = __builtin_amdgcn_permlane32_swap(__float_as_uint(pmax), __float_as_uint(pmax), false, false);
      pmax = fmaxf(__uint_as_float(rr[0]), __uint_as_float(rr[1])); }
    if (__builtin_expect(__all(pmax - m_reg <= THR / SCALE), 1)) { mn = m_reg; alpha = 1.f; }
    else { mn = fmaxf(m_reg, pmax); alpha = __builtin_amdgcn_exp2f((m_reg - mn) * C); m_reg = mn; }
    const float mnC = -mn * C;
#pragma unroll
    for (int r = 0; r < 16; ++r) p0[r] = fmaf(p0[r], C, mnC);
#pragma unroll
    for (int r = 0; r < 16; ++r) p1[r] = fmaf(p1[r], C, mnC);
#pragma unroll
    for (int r = 0; r < 16; ++r) p0[r] = __builtin_amdgcn_exp2f(p0[r]);
}
__device__ __forceinline__ void finishSM(f32x16& p0, f32x16& p1, float alpha, float& l_reg, bf16x8& pa0, bf16x8& pa1, bf16x8& pa2, bf16x8& pa3) {
#pragma unroll
    for (int r = 0; r < 16; ++r) p1[r] = __builtin_amdgcn_exp2f(p1[r]);
    float ps = 0;
#pragma unroll
    for (int r = 0; r < 16; ++r) ps += p0[r];
#pragma unroll
    for (int r = 0; r < 16; ++r) ps += p1[r];
    { auto rr = __builtin_amdgcn_permlane32_swap(__float_as_uint(ps), __float_as_uint(ps), false, false);
      ps = __uint_as_float(rr[0]) + __uint_as_float(rr[1]); }
    l_reg = l_reg * alpha + ps;
#define PK4(P, BASE, OUT) do { unsigned a0 = cvt_pk_bf16(P[BASE + 0], P[BASE + 1]), a1 = cvt_pk_bf16(P[BASE + 2], P[BASE + 3]);   \
    unsigned b0 = cvt_pk_bf16(P[BASE + 4], P[BASE + 5]), b1 = cvt_pk_bf16(P[BASE + 6], P[BASE + 7]);                              \
    auto r0 = __builtin_amdgcn_permlane32_swap(a0, b0, false, false); auto r1 = __builtin_amdgcn_permlane32_swap(a1, b1, false, false); \
    u32x4 w = {r0[0], r1[0], r0[1], r1[1]}; OUT = *reinterpret_cast<bf16x8*>(&w); } while (0)
    PK4(p0, 0, pa0); PK4(p0, 8, pa1); PK4(p1, 0, pa2); PK4(p1, 8, pa3);
#undef PK4
}
__device__ __forceinline__ void qkt(f32x16& p0, f32x16& p1, const char* Ks, const char* Rs, const bf16x8* qr, const char* Qp, int r32, int hi) {
    p0 = f32x16{}; p1 = f32x16{};
#pragma unroll
    for (int d0 = 0; d0 < 8; ++d0) { const int cb = (d0 * 16 + hi * 8) * 2;
        const bf16x8 b0 = *reinterpret_cast<const bf16x8*>(Ks + KSWZ(r32, cb));
        const bf16x8 b1 = *reinterpret_cast<const bf16x8*>(Ks + KSWZ(32 + r32, cb));
        p0 = __builtin_amdgcn_mfma_f32_32x32x16_bf16(b0, qr[d0], p0, 0, 0, 0);
        p1 = __builtin_amdgcn_mfma_f32_32x32x16_bf16(b1, qr[d0], p1, 0, 0, 0); }
#pragma unroll
    for (int d0 = 0; d0 < 4; ++d0) { const int cb = (d0 * 16 + hi * 8) * 2;
        const bf16x8 b0 = *reinterpret_cast<const bf16x8*>(Rs + RSWZ(r32, cb));
        const bf16x8 b1 = *reinterpret_cast<const bf16x8*>(Rs + RSWZ(32 + r32, cb));
        const bf16x8 qq = *reinterpret_cast<const bf16x8*>(Qp + RSWZ(r32, cb));
        p0 = __builtin_amdgcn_mfma_f32_32x32x16_bf16(b0, qq, p0, 0, 0, 0);
        p1 = __builtin_amdgcn_mfma_f32_32x32x16_bf16(b1, qq, p1, 0, 0, 0); }
}
__device__ __forceinline__ int v_st(int k, int c) { const int kk = (k & ~0xC) | ((k & 4) << 1) | ((k & 8) >> 1); return ((kk >> 3) * 4 + (c >> 5)) * 512 + ((kk & 7) * 32 + (c & 31)) * 2; }
__device__ __forceinline__ int v_rd_base(int lane) { return ((lane & 3) << 3) | (((lane >> 2) & 3) << 6) | (((lane >> 4) & 1) << 5) | (((lane >> 5) & 1) << 8); }
constexpr int v_rd_off(int d0, int ks, int half) { return d0 * 512 + ks * 4096 + half * 2048; }
template <int OFF> __device__ __forceinline__ s16x4 tr_read(int vb) {
    s16x4 r; asm volatile("ds_read_b64_tr_b16 %0, %1 offset:%2" : "=&v"(r) : "v"(vb), "i"(OFF) : "memory"); return r;
}
template <int D0> __device__ __forceinline__ void pv_one(f32x16& od, int vb, bf16x8 pa0, bf16x8 pa1, bf16x8 pa2, bf16x8 pa3) {
    const s16x4 l0 = tr_read<v_rd_off(D0, 0, 0)>(vb), h0 = tr_read<v_rd_off(D0, 0, 1)>(vb), l1 = tr_read<v_rd_off(D0, 1, 0)>(vb), h1 = tr_read<v_rd_off(D0, 1, 1)>(vb);
    const s16x4 l2 = tr_read<v_rd_off(D0, 2, 0)>(vb), h2 = tr_read<v_rd_off(D0, 2, 1)>(vb), l3 = tr_read<v_rd_off(D0, 3, 0)>(vb), h3 = tr_read<v_rd_off(D0, 3, 1)>(vb);
    asm volatile("s_waitcnt lgkmcnt(0)" ::: "memory"); SBAR();
#define PK(L, H) (bf16x8){L[0], L[1], L[2], L[3], H[0], H[1], H[2], H[3]}
    od = __builtin_amdgcn_mfma_f32_32x32x16_bf16(pa0, PK(l0, h0), od, 0, 0, 0);
    od = __builtin_amdgcn_mfma_f32_32x32x16_bf16(pa1, PK(l1, h1), od, 0, 0, 0);
    od = __builtin_amdgcn_mfma_f32_32x32x16_bf16(pa2, PK(l2, h2), od, 0, 0, 0);
    od = __builtin_amdgcn_mfma_f32_32x32x16_bf16(pa3, PK(l3, h3), od, 0, 0, 0);
#undef PK
}
__device__ __forceinline__ void pv_d0(f32x16* o, int vb, bf16x8 pa0, bf16x8 pa1, bf16x8 pa2, bf16x8 pa3) {
    pv_one<0>(o[0], vb, pa0, pa1, pa2, pa3); pv_one<1>(o[1], vb, pa0, pa1, pa2, pa3); pv_one<2>(o[2], vb, pa0, pa1, pa2, pa3); pv_one<3>(o[3], vb, pa0, pa1, pa2, pa3);
}
__device__ __forceinline__ void attn_body(const bf16_t* __restrict__ Qb, const bf16_t* __restrict__ Kh, const bf16_t* __restrict__ Vh, const bf16_t* __restrict__ Rh,
                                          bf16_t* __restrict__ Zb, int seq, char* lds, int wv, bool nowrite) {
    const int tid = opaque_tid(wv), wid = wv, lane = tid & 63, r32 = lane & 31, hi = lane >> 5;
    char* V_lds = lds + OFF_V; char* K_lds = lds + OFF_K; char* R_lds = lds + OFF_R;
    float* ws = (float*)(lds + OFF_WS) + wid * 64; float* li_l = ws; float* al_l = ws + 32;
    float m_reg = -1e30f, l_reg = 0; f32x16 o[4] = {}; bf16x8 qr[8];
    const bf16_t* Qw = Qb + (long)(wid * QBLK + r32) * LDQ + hi * 8;
    char* Qp = lds + OFF_QR + wid * 4096;
#pragma unroll
    for (int d0 = 0; d0 < 8; ++d0) qr[d0] = *reinterpret_cast<const bf16x8*>(Qw + d0 * 16);
#pragma unroll
    for (int d0 = 0; d0 < 4; ++d0) *reinterpret_cast<bf16x8*>(Qp + RSWZ(r32, (d0 * 16 + hi * 8) * 2)) = *reinterpret_cast<const bf16x8*>(Qw + 128 + d0 * 16);
    const int sr = tid >> 4, sc = (tid & 15) * 8, vst0 = v_st(sr, sc), vst1 = v_st(32 + sr, sc);
    const int rr = tid >> 3, rc = (tid & 7) * 8;
    const int vb0 = (int)(uintptr_t)(LAS char*)V_lds + v_rd_base(lane);
    bf16x8 vs0, vs1, ks0, ks1, rs0;
#define SLOAD(k0) do { vs0 = *reinterpret_cast<const bf16x8*>(&Vh[(long)((k0) + sr) * LDK + sc]); vs1 = *reinterpret_cast<const bf16x8*>(&Vh[(long)((k0) + 32 + sr) * LDK + sc]); \
    ks0 = *reinterpret_cast<const bf16x8*>(&Kh[(long)((k0) + sr) * LDK + sc]); ks1 = *reinterpret_cast<const bf16x8*>(&Kh[(long)((k0) + 32 + sr) * LDK + sc]); \
    rs0 = *reinterpret_cast<const bf16x8*>(&Rh[(long)((k0) + rr) * LDR + rc]); } while (0)
#define SWRITE(b) do { *(bf16x8*)(V_lds + (b) * SHM_V + vst0) = vs0; *(bf16x8*)(V_lds + (b) * SHM_V + vst1) = vs1; const int kc = sc * 2; \
    *(bf16x8*)(K_lds + (b) * SHM_K + KSWZ(sr, kc)) = ks0; *(bf16x8*)(K_lds + (b) * SHM_K + KSWZ(32 + sr, kc)) = ks1; \
    *(bf16x8*)(R_lds + (b) * SHM_R + RSWZ(rr, rc * 2)) = rs0; } while (0)
#define SWAIT() asm volatile("s_waitcnt vmcnt(0)" ::: "memory")
#define RESC(a) do { if (__any((a) < 1.f)) { if (hi == 0) al_l[r32] = (a); asm volatile("s_waitcnt lgkmcnt(0)" ::: "memory"); \
    _Pragma("unroll") for (int d = 0; d < 4; ++d) _Pragma("unroll") for (int r = 0; r < 16; ++r) o[d][r] *= al_l[crow(r, hi)]; } } while (0)
    f32x16 pA0, pA1, pB0, pB1; float mnA, mnB, alA, alB; bf16x8 pa0, pa1, pa2, pa3; const int NT = seq / KVBLK;
    SLOAD(0); SWAIT(); SWRITE(0); __syncthreads();
    qkt(pA0, pA1, K_lds, R_lds, qr, Qp, r32, hi); partialSM(pA0, pA1, m_reg, mnA, alA);
    SLOAD(KVBLK);
    SWAIT(); SWRITE(1); __syncthreads();
    for (int j = 1; j + 1 < NT; j += 2) {
        SBAR(); qkt(pB0, pB1, K_lds + SHM_K, R_lds + SHM_R, qr, Qp, r32, hi);
        finishSM(pA0, pA1, alA, l_reg, pa0, pa1, pa2, pa3); SBAR();
        SLOAD((j + 1) * KVBLK); SBAR();
        pv_d0(o, vb0, pa0, pa1, pa2, pa3); partialSM(pB0, pB1, m_reg, mnB, alB);
        __syncthreads(); SWAIT(); SWRITE(0);
        RESC(alB); __syncthreads();
        SBAR(); qkt(pA0, pA1, K_lds, R_lds, qr, Qp, r32, hi);
        finishSM(pB0, pB1, alB, l_reg, pa0, pa1, pa2, pa3); SBAR();
        SLOAD((j + 2) * KVBLK); SBAR();
        pv_d0(o, vb0 + SHM_V, pa0, pa1, pa2, pa3); partialSM(pA0, pA1, m_reg, mnA, alA);
        __syncthreads(); SWAIT(); SWRITE(1);
        RESC(alA); __syncthreads();
    }
    SBAR(); qkt(pB0, pB1, K_lds + SHM_K, R_lds + SHM_R, qr, Qp, r32, hi);
    finishSM(pA0, pA1, alA, l_reg, pa0, pa1, pa2, pa3); SBAR();
    pv_d0(o, vb0, pa0, pa1, pa2, pa3); partialSM(pB0, pB1, m_reg, mnB, alB);
    __syncthreads(); RESC(alB);
    finishSM(pB0, pB1, alB, l_reg, pa0, pa1, pa2, pa3); SBAR();
    pv_d0(o, vb0 + SHM_V, pa0, pa1, pa2, pa3);
    if (hi == 0) li_l[r32] = l_reg; asm volatile("s_waitcnt lgkmcnt(0)" ::: "memory");
    float rli[16];
#pragma unroll
    for (int r = 0; r < 16; ++r) rli[r] = __builtin_amdgcn_rcpf(li_l[crow(r, hi)]);
    bf16_t* Zw = Zb + (long)(wid * QBLK + 4 * hi) * LDZ + r32;
    unsigned short zq[16][4];
#pragma unroll
    for (int r = 0; r < 16; ++r)
#pragma unroll
        for (int d0 = 0; d0 < 4; ++d0) zq[r][d0] = Zw[(long)((r & 3) + 8 * (r >> 2)) * LDZ + d0 * 32];
    asm volatile("s_waitcnt vmcnt(0)" ::: "memory"); SBAR();
#pragma unroll
    for (int r = 0; r < 16; ++r) {
#pragma unroll
        for (int d0 = 0; d0 < 4; ++d0) { const float z = bf2f(zq[r][d0]);
            if (!nowrite) Zw[(long)((r & 3) + 8 * (r >> 2)) * LDZ + d0 * 32] = (bf16_t)(cvt_pk_bf16(o[d0][r] * rli[r] * silu_f(z), 0.f) & 0xffffu); } }
    __syncthreads();
#undef SLOAD
#undef SWRITE
#undef SWAIT
#undef RESC
}
__device__ __forceinline__ void phase_attn(const bf16_t* QH, const bf16_t* KNH, const bf16_t* VH, const bf16_t* KRO, bf16_t* Z, int half, char* lds, int wv, bool nowrite) {
    const int c = blockIdx.x, G = gridDim.x;
    const int per = 2048 / G;
    for (int i = 0; i < per; ++i) {
        int bh, qb;
        if (G == 256) { const int xcd = c & 7, slot = c >> 3; bh = i * 32 + xcd * 4 + (slot >> 3); qb = slot & 7; }
        else { const int u = i * G + c; bh = u >> 3; qb = u & 7; }
        const int bl = bh >> 4, h = bh & 15;
        const size_t lrow = (size_t)bl * SEQ, grow = (size_t)half * TH + lrow;
        attn_body(QH + (lrow + qb * 256) * LDQ + h * 192, KNH + lrow * LDK + h * 128, VH + lrow * LDK + h * 128, KRO + grow * 64,
                  Z + (grow + qb * 256) * LDZ + h * 128, SEQ, lds, wv, nowrite);
    }
}
}

#ifndef SC_MASK
#define SC_MASK 0xFFFF
#endif
#define SCB(i) do { if (SC_MASK & (1 << (i))) __builtin_amdgcn_sched_barrier(0); } while (0)
namespace scan {
constexpr int QE_ST = 272, KE_ST = 320, P_ST = 144, V_ST = 576, BC_ST = 528;
constexpr int OFF_QE = 0, OFF_KE = OFF_QE + 64 * QE_ST, OFF_P = OFF_KE + 64 * KE_ST, OFF_V = OFF_P + 64 * P_ST, OFF_BC = OFF_V + 64 * V_ST,
              OFF_GLR = OFF_BC + 64 * BC_ST, OFF_PART = OFF_GLR + 4096, OFF_EBT = OFF_PART + 2048, OFF_WG = OFF_EBT + 512, OFF_SSQW = OFF_WG + 8192, OFF_RN = OFF_SSQW + 2048, OFF_G = OFF_RN + 256, OFF_END = OFF_G + 1024;
static_assert(OFF_END <= LDS_BYTES, "scan LDS");
template <int OFF> __device__ __forceinline__ s16x4 tr_read(int vb) {
    s16x4 r; asm volatile("ds_read_b64_tr_b16 %0, %1 offset:%2" : "=&v"(r) : "v"(vb), "i"(OFF) : "memory"); return r;
}
#define PK8(L, H) (bf16x8){L[0], L[1], L[2], L[3], H[0], H[1], H[2], H[3]}
#define LAUNDER(t) const int t = opaque_tid(wv)
__device__ __forceinline__ void phase_scan(const bf16_t* QK, const bf16_t* V, const float* GLR, bf16_t* OFW, const float* wgate, const float* bgate, char* lds, int wv,
                                           bf16_t* Z, const float* gn, unsigned long long* X, unsigned tag) {
    const int wid = wv;
    if (wv >= 4) __builtin_amdgcn_s_setprio(1);
    for (int item = blockIdx.x; item < 256; item += gridDim.x) {
        const int b = item >> 3, h = (item >> 1) & 3, vh = item & 1;
        __syncthreads();
        { LAUNDER(t); if (t < 256) *(float*)(lds + OFF_G + t * 4) = gn[h * 512 + vh * 256 + t]; }
        for (int dir = 0; dir < 2; ++dir) {
            __syncthreads();
            float bgv; float wgb[8];
            { LAUNDER(t); const int ln = t & 63, r32_ = ln & 31, hi_ = ln >> 5, db_ = wid & 3;
#pragma unroll
              for (int kk = 0; kk < 8; ++kk) wgb[kk] = wgate[((size_t)dir * 16 + 2 * kk + hi_) * 512 + h * 128 + db_ * 32 + r32_];
              bgv = bgate[(size_t)dir * 512 + h * 128 + db_ * 32 + r32_]; }
            f32x16 S[4];
#pragma unroll
            for (int i = 0; i < 4; ++i) S[i] = f32x16{};
            bf16x8 rq[2], rk[2], rv[4]; f32x2 rg;
#define CLOAD_QK(n) do { LAUNDER(t_); const unsigned qo_ = (unsigned)((t_ >> 4) * 1024 + (t_ & 15) * 8) * 2u; const size_t t0_ = (size_t)b * SEQ + (size_t)(n) * 64; const char* qb_ = (const char*)QK + (t0_ * 1024 + h * 128) * 2; \
    rq[0] = *(const bf16x8*)(qb_ + qo_); rq[1] = *(const bf16x8*)(qb_ + 65536 + qo_); rk[0] = *(const bf16x8*)(qb_ + 1024 + qo_); rk[1] = *(const bf16x8*)(qb_ + 1024 + 65536 + qo_); } while (0)
#define CLOAD_VG(n) do { LAUNDER(t_); const unsigned vo_ = (unsigned)((t_ >> 5) * 2048 + (t_ & 31) * 8) * 2u, go_ = (unsigned)((t_ >> 3) * 32 + (t_ & 7) * 2) * 4u; const size_t t0_ = (size_t)b * SEQ + (size_t)(n) * 64; \
    const char* vb_ = (const char*)V + (t0_ * 2048 + h * 512 + vh * 256) * 2; const char* gb_ = (const char*)GLR + (t0_ * 32 + dir * 16) * 4; \
    _Pragma("unroll") for (int i = 0; i < 4; ++i) rv[i] = *(const bf16x8*)(vb_ + (size_t)i * 65536 + vo_); \
    rg = *(const f32x2*)(gb_ + go_); } while (0)
            CLOAD_QK(dir == 0 ? 0 : 31); CLOAD_VG(dir == 0 ? 0 : 31);
#define LBAR() do { asm volatile("s_waitcnt lgkmcnt(0)" ::: "memory"); __builtin_amdgcn_s_barrier(); asm volatile("" ::: "memory"); } while (0)
#define STAGE_VG() do { LAUNDER(t_); const int vr = t_ >> 5, vc = (t_ & 31) * 8, gr = t_ >> 3, gc = (t_ & 7) * 2; \
    _Pragma("unroll") for (int i = 0; i < 4; ++i) *(bf16x8*)(lds + OFF_V + (vr + 16 * i) * V_ST + vc * 2) = rv[i]; \
    *(f32x2*)(lds + OFF_GLR + gr * 64 + gc * 4) = rg; } while (0)
#define XSLOT(nc, half_) (X + ((((size_t)(b * 4 + h) * 32 + (nc)) * 2 + (half_)) * 64))
#define GN_PUBLISH(nc) do { if (wid == 0) { LAUNDER(t_); const int ln_ = t_ & 63; float own_ = 0.f; \
    _Pragma("unroll") for (int w_ = 0; w_ < 8; ++w_) own_ += *(const float*)(lds + OFF_SSQW + (w_ * 64 + ln_) * 4); hown = own_; \
    const unsigned long long g_ = ((unsigned long long)tag << 32) | (unsigned long long)__float_as_uint(own_); \
    __hip_atomic_store(XSLOT(nc, vh) + ln_, g_, __ATOMIC_RELAXED, __HIP_MEMORY_SCOPE_AGENT); } } while (0)
#define GN_POLL(nc) do { if (wid == 0) { LAUNDER(t_); const int ln_ = t_ & 63; unsigned long long g_ = 0ull; unsigned sp_ = 0u; \
    for (;;) { g_ = __hip_atomic_load(XSLOT(nc, vh ^ 1) + ln_, __ATOMIC_RELAXED, __HIP_MEMORY_SCOPE_AGENT); if ((unsigned)(g_ >> 32) == tag || ++sp_ > (1u << 22)) break; __builtin_amdgcn_s_sleep(1); } \
    const float tot_ = hown + __uint_as_float((unsigned)g_); *(float*)(lds + OFF_RN + ln_ * 4) = rsqrtf(tot_ * (1.f / 512.f) + EPS); } } while (0)
#define GN_FINAL(nc) do { LAUNDER(t_); const int ln_ = t_ & 63; const float r_ = *(const float*)(lds + OFF_RN + ln_ * 4); \
    bf16_t* zr_ = Z + ((size_t)b * SEQ + (size_t)(nc) * 64 + ln_) * 2048 + h * 512 + vh * 256 + wid * 32; \
    _Pragma("unroll") for (int j_ = 0; j_ < 4; ++j_) { const f32x4 g0_ = *(const f32x4*)(lds + OFF_G + (wid * 32 + j_ * 8) * 4), g1_ = *(const f32x4*)(lds + OFF_G + (wid * 32 + j_ * 8 + 4) * 4); \
        const f32x4 a_ = hs[2 * j_], c_ = hs[2 * j_ + 1]; const u32x4 z_ = hz[j_]; \
        u32x4 w_ = {cvt_pk_bf16(a_[0] * r_ * g0_[0] * silu_fast(bflo(z_[0])), a_[1] * r_ * g0_[1] * silu_fast(bfhi(z_[0]))), cvt_pk_bf16(a_[2] * r_ * g0_[2] * silu_fast(bflo(z_[1])), a_[3] * r_ * g0_[3] * silu_fast(bfhi(z_[1]))), \
                    cvt_pk_bf16(c_[0] * r_ * g1_[0] * silu_fast(bflo(z_[2])), c_[1] * r_ * g1_[1] * silu_fast(bfhi(z_[2]))), cvt_pk_bf16(c_[2] * r_ * g1_[2] * silu_fast(bflo(z_[3])), c_[3] * r_ * g1_[3] * silu_fast(bfhi(z_[3])))}; \
        *(u32x4*)(zr_ + j_ * 8) = w_; __builtin_amdgcn_sched_barrier(0); } } while (0)
            STAGE_VG();
            CLOAD_VG(dir == 0 ? 1 : 30);
            LBAR();
            for (int step = 0; step < 32; ++step) {
                const int n = dir == 0 ? step : 31 - step;
                const size_t t0 = (size_t)b * SEQ + (size_t)n * 64;
                {
                    LAUNDER(t); const int ln = t & 63, r32 = ln & 31, hi = ln >> 5, cb = wid >> 2, db = wid & 3, d = db * 32 + r32;
                    f32x4 ar[4];
#pragma unroll
                    for (int i = 0; i < 4; ++i) ar[i] = *(const f32x4*)(lds + OFF_GLR + (cb * 32 + r32) * 64 + i * 16);
                    asm volatile("s_waitcnt lgkmcnt(0)" ::: "memory"); __builtin_amdgcn_sched_barrier(0);
                    f32x16 pa;
#pragma unroll
                    for (int r = 0; r < 16; ++r) pa[r] = bgv;
#pragma unroll
                    for (int kk = 0; kk < 8; ++kk) { const float a = hi ? ar[kk >> 1][2 * (kk & 1) + 1] : ar[kk >> 1][2 * (kk & 1)];
                        pa = __builtin_amdgcn_mfma_f32_32x32x2f32(a, wgb[kk], pa, 0, 0, 0); }
                    float lgv[16], pl[16];
#pragma unroll
                    for (int r = 0; r < 16; ++r) { const float pre = pa[r]; lgv[r] = -(fmaxf(-pre, 0.f) + __logf(1.f + __expf(-fabsf(pre)))) * (0.0625f * 1.4426950408889634f); }
#pragma unroll
                    for (int k = 0; k < 4; ++k) { pl[4 * k] = lgv[4 * k]; pl[4 * k + 1] = pl[4 * k] + lgv[4 * k + 1]; pl[4 * k + 2] = pl[4 * k + 1] + lgv[4 * k + 2]; pl[4 * k + 3] = pl[4 * k + 2] + lgv[4 * k + 3]; }
#pragma unroll
                    for (int k = 0; k < 4; ++k) *(float*)(lds + OFF_P + ((cb * 8 + 2 * k + hi) * 128 + d) * 4) = pl[4 * k + 3];
                    LBAR();
                    float gsv[16];
#pragma unroll
                    for (int g = 0; g < 16; ++g) gsv[g] = *(const float*)(lds + OFF_P + (g * 128 + d) * 4);
                    asm volatile("s_waitcnt lgkmcnt(0)" ::: "memory"); __builtin_amdgcn_sched_barrier(0);
                    float ex[16]; float run = 0.f;
#pragma unroll
                    for (int g = 0; g < 16; ++g) { ex[g] = run; run += gsv[g]; }
                    const float tot = run;
#pragma unroll
                    for (int k = 0; k < 4; ++k) { const float e0 = cb ? ex[8 + 2 * k] : ex[2 * k], e1 = cb ? ex[8 + 2 * k + 1] : ex[2 * k + 1]; const float off = hi ? e1 : e0;
#pragma unroll
                        for (int e = 0; e < 4; ++e) { const int r = 4 * k + e; const float bc = dir == 0 ? off + pl[r] : tot - (off + pl[r] - lgv[r]);
                            *(float*)(lds + OFF_BC + (cb * 32 + e + 8 * k + 4 * hi) * BC_ST + d * 4) = bc; } }
                    if (cb == 0 && hi == 0) *(float*)(lds + OFF_EBT + d * 4) = __builtin_amdgcn_exp2f(tot);
                }
                LBAR();
                { LAUNDER(t); const int sr = t >> 4, sc = (t & 15) * 8;
#pragma unroll
                  for (int i = 0; i < 2; ++i) { const int row = sr + 32 * i;
                    const f32x4 b0 = *(const f32x4*)(lds + OFF_BC + row * BC_ST + sc * 4), b1 = *(const f32x4*)(lds + OFF_BC + row * BC_ST + sc * 4 + 16);
                    const bf16x8 qv = rq[i], kv = rk[i];
                    float qf[8], kf[8];
#pragma unroll
                    for (int e = 0; e < 8; ++e) { const float bb = e < 4 ? b0[e] : b1[e - 4]; const float eb = __builtin_amdgcn_exp2f(bb), ei = __builtin_amdgcn_exp2f(-bb);
                        qf[e] = bf2f((unsigned short)qv[e]) * eb; kf[e] = bf2f((unsigned short)kv[e]) * ei; }
                    u32x4 qw = {cvt_pk_bf16(qf[0], qf[1]), cvt_pk_bf16(qf[2], qf[3]), cvt_pk_bf16(qf[4], qf[5]), cvt_pk_bf16(qf[6], qf[7])};
                    u32x4 kw = {cvt_pk_bf16(kf[0], kf[1]), cvt_pk_bf16(kf[2], kf[3]), cvt_pk_bf16(kf[4], kf[5]), cvt_pk_bf16(kf[6], kf[7])};
                    *(u32x4*)(lds + OFF_QE + row * QE_ST + sc * 2) = qw; *(u32x4*)(lds + OFF_KE + row * KE_ST + sc * 2) = kw; } }
                if (step + 1 < 32) { const int nn = dir == 0 ? step + 1 : 30 - step; CLOAD_QK(nn); }
                u32x4 pf[4];
                bf16_t* orow;
                { LAUNDER(t); const int ln = t & 63; orow = OFW + ((((size_t)item * 32 + n) * 8 + wid) * 256 + ln) * 8; }
                if (dir == 1) {
#pragma unroll
                    for (int j = 0; j < 4; ++j) pf[j] = *(const u32x4*)(orow + j * 512);
                }
                LBAR();
                { LAUNDER(t); const int fr = t & 15, fq = (t >> 4) & 3;
#pragma unroll
                  for (int tt = 0; tt < 2; ++tt) { const int tl = wid * 2 + tt, it = tl >> 2, jt = tl & 3;
                    f32x4 pc = {0.f, 0.f, 0.f, 0.f};
                    bf16x8 af[4], bfg[4];
#pragma unroll
                    for (int ks = 0; ks < 4; ++ks) {
                        af[ks] = *(const bf16x8*)(lds + OFF_KE + (jt * 16 + fr) * KE_ST + (ks * 32 + fq * 8) * 2);
                        bfg[ks] = *(const bf16x8*)(lds + OFF_QE + (it * 16 + fr) * QE_ST + (ks * 32 + fq * 8) * 2); }
                    asm volatile("s_waitcnt lgkmcnt(0)" ::: "memory"); SCB(1);
#pragma unroll
                    for (int ks = 0; ks < 4; ++ks) pc = __builtin_amdgcn_mfma_f32_16x16x32_bf16(af[ks], bfg[ks], pc, 0, 0, 0);
                    const int ii = it * 16 + fr, j0 = jt * 16 + fq * 4;
                    float pm[4];
#pragma unroll
                    for (int e = 0; e < 4; ++e) pm[e] = (dir == 0 ? (j0 + e <= ii) : (j0 + e >= ii)) ? pc[e] : 0.f;
                    u32x2 pw = {cvt_pk_bf16(pm[0], pm[1]), cvt_pk_bf16(pm[2], pm[3])};
                    *(u32x2*)(lds + OFF_P + ii * P_ST + j0 * 2) = pw; } }
                bf16x8 vf[4];
                f32x16 o0 = f32x16{}, o1 = f32x16{};
                {
                    LAUNDER(t); const int ln = t & 63, hi = ln >> 5, r32 = ln & 31, m16 = ln & 15, g16 = (ln >> 4) & 1;
                    const int ldsb = (int)(uintptr_t)(LAS char*)lds;
                    const int trv = ldsb + OFF_V + (8 * hi + (m16 >> 2)) * V_ST + (wid * 32 + 16 * g16 + 4 * (m16 & 3)) * 2;
                    const int trk = ldsb + OFF_KE + (8 * hi + (m16 >> 2)) * KE_ST + (16 * g16 + 4 * (m16 & 3)) * 2;
                    {
                    const s16x4 l0 = tr_read<0 * 16 * V_ST>(trv), h0 = tr_read<0 * 16 * V_ST + 4 * V_ST>(trv), l1 = tr_read<1 * 16 * V_ST>(trv), h1 = tr_read<1 * 16 * V_ST + 4 * V_ST>(trv);
                    const s16x4 l2 = tr_read<2 * 16 * V_ST>(trv), h2 = tr_read<2 * 16 * V_ST + 4 * V_ST>(trv), l3 = tr_read<3 * 16 * V_ST>(trv), h3 = tr_read<3 * 16 * V_ST + 4 * V_ST>(trv);
                    asm volatile("s_waitcnt lgkmcnt(0)" ::: "memory"); SCB(2);
                    vf[0] = PK8(l0, h0); vf[1] = PK8(l1, h1); vf[2] = PK8(l2, h2); vf[3] = PK8(l3, h3);
                    }
                    const char* qa = lds + OFF_QE + r32 * QE_ST + 8 * hi;
#pragma unroll
                    for (int db = 0; db < 4; ++db) {
                        s16x4 al[2][2], ah[2][2];
#pragma unroll
                        for (int s = 0; s < 2; ++s) { const int dcol = (db * 32 + 16 * s) * 2;
                            al[s][0] = *(const s16x4*)(qa + dcol); ah[s][0] = *(const s16x4*)(qa + dcol + 16);
                            al[s][1] = *(const s16x4*)(qa + 32 * QE_ST + dcol); ah[s][1] = *(const s16x4*)(qa + 32 * QE_ST + dcol + 16); }
                        bf16x8 bfr[2];
#pragma unroll
                        for (int s = 0; s < 2; ++s) {
                            u32x4 bw = {cvt_pk_bf16(S[db][8 * s + 0], S[db][8 * s + 1]), cvt_pk_bf16(S[db][8 * s + 2], S[db][8 * s + 3]),
                                        cvt_pk_bf16(S[db][8 * s + 4], S[db][8 * s + 5]), cvt_pk_bf16(S[db][8 * s + 6], S[db][8 * s + 7])};
                            bfr[s] = *reinterpret_cast<bf16x8*>(&bw); }
                        asm volatile("s_waitcnt lgkmcnt(0)" ::: "memory"); SCB(3);
#pragma unroll
                        for (int s = 0; s < 2; ++s) {
                            o0 = __builtin_amdgcn_mfma_f32_32x32x16_bf16(PK8(al[s][0], ah[s][0]), bfr[s], o0, 0, 0, 0);
                            o1 = __builtin_amdgcn_mfma_f32_32x32x16_bf16(PK8(al[s][1], ah[s][1]), bfr[s], o1, 0, 0, 0); }
                    }
                    const char* ebp = lds + OFF_EBT + 16 * hi;
#define SUPD(DB) do { \
    const s16x4 l0 = tr_read<(DB) * 64 + 0 * 16 * KE_ST>(trk), h0 = tr_read<(DB) * 64 + 0 * 16 * KE_ST + 4 * KE_ST>(trk), l1 = tr_read<(DB) * 64 + 1 * 16 * KE_ST>(trk), h1 = tr_read<(DB) * 64 + 1 * 16 * KE_ST + 4 * KE_ST>(trk); \
    const s16x4 l2 = tr_read<(DB) * 64 + 2 * 16 * KE_ST>(trk), h2 = tr_read<(DB) * 64 + 2 * 16 * KE_ST + 4 * KE_ST>(trk), l3 = tr_read<(DB) * 64 + 3 * 16 * KE_ST>(trk), h3 = tr_read<(DB) * 64 + 3 * 16 * KE_ST + 4 * KE_ST>(trk); \
    asm volatile("s_waitcnt lgkmcnt(0)" ::: "memory"); SCB(4); \
    S[DB] = __builtin_amdgcn_mfma_f32_32x32x16_bf16(PK8(l0, h0), vf[0], S[DB], 0, 0, 0); \
    S[DB] = __builtin_amdgcn_mfma_f32_32x32x16_bf16(PK8(l1, h1), vf[1], S[DB], 0, 0, 0); \
    S[DB] = __builtin_amdgcn_mfma_f32_32x32x16_bf16(PK8(l2, h2), vf[2], S[DB], 0, 0, 0); \
    S[DB] = __builtin_amdgcn_mfma_f32_32x32x16_bf16(PK8(l3, h3), vf[3], S[DB], 0, 0, 0); \
    _Pragma("unroll") for (int g = 0; g < 4; ++g) { const f32x4 eb = *(const f32x4*)(ebp + ((DB) * 32 + 8 * g) * 4); \
        S[DB][4 * g + 0] *= eb[0]; S[DB][4 * g + 1] *= eb[1]; S[DB][4 * g + 2] *= eb[2]; S[DB][4 * g + 3] *= eb[3]; } asm volatile("" : "+v"(S[DB])); } while (0)
                    SUPD(0); SUPD(1); SUPD(2); SUPD(3);
#undef SUPD
                }
                LBAR();
                if (step + 1 < 32) { STAGE_VG(); if (step + 2 < 32) { const int nn = dir == 0 ? step + 2 : 29 - step; CLOAD_VG(nn); } }

                {
                    LAUNDER(t); const int ln = t & 63, hi = ln >> 5, r32 = ln & 31;
                    const char* pa = lds + OFF_P + r32 * P_ST + 16 * hi;
                    bf16x8 pa0[4], pa1[4];
#pragma unroll
                    for (int ks = 0; ks < 4; ++ks) { pa0[ks] = *(const bf16x8*)(pa + ks * 32); pa1[ks] = *(const bf16x8*)(pa + 32 * P_ST + ks * 32); }
                    asm volatile("s_waitcnt lgkmcnt(0)" ::: "memory"); SCB(5);
#pragma unroll
                    for (int ks = 0; ks < 4; ++ks) {
                        o0 = __builtin_amdgcn_mfma_f32_32x32x16_bf16(pa0[ks], vf[ks], o0, 0, 0, 0);
                        o1 = __builtin_amdgcn_mfma_f32_32x32x16_bf16(pa1[ks], vf[ks], o1, 0, 0, 0);
                    }
                    if (dir == 0) {
#pragma unroll
                        for (int j = 0; j < 4; ++j) {
                            u32x4 w;
                            if (j < 2) w = (u32x4){cvt_pk_bf16(o0[8 * j + 0], o0[8 * j + 1]), cvt_pk_bf16(o0[8 * j + 2], o0[8 * j + 3]), cvt_pk_bf16(o0[8 * j + 4], o0[8 * j + 5]), cvt_pk_bf16(o0[8 * j + 6], o0[8 * j + 7])};
                            else { const int k = j - 2; w = (u32x4){cvt_pk_bf16(o1[8 * k + 0], o1[8 * k + 1]), cvt_pk_bf16(o1[8 * k + 2], o1[8 * k + 3]), cvt_pk_bf16(o1[8 * k + 4], o1[8 * k + 5]), cvt_pk_bf16(o1[8 * k + 6], o1[8 * k + 7])}; }
                            *(u32x4*)(orow + j * 512) = w;
                        }
                    } else {
#pragma unroll
                        for (int j = 0; j < 2; ++j)
#pragma unroll
                            for (int e = 0; e < 4; ++e) { o0[8 * j + 2 * e] += bflo(pf[j][e]); o0[8 * j + 2 * e + 1] += bfhi(pf[j][e]); o1[8 * j + 2 * e] += bflo(pf[2 + j][e]); o1[8 * j + 2 * e + 1] += bfhi(pf[2 + j][e]); }
                        char* ost = lds + (wid < 4 ? OFF_QE + wid * 8192 : OFF_BC + (wid - 4) * 8192);
#pragma unroll
                        for (int r = 0; r < 16; ++r) { const int ic = (r & 3) + 8 * (r >> 2) + 4 * hi;
                            const int sw = ((((r32 >> 2) ^ (ic & 7)) << 4) | ((r32 & 3) << 2));
                            *(float*)(ost + ic * 128 + sw) = o0[r]; *(float*)(ost + (32 + ic) * 128 + sw) = o1[r]; }
                        asm volatile("s_waitcnt lgkmcnt(0)" ::: "memory"); __builtin_amdgcn_sched_barrier(0);
                        f32x4 oa[4], oc[4];
#pragma unroll
                        for (int j = 0; j < 4; ++j) { oa[j] = *(const f32x4*)(ost + ln * 128 + (((2 * j) ^ (ln & 7)) << 4)); oc[j] = *(const f32x4*)(ost + ln * 128 + (((2 * j + 1) ^ (ln & 7)) << 4)); }
                        asm volatile("s_waitcnt lgkmcnt(0)" ::: "memory"); SCB(6);
                        f32x4 hs[8]; u32x4 hz[4]; float hown = 0.f;
                        float ss = 0.f;
#pragma unroll
                        for (int j = 0; j < 4; ++j) {
                            const f32x4 a = oa[j], c = oc[j];
                            ss += a[0] * a[0] + a[1] * a[1] + a[2] * a[2] + a[3] * a[3] + c[0] * c[0] + c[1] * c[1] + c[2] * c[2] + c[3] * c[3];
                            hs[2 * j] = a; hs[2 * j + 1] = c;
                        }
                        *(float*)(lds + OFF_SSQW + (wid * 64 + ln) * 4) = ss;
                        const bf16_t* zr = Z + (t0 + ln) * 2048 + h * 512 + vh * 256 + wid * 32;
#pragma unroll
                        for (int j = 0; j < 4; ++j) hz[j] = *(const u32x4*)(zr + j * 8);
                        LBAR();
                        GN_PUBLISH(n); GN_POLL(n);
                        LBAR();
                        GN_FINAL(n);
                    }
                }
                if (dir == 0) LBAR();
            }
#undef LBAR
#undef STAGE_VG
#undef XSLOT
#undef GN_PUBLISH
#undef GN_POLL
#undef GN_FINAL
#undef CLOAD_QK
#undef CLOAD_VG
        }
    }
    __builtin_amdgcn_s_setprio(0);
}
#undef LAUNDER
#undef PK8
}


#define XB_TMO      128
#define XB_XCNT(j)  (256  + 64 * (j))
#define XB_XSUB(j)  (1280 + 64 * (j))
#define XB_XGEN(j)  (2304 + 64 * (j))
#define XB_TOP      3328
#define XB_TOPGEN   3392
#define XCD_BAR_WORDS 3456
#define XB_SPIN_CAP (1u << 18)
__device__ __forceinline__ unsigned xb_ld(unsigned* p)              { return __hip_atomic_load(p, __ATOMIC_RELAXED, __HIP_MEMORY_SCOPE_AGENT); }
__device__ __forceinline__ unsigned xb_add(unsigned* p, unsigned v) { return __hip_atomic_fetch_add(p, v, __ATOMIC_RELAXED, __HIP_MEMORY_SCOPE_AGENT); }
__device__ __forceinline__ unsigned xb_xcc_id() { return (unsigned)__builtin_amdgcn_s_getreg((3 << 11) | 20) & 0xFu; }
#define XB_SPIN(cond, bar) do { unsigned _sp = 0; while (cond) { __builtin_amdgcn_s_sleep(1); \
    if ((++_sp & 255u) == 0u) { if (xb_ld(&(bar)[XB_TMO])) break; if (_sp > XB_SPIN_CAP) { atomicAdd(&(bar)[XB_TMO], 1u); break; } } } } while (0)
__device__ __forceinline__ void xcd_barrier_complete(unsigned* bar, unsigned x, unsigned& nloc, unsigned& nx) {
    const unsigned G = gridDim.x;
    unsigned sum, cnt, mine, sp = 0u;
    for (;;) {
        sum = 0u; cnt = 0u; mine = 0u;
#pragma unroll
        for (unsigned j = 0; j < 16; ++j) { const unsigned c = xb_ld(&bar[XB_XCNT(j)]); sum += c; cnt += (c > 0u) ? 1u : 0u; mine = (j == x) ? c : mine; }
        if (sum == G) break;
        __builtin_amdgcn_s_sleep(1);
        if ((++sp & 255u) == 0u) { if (xb_ld(&bar[XB_TMO])) break; if (sp > XB_SPIN_CAP) { atomicAdd(&bar[XB_TMO], 1u); break; } }
    }
    nloc = mine > 0u ? mine : 1u; nx = cnt > 0u ? cnt : 1u;
}
__device__ __forceinline__ void xcd_barrier(unsigned* bar, unsigned x, volatile LAS unsigned* st, int wv) {
    asm volatile("s_waitcnt vmcnt(0)" ::: "memory");
    __syncthreads();
    if (wv == 0 && opaque_lane() == 0) {
        __builtin_amdgcn_s_waitcnt(0);
        unsigned nloc = st[0], nx = st[1];
        if (nloc == 0u) { xcd_barrier_complete(bar, x, nloc, nx); st[0] = nloc; st[1] = nx; }
        const unsigned old = xb_add(&bar[XB_XSUB(x)], 1u);
        const unsigned gen = old / nloc;
        if (old + 1u == (gen + 1u) * nloc) {
            __builtin_amdgcn_fence(__ATOMIC_RELEASE, "agent");
            asm volatile("s_waitcnt vmcnt(0)" ::: "memory");
            const unsigned og = xb_add(&bar[XB_TOP], 1u);
            const unsigned tg = og / nx;
            if (og + 1u == (tg + 1u) * nx) xb_add(&bar[XB_TOPGEN], 1u);
            else XB_SPIN(xb_ld(&bar[XB_TOPGEN]) == tg, bar);
            __builtin_amdgcn_fence(__ATOMIC_ACQUIRE, "agent");
            xb_add(&bar[XB_XGEN(x)], 1u);
            asm volatile("s_waitcnt vmcnt(0)" ::: "memory");
        } else {
            XB_SPIN(xb_ld(&bar[XB_XGEN(x)]) == gen, bar);
            __builtin_amdgcn_fence(__ATOMIC_ACQUIRE, "agent");
            asm volatile("s_waitcnt vmcnt(0)" ::: "memory");
        }
    }
    __syncthreads();
}

constexpr int NPHASE = 23;
#ifndef MK_EN
#define MK_EN 0xFFFF
#endif
#ifndef MK_DUP
#define MK_DUP 0
#endif
#define REPS(bit) for (int rep_ = 0, nrep_ = (MK_DUP & (bit)) ? 2 : 1; rep_ < nrep_; ++rep_)
__global__ void __launch_bounds__(512, 2) mk_fwd(Params p) {
    extern __shared__ __attribute__((aligned(16))) unsigned char lds[];
    LAS unsigned char* lds3 = (LAS unsigned char*)lds;
    typedef const __attribute__((address_space(4))) Params* KP;
    const int wv = __builtin_amdgcn_readfirstlane((int)(threadIdx.x >> 6));
    volatile LAS unsigned* bst = (volatile LAS unsigned*)(lds3 + LDS_ST_OFF);
    if (threadIdx.x == 0) { bst[0] = 0u; bst[1] = 0u; }
    __syncthreads();
    const unsigned bx = xb_xcc_id();
    if (threadIdx.x == 0) (void)xb_add(&((unsigned*)(p.ws + WS_BAR))[XB_XCNT(bx)], 1u);
    const int ph_lo = p.ph_lo, ph_hi = p.ph_hi;
    if (ph_lo == 0) {
        KP pp0 = (KP)__builtin_amdgcn_kernarg_segment_ptr();
        if (MK_EN & 1) REPS(1) phase_prep(pp0, lds, wv);
        if (ph_hi > 1) cg::this_grid().sync();
    }
    const int nrounds = (MK_DUP & 4096) ? 2 : 1;
    for (int ph2 = ph_lo > 1 ? ph_lo : 1; ph2 < ph_hi * nrounds; ++ph2) {
        const int ph = ph2 >= ph_hi ? ph2 - ph_hi : ph2;
        if (ph == 0) { KP pp0 = (KP)__builtin_amdgcn_kernarg_segment_ptr(); phase_prep(pp0, lds, wv); xcd_barrier((unsigned*)(p.ws + WS_BAR), xb_xcc_id(), (volatile LAS unsigned*)(lds3 + LDS_ST_OFF), wv); continue; }
        int q = ph; asm volatile("" : "+s"(q));
        KP pp = (KP)__builtin_amdgcn_kernarg_segment_ptr(); asm volatile("" : "+s"(pp));
        unsigned char* ws = pp->ws;
        const int G = gridDim.x, c = blockIdx.x;
        int kind, L = 0, half = 0;
        if (q == 0) kind = 0;
        else { const int pr = (q - 1) / 11, r = (q - 1) % 11;
            if (r < 4) { L = 2 * pr; kind = r == 0 ? 1 : r == 1 ? 2 : r == 2 ? 4 : 5; } else { L = 2 * pr + 1; const int r2 = r - 4;
                if (r2 == 0) kind = 6; else if (r2 < 5) { half = (r2 - 1) >> 1; kind = 8 + ((r2 - 1) & 1); } else kind = r2 == 5 ? 4 : 5; } }
        const int j = L >> 1;
        float* XRES = pp->out;
        bf16_t* XB = (bf16_t*)(ws + WS_XB);
        if (kind == 1) { pg8::Gemm g{XB, (const bf16_t*)(ws + W_GIN + j * W_GIN_SZ), T, GLA_NPAD, 1024}; pg8::StaticOrder S; S.init(T, GLA_NPAD, G, c);
            pg8::EpiGlaIn E{(bf16_t*)(ws + WS_GQK), (bf16_t*)(ws + WS_GV), (bf16_t*)(ws + WS_GZ), (float*)(ws + WS_GLR)}; if (MK_EN & 2) REPS(2) pg8::gemm_phase(lds3, g, S, E, wv); }
        else if (kind == 2) { if (MK_EN & 4) scan::phase_scan((const bf16_t*)(ws + WS_GQK), (const bf16_t*)(ws + WS_GV), (const float*)(ws + WS_GLR), (bf16_t*)(ws + WS_OFW),
                                                              pp->gla_w_gate + (size_t)j * 2 * 16 * 512, pp->gla_b_gate + (size_t)j * 2 * 512, (char*)lds, wv,
                                                              (bf16_t*)(ws + WS_GZ), pp->gla_gn_g + (size_t)j * 2048, (unsigned long long*)(ws + WS_XCH), (unsigned)(j + 1)); }
        else if (kind == 3) { if (MK_EN & 8) REPS(8) phase_gla_gate((const bf16_t*)(ws + WS_OFW), (bf16_t*)(ws + WS_GZ), pp->gla_gn_g + (size_t)j * 2048, wv, rep_ + 1 < nrep_); }
        else if (kind == 4) { const bool gla = (L & 1) == 0; const float* xin = L == 0 ? pp->x : XRES;
            pg8::Gemm g{(const bf16_t*)(ws + (gla ? WS_GZ : WS_MZ)), (const bf16_t*)(ws + (gla ? W_GOUT : W_MOUT) + j * W_OUT_SZ), T, 1024, 2048}; pg8::StaticOrder S; S.init(T, 1024, G, c);
            if (MK_EN & 16) REPS(16) { pg8::EpiRes E{XRES, xin, L == 0 ? (const f32x2*)nullptr : (const f32x2*)(ws + WS_STATS), pp->ln_g + (L - 1) * 1024, pp->ln_b + (L - 1) * 1024, rep_ + 1 < nrep_}; pg8::gemm_phase(lds3, g, S, E, wv); } }
        else if (kind == 5) { if (MK_EN & 1024) REPS(1024) phase_ln(XRES, XB, (f32x2*)(ws + WS_STATS), pp->ln_g + L * 1024, pp->ln_b + L * 1024, wv, rep_ + 1 < nrep_, L == 3); }
        else if (kind == 6) { pg8::Gemm g{XB, (const bf16_t*)(ws + W_MIN + j * W_MIN_SZ), T, MLA_NPAD, 1024}; pg8::StaticOrder S; S.init(T, MLA_NPAD, G, c);
            pg8::EpiMlaIn E{(bf16_t*)(ws + WS_MZ), (bf16_t*)(ws + WS_CKV), (bf16_t*)(ws + WS_CQ), (bf16_t*)(ws + WS_KRO), (float*)(ws + WS_RQ + (size_t)j * 524288), (float*)(ws + WS_RQ + (size_t)j * 524288 + 262144), (const float*)(ws + WS_COS), (const float*)(ws + WS_SIN)}; if (MK_EN & 32) REPS(32) pg8::gemm_phase(lds3, g, S, E, wv); }
        else if (kind == 7) { if (MK_EN & 64) REPS(64) phase_mla_stats((const bf16_t*)(ws + WS_CQ), (const bf16_t*)(ws + WS_CKV), (const float*)(ws + WS_KRR), (bf16_t*)(ws + WS_KRO), (float*)(ws + WS_RQ), (float*)(ws + WS_RKV),
                                                              (const float*)(ws + WS_COS), (const float*)(ws + WS_SIN), wv); }
        else if (kind == 8) {
            { pg8::Gemm g{(const bf16_t*)(ws + WS_CQ) + (size_t)half * TH * 384, (const bf16_t*)(ws + W_MUQ + j * W_MUQ_SZ), TH, 3072, 384}; pg8::StaticOrder S; S.init(TH, 3072, G, c);
              pg8::EpiQup E{(bf16_t*)(ws + WS_QH), (const float*)(ws + WS_RQ + (size_t)j * 524288), (const float*)(ws + WS_COS), (const float*)(ws + WS_SIN), half * TH}; if (MK_EN & 128) REPS(128) pg8::gemm_phase(lds3, g, S, E, wv); }
            { pg8::Gemm g{(const bf16_t*)(ws + WS_CKV) + (size_t)half * TH * 256, (const bf16_t*)(ws + W_MUKV + j * W_MUKV_SZ), TH, 4096, 256}; pg8::StaticOrder S; S.init(TH, 4096, G, c);
              pg8::EpiKVup E{(bf16_t*)(ws + WS_KNH), (bf16_t*)(ws + WS_VH), (const float*)(ws + WS_RQ + (size_t)j * 524288 + 262144), half * TH}; if (MK_EN & 256) REPS(256) pg8::gemm_phase(lds3, g, S, E, wv); }
        }
        else { if (MK_EN & 512) REPS(512) att::phase_attn((const bf16_t*)(ws + WS_QH), (const bf16_t*)(ws + WS_KNH), (const bf16_t*)(ws + WS_VH), (const bf16_t*)(ws + WS_KRO), (bf16_t*)(ws + WS_MZ), half, (char*)lds, wv, rep_ + 1 < nrep_); }
        if (ph2 + 1 < ph_hi * nrounds) REPS(2048) xcd_barrier((unsigned*)(ws + WS_BAR), xb_xcc_id(), (volatile LAS unsigned*)(lds3 + LDS_ST_OFF), wv);
    }
}

#ifndef MK_MULTI
#define MK_MULTI 0
#endif
extern "C" void kernel_launch(void* const* d_in, const int* in_sizes, int n_in, void* d_out, int out_size, void* d_ws, size_t ws_size, hipStream_t stream) {
    static int grid = 0;
    if (grid == 0) {
        if (n_in != 15 || out_size != T * DM || ws_size < WS_END) { fprintf(stderr, "kernel_launch: unexpected shapes n_in %d out %d ws %zu (need %zu)\n", n_in, out_size, ws_size, (size_t)WS_END); grid = -1; return; }
        if (hipFuncSetAttribute((const void*)mk_fwd, hipFuncAttributeMaxDynamicSharedMemorySize, LDS_BYTES) != hipSuccess) { fprintf(stderr, "kernel_launch: hipFuncSetAttribute failed\n"); grid = -1; return; }
        int dev = 0, cus = 0, per_cu = 0;
        hipGetDevice(&dev); hipDeviceGetAttribute(&cus, hipDeviceAttributeMultiprocessorCount, dev);
        hipOccupancyMaxActiveBlocksPerMultiprocessor(&per_cu, (const void*)mk_fwd, 512, LDS_BYTES);
        if (per_cu < 1) { fprintf(stderr, "kernel_launch: occupancy query says %d blocks per CU\n", per_cu); }
        (void)hipGetLastError();
        grid = cus > 0 ? cus : 256;
    }
    if (grid < 0) return;
    Params p{};
    p.x = (const float*)d_in[0]; p.pos = (const int*)d_in[1]; p.ln_g = (const float*)d_in[2]; p.ln_b = (const float*)d_in[3];
    p.gla_w_in = (const float*)d_in[4]; p.gla_w_gate = (const float*)d_in[5]; p.gla_b_gate = (const float*)d_in[6]; p.gla_gn_g = (const float*)d_in[7]; p.gla_w_out = (const float*)d_in[8];
    p.mla_w_in = (const float*)d_in[9]; p.mla_qn_g = (const float*)d_in[10]; p.mla_kvn_g = (const float*)d_in[11]; p.mla_w_uq = (const float*)d_in[12]; p.mla_w_ukv = (const float*)d_in[13]; p.mla_w_out = (const float*)d_in[14];
    p.out = (float*)d_out; p.ws = (unsigned char*)d_ws;
    if (hipMemsetAsync((char*)d_ws + WS_XCH, 0, 4 * MiB, stream) != hipSuccess) { fprintf(stderr, "kernel_launch: memset failed\n"); return; }
    if (hipMemsetAsync((char*)d_ws + WS_BAR, 0, XCD_BAR_WORDS * 4, stream) != hipSuccess) { fprintf(stderr, "kernel_launch: memset failed\n"); return; }
#if MK_MULTI
    for (int ph = 0; ph < NPHASE; ++ph) {
        p.ph_lo = ph; p.ph_hi = ph + 1;
        hipLaunchKernelGGL(mk_fwd, dim3(grid), dim3(512), LDS_BYTES, stream, p);
    }
#else
    p.ph_lo = 0; p.ph_hi = NPHASE;
    void* args[] = {&p};
    hipError_t e = hipLaunchCooperativeKernel((const void*)mk_fwd, dim3(grid), dim3(512), args, LDS_BYTES, stream);
    if (e != hipSuccess) fprintf(stderr, "cooperative launch failed: %s (grid %d)\n", hipGetErrorString(e), grid);
#endif
    const hipError_t le = hipPeekAtLastError();
    if (le != hipSuccess) fprintf(stderr, "kernel_launch: launch failed: %s\n", hipGetErrorName(le));
}
```

```cpp
#include <hip/hip_runtime.h>
#include <hip/hip_cooperative_groups.h>
#include <cstdio>
#include <cstdint>
namespace cg = cooperative_groups;

#define LAS __attribute__((address_space(3)))
typedef unsigned short bf16_t;
typedef short bf16x8 __attribute__((ext_vector_type(8)));
typedef short s16x4 __attribute__((ext_vector_type(4)));
typedef float f32x4 __attribute__((ext_vector_type(4)));
typedef float f32x2 __attribute__((ext_vector_type(2)));
typedef float f32x16 __attribute__((ext_vector_type(16)));
typedef unsigned u32x4 __attribute__((ext_vector_type(4)));
typedef unsigned u32x2 __attribute__((ext_vector_type(2)));

constexpr int T = 65536, DM = 1024, SEQ = 2048, NBATCH = 32;
constexpr int TH = T / 2;
constexpr float ALPHA = 1.6817928305074290f;
constexpr float EPS = 1e-5f;
constexpr int GLA_NPAD = 5376, MLA_NPAD = 2816;
constexpr int LDS_BYTES = 143360;

constexpr size_t MiB = 1048576;
constexpr size_t W_GIN = 0, W_GIN_SZ = (size_t)GLA_NPAD * 1024 * 2;
constexpr size_t W_GOUT = W_GIN + 2 * W_GIN_SZ, W_OUT_SZ = (size_t)1024 * 2048 * 2;
constexpr size_t W_MIN = W_GOUT + 2 * W_OUT_SZ, W_MIN_SZ = (size_t)MLA_NPAD * 1024 * 2;
constexpr size_t W_MUQ = W_MIN + 2 * W_MIN_SZ, W_MUQ_SZ = (size_t)3072 * 384 * 2;
constexpr size_t W_MUKV = W_MUQ + 2 * W_MUQ_SZ, W_MUKV_SZ = (size_t)4096 * 256 * 2;
constexpr size_t W_MOUT = W_MUKV + 2 * W_MUKV_SZ;
static_assert(W_MOUT + 2 * W_OUT_SZ <= 64 * MiB, "weights region");
constexpr size_t WS_XB = 64 * MiB;
constexpr size_t WS_OFW = 64 * MiB, WS_GQK = 320 * MiB, WS_GV = 448 * MiB, WS_GZ = 704 * MiB, WS_GLR = 960 * MiB;
constexpr size_t WS_MZ = 192 * MiB, WS_QH = 448 * MiB, WS_KNH = 640 * MiB, WS_VH = 768 * MiB, WS_CQ = 896 * MiB, WS_CKV = 944 * MiB,
                 WS_KRR = 976 * MiB, WS_KRO = 992 * MiB, WS_RQ = 1000 * MiB, WS_RKV = 1000 * MiB + 262144;
constexpr size_t WS_COS = 1001 * MiB, WS_SIN = 1009 * MiB, WS_BAR = 1017 * MiB, WS_STATS = 1017 * MiB + 65536, WS_XCH = 1018 * MiB, WS_END = 1022 * MiB;
constexpr int LDS_ST_OFF = 143344;

struct Params {
    const float* x; const int* pos; const float* ln_g; const float* ln_b;
    const float* gla_w_in; const float* gla_w_gate; const float* gla_b_gate; const float* gla_gn_g; const float* gla_w_out;
    const float* mla_w_in; const float* mla_qn_g; const float* mla_kvn_g; const float* mla_w_uq; const float* mla_w_ukv; const float* mla_w_out;
    float* out; unsigned char* ws;
    int ph_lo, ph_hi;
};

__device__ __forceinline__ unsigned cvt_pk_bf16(float lo, float hi) { unsigned r; asm volatile("v_cvt_pk_bf16_f32 %0, %1, %2" : "=v"(r) : "v"(lo), "v"(hi)); return r; }
__device__ __forceinline__ float bf2f(unsigned short b) { return __uint_as_float(((unsigned)b) << 16); }
__device__ __forceinline__ float bflo(unsigned w) { return __uint_as_float(w << 16); }
__device__ __forceinline__ float bfhi(unsigned w) { return __uint_as_float(w & 0xffff0000u); }
__device__ __forceinline__ float silu_f(float z) { return z / (1.f + __expf(-z)); }
__device__ __forceinline__ float silu_fast(float z) { return z * __builtin_amdgcn_rcpf(1.f + __expf(-z)); }
__device__ __forceinline__ float wave_sum(float v) {
#pragma unroll
    for (int o = 32; o > 0; o >>= 1) v += __shfl_xor(v, o, 64);
    return v;
}

__device__ __forceinline__ int opaque_lane() { int l = __builtin_amdgcn_mbcnt_hi(~0u, __builtin_amdgcn_mbcnt_lo(~0u, 0u)); asm volatile("" : "+v"(l)); return l; }
__device__ __forceinline__ int opaque_tid(int wv) { return wv * 64 + opaque_lane(); }
namespace pg8 {
constexpr int BM = 256, BK = 64, HALF = 128, HTB = HALF * BK * 2, STAGE_BYTES = 8 * HTB, NXCD = 8, WGM = 8;
__host__ __device__ __forceinline__ int lds_byte(int r, int c) { const int st = (r >> 4) * 2 + (c >> 5), rr = r & 15, cc = c & 31, ob = rr * 64 + cc * 2; return st * 1024 + (ob ^ (((ob >> 9) & 1) << 5)); }
__host__ __device__ __forceinline__ void stage_rc(int b, int& R, int& C) { const int st = b / 1024, sb = b % 1024, swz = sb ^ (((sb >> 9) & 1) << 5); R = (st >> 1) * 16 + swz / 64; C = (st & 1) * 32 + (swz % 64) / 2; }
__host__ __device__ __forceinline__ int perm32(int rho) { const int n = rho >> 4, i = rho & 15; return 8 * (i >> 2) + 4 * n + (i & 3); }
struct Unit { int pm, pn; };
struct Gemm { const bf16_t* A; const bf16_t* Bt; int M, N, K; };
struct StaticOrder {
    int nM, nN, nwg, G, c;
    __device__ void init(int M, int N, int G_, int c_) { nM = M / BM; nN = N / BM; nwg = nM * nN; G = G_; c = c_; }
    __device__ bool next(int i, Unit& u) const {
        const long L = (long)i * G + c; if (L >= nwg) return false;
        int wgid = (int)L; { const int q = nwg / NXCD, r = nwg % NXCD, xcd = wgid % NXCD, off = wgid / NXCD; wgid = (xcd < r ? xcd * (q + 1) : r * (q + 1) + (xcd - r) * q) + off; }
        const int nig = WGM * nN, gid = wgid / nig, fm = gid * WGM, gsz = (nM - fm) < WGM ? (nM - fm) : WGM;
        u.pm = fm + ((wgid % nig) % gsz); u.pn = (wgid % nig) / gsz; return true;
    }
};

template <class Epi>
__device__ __forceinline__ void gemm_phase(LAS unsigned char* lds, const Gemm g, const StaticOrder& S, const Epi& E, int wv) {
    const int tid = opaque_tid(wv), wid = wv, lane = tid & 63, wr = wid >> 2, wc = wid & 3, fr = lane & 15, fq = lane >> 4;
    const int K = g.K, nt = K / BK;
    unsigned voffA[2], voffB[2];
#pragma unroll
    for (int i = 0; i < 2; ++i) { int R, C; stage_rc(tid * 16 + i * 8192, R, C); const int Rb = Epi::PERM ? ((R & ~31) + perm32(R & 31)) : R;
        voffA[i] = (unsigned)(R * K + C) * 2u; voffB[i] = (unsigned)(Rb * K + C) * 2u; }
    const size_t kstep = (size_t)(BK * 2);
    const size_t hstep = (size_t)HALF * K * 2;
    const size_t tstep = 2 * hstep;
    const unsigned ldsw = (unsigned)wid * 1024u;
    const int aoff = lds_byte(wr * 64 + fr, fq * 8), boff = lds_byte(wc * 32 + fr, fq * 8);
#define PG8_SA(b, h) (((b) * 2 + (h)) * HTB)
#define PG8_SB(b, h) ((4 + (b) * 2 + (h)) * HTB)
#define PG8_STAGE(bufoff, gbase, voff) do { _Pragma("unroll") for (int _i = 0; _i < 2; ++_i) \
        __builtin_amdgcn_global_load_lds((const unsigned*)((const char*)(gbase) + (voff)[_i]), (LAS unsigned*)(lds + (bufoff) + ldsw + _i * 8192), 16, 0, 0); } while (0)
#define PG8_LDA(dst, b, h) do { _Pragma("unroll") for (int m = 0; m < 4; ++m) _Pragma("unroll") for (int k = 0; k < 2; ++k) dst[m][k] = *(const LAS bf16x8*)(lds + PG8_SA(b, h) + aoff + m * 2048 + k * 1024); } while (0)
#define PG8_LDB(dst, b, h) do { _Pragma("unroll") for (int n = 0; n < 2; ++n) _Pragma("unroll") for (int k = 0; k < 2; ++k) dst[n][k] = *(const LAS bf16x8*)(lds + PG8_SB(b, h) + boff + n * 2048 + k * 1024); } while (0)
#define PG8_MMA(ai, bj, At, Bt) do { __builtin_amdgcn_s_setprio(1); _Pragma("unroll") for (int m = 0; m < 4; ++m) _Pragma("unroll") for (int n = 0; n < 2; ++n) _Pragma("unroll") for (int k = 0; k < 2; ++k) \
        acc[ai][bj][m][n] = __builtin_amdgcn_mfma_f32_16x16x32_bf16(Bt[n][k], At[m][k], acc[ai][bj][m][n], 0, 0, 0); __builtin_amdgcn_s_setprio(0); } while (0)
#define PG8_WAIT_V(n) asm volatile("s_waitcnt vmcnt(" #n ")" ::: "memory")
#define PG8_WAIT_L(n) asm volatile("s_waitcnt lgkmcnt(" #n ")" ::: "memory")
#define PG8_BAR __builtin_amdgcn_s_barrier()
#define PG8_SCHED __builtin_amdgcn_sched_barrier(0)
    Unit cur, nxt; int ui = 0;
    if (!S.next(0, cur)) return;
    f32x4 acc[2][2][4][2];
#pragma unroll
    for (int a = 0; a < 2; ++a)
#pragma unroll
        for (int b = 0; b < 2; ++b)
#pragma unroll
            for (int m = 0; m < 4; ++m)
#pragma unroll
                for (int n = 0; n < 2; ++n) acc[a][b][m][n] = (f32x4){0.f, 0.f, 0.f, 0.f};
    bf16x8 At[4][2], B0[2][2], B1[2][2];
    const char* cA = (const char*)g.A + (size_t)cur.pm * tstep; const char* cB = (const char*)g.Bt + (size_t)cur.pn * tstep;
    PG8_STAGE(PG8_SB(0, 0), cB, voffB); PG8_STAGE(PG8_SA(0, 0), cA, voffA); PG8_STAGE(PG8_SB(0, 1), cB + hstep, voffB); PG8_STAGE(PG8_SA(0, 1), cA + hstep, voffA);
    if (wr == 1) PG8_BAR;
    PG8_WAIT_V(4); PG8_BAR;
    PG8_STAGE(PG8_SB(1, 0), cB + kstep, voffB); PG8_STAGE(PG8_SA(1, 0), cA + kstep, voffA); PG8_STAGE(PG8_SB(1, 1), cB + hstep + kstep, voffB);
    PG8_WAIT_V(6); PG8_BAR;
    for (;;) {
        const bool has_next = S.next(ui + 1, nxt);
        const char* nA = has_next ? (const char*)g.A + (size_t)nxt.pm * tstep : cA; const char* nB = has_next ? (const char*)g.Bt + (size_t)nxt.pn * tstep : cB;
        for (int t = 0; t < nt; t += 2) {
            const bool last = (t == nt - 2);
            const char* a1 = cA + (size_t)(t + 1) * kstep;
            const char* a2 = last ? nA : cA + (size_t)(t + 2) * kstep; const char* b2 = last ? nB : cB + (size_t)(t + 2) * kstep;
            const char* a3 = a2 + kstep; const char* b3 = b2 + kstep;
            PG8_LDB(B0, 0, 0); PG8_SCHED; PG8_LDA(At, 0, 0); PG8_STAGE(PG8_SA(1, 1), a1 + hstep, voffA);
            PG8_WAIT_L(8); PG8_BAR; PG8_WAIT_L(0); PG8_MMA(0, 0, At, B0); PG8_BAR; PG8_SCHED;
            PG8_LDB(B1, 0, 1); PG8_STAGE(PG8_SB(0, 0), b2, voffB);
            PG8_BAR; PG8_WAIT_L(0); PG8_MMA(0, 1, At, B1); PG8_BAR;
            PG8_LDA(At, 0, 1); PG8_STAGE(PG8_SA(0, 0), a2, voffA);
            PG8_BAR; PG8_WAIT_L(0); PG8_MMA(1, 0, At, B0); PG8_BAR; PG8_SCHED;
            PG8_STAGE(PG8_SB(0, 1), b2 + hstep, voffB);
            PG8_WAIT_V(6); PG8_BAR; PG8_MMA(1, 1, At, B1); PG8_BAR;
            PG8_LDB(B0, 1, 0); PG8_SCHED; PG8_LDA(At, 1, 0); PG8_STAGE(PG8_SA(0, 1), a2 + hstep, voffA);
            PG8_WAIT_L(8); PG8_BAR; PG8_WAIT_L(0); PG8_MMA(0, 0, At, B0); PG8_BAR; PG8_SCHED;
            PG8_LDB(B1, 1, 1); PG8_STAGE(PG8_SB(1, 0), b3, voffB);
            PG8_BAR; PG8_WAIT_L(0); PG8_MMA(0, 1, At, B1); PG8_BAR;
            PG8_LDA(At, 1, 1); PG8_STAGE(PG8_SA(1, 0), a3, voffA);
            PG8_BAR; PG8_WAIT_L(0); PG8_MMA(1, 0, At, B0); PG8_BAR; PG8_SCHED;
            PG8_STAGE(PG8_SB(1, 1), b3 + hstep, voffB);
            PG8_WAIT_V(6); PG8_BAR; PG8_MMA(1, 1, At, B1); PG8_BAR;
        }
        E(acc, cur, wv);
        if (!has_next) break;
#pragma unroll
        for (int a = 0; a < 2; ++a)
#pragma unroll
            for (int b = 0; b < 2; ++b)
#pragma unroll
                for (int m = 0; m < 4; ++m)
#pragma unroll
                    for (int n = 0; n < 2; ++n) acc[a][b][m][n] = (f32x4){0.f, 0.f, 0.f, 0.f};
        cur = nxt; cA = nA; cB = nB; ++ui;
    }
    PG8_WAIT_V(0);
    if (wr == 0) PG8_BAR;
    PG8_BAR;
#undef PG8_SA
#undef PG8_SB
#undef PG8_STAGE
#undef PG8_LDA
#undef PG8_LDB
#undef PG8_MMA
#undef PG8_WAIT_V
#undef PG8_WAIT_L
#undef PG8_BAR
#undef PG8_SCHED
}

typedef f32x4 Acc[2][2][4][2];
__device__ __forceinline__ void store8_bf16(bf16_t* p, f32x4 v0, f32x4 v1, float s) {
    u32x4 w = {cvt_pk_bf16(v0[0] * s, v0[1] * s), cvt_pk_bf16(v0[2] * s, v0[3] * s), cvt_pk_bf16(v1[0] * s, v1[1] * s), cvt_pk_bf16(v1[2] * s, v1[3] * s)};
    *(u32x4*)p = w;
}
__device__ __forceinline__ void tile_store_bf16(const Acc& acc, bf16_t* base, int ld, int pm, int wr, int wc, int fr, int fq, float s) {
    const int row0 = pm * BM + wr * 64 + fr, col0 = wc * 32 + 8 * fq;
#pragma unroll
    for (int ai = 0; ai < 2; ++ai)
#pragma unroll
        for (int m = 0; m < 4; ++m) { bf16_t* rowp = base + (size_t)(row0 + ai * HALF + m * 16) * ld + col0;
#pragma unroll
            for (int bj = 0; bj < 2; ++bj) store8_bf16(rowp + bj * HALF, acc[ai][bj][m][0], acc[ai][bj][m][1], s); }
}
struct EpiGlaIn {
    static constexpr bool PERM = true;
    bf16_t* QK; bf16_t* V; bf16_t* Z; float* GLR;
    __device__ __forceinline__ void operator()(const Acc& acc, const Unit& u, int wv) const {
        const int wr = wv >> 2, wc = wv & 3, ln_ = opaque_lane(), fr = ln_ & 15, fq = ln_ >> 4;
        const int pn = u.pn;
        if (pn < 4) tile_store_bf16(acc, QK + pn * 256, 1024, u.pm, wr, wc, fr, fq, pn < 2 ? 0.08838834764831845f : 1.f);
        else if (pn < 12) tile_store_bf16(acc, V + (pn - 4) * 256, 2048, u.pm, wr, wc, fr, fq, 1.f);
        else if (pn < 20) tile_store_bf16(acc, Z + (pn - 12) * 256, 2048, u.pm, wr, wc, fr, fq, 1.f);
        else if (wc == 0) {
            const int row0 = u.pm * BM + wr * 64 + fr;
#pragma unroll
            for (int ai = 0; ai < 2; ++ai)
#pragma unroll
                for (int m = 0; m < 4; ++m) { float* rowp = GLR + (size_t)(row0 + ai * HALF + m * 16) * 32 + 8 * fq;
                    *(f32x4*)rowp = acc[ai][0][m][0]; *(f32x4*)(rowp + 4) = acc[ai][0][m][1]; }
        }
    }
};
__device__ __forceinline__ float sumsq8(f32x4 a, f32x4 b) { return a[0] * a[0] + a[1] * a[1] + a[2] * a[2] + a[3] * a[3] + b[0] * b[0] + b[1] * b[1] + b[2] * b[2] + b[3] * b[3]; }
struct EpiMlaIn {
    static constexpr bool PERM = true;
    bf16_t* Z; bf16_t* CKV; bf16_t* CQ; bf16_t* KRO; float* SSQ_Q; float* SSQ_KV; const float* COS; const float* SIN;
    __device__ __forceinline__ void operator()(const Acc& acc, const Unit& u, int wv) const {
        const int wr = wv >> 2, wc = wv & 3, ln_ = opaque_lane(), fr = ln_ & 15, fq = ln_ >> 4;
        const int pn = u.pn;
        if (pn < 8) { tile_store_bf16(acc, Z + pn * 256, 2048, u.pm, wr, wc, fr, fq, 1.f); return; }
        const int row0 = u.pm * BM + wr * 64 + fr, col0 = wc * 32 + 8 * fq;
#pragma unroll
        for (int ai = 0; ai < 2; ++ai)
#pragma unroll
            for (int m = 0; m < 4; ++m) { const size_t row = (size_t)(row0 + ai * HALF + m * 16);
                float ss;
                if (pn == 8) { bf16_t* rp = CKV + row * 256 + col0; store8_bf16(rp, acc[ai][0][m][0], acc[ai][0][m][1], 1.f); store8_bf16(rp + HALF, acc[ai][1][m][0], acc[ai][1][m][1], 1.f);
                    ss = sumsq8(acc[ai][0][m][0], acc[ai][0][m][1]) + sumsq8(acc[ai][1][m][0], acc[ai][1][m][1]); }
                else if (pn == 9) { bf16_t* rp = CQ + row * 384 + col0; store8_bf16(rp, acc[ai][0][m][0], acc[ai][0][m][1], 1.f); store8_bf16(rp + HALF, acc[ai][1][m][0], acc[ai][1][m][1], 1.f);
                    ss = sumsq8(acc[ai][0][m][0], acc[ai][0][m][1]) + sumsq8(acc[ai][1][m][0], acc[ai][1][m][1]); }
                else { store8_bf16(CQ + row * 384 + 256 + col0, acc[ai][0][m][0], acc[ai][0][m][1], 1.f);
                    ss = sumsq8(acc[ai][0][m][0], acc[ai][0][m][1]);
                    if (wc < 2) { const int i0 = col0 >> 1; const f32x4 cs = *(const f32x4*)(COS + row * 32 + i0), sn = *(const f32x4*)(SIN + row * 32 + i0);
                        const f32x4 v0 = acc[ai][1][m][0], v1 = acc[ai][1][m][1]; f32x4 w0, w1;
                        w0[0] = v0[0] * cs[0] - v0[1] * sn[0]; w0[1] = v0[1] * cs[0] + v0[0] * sn[0];
                        w0[2] = v0[2] * cs[1] - v0[3] * sn[1]; w0[3] = v0[3] * cs[1] + v0[2] * sn[1];
                        w1[0] = v1[0] * cs[2] - v1[1] * sn[2]; w1[1] = v1[1] * cs[2] + v1[0] * sn[2];
                        w1[2] = v1[2] * cs[3] - v1[3] * sn[3]; w1[3] = v1[3] * cs[3] + v1[2] * sn[3];
                        store8_bf16(KRO + row * 64 + col0, w0, w1, 1.f); } }
                { auto r16 = __builtin_amdgcn_permlane16_swap(__float_as_uint(ss), __float_as_uint(ss), false, false); ss = __uint_as_float(r16[0]) + __uint_as_float(r16[1]);
                  auto r32s = __builtin_amdgcn_permlane32_swap(__float_as_uint(ss), __float_as_uint(ss), false, false); ss = __uint_as_float(r32s[0]) + __uint_as_float(r32s[1]); }
                if (fq == 0) atomicAdd((pn == 8 ? SSQ_KV : SSQ_Q) + row, ss);
                __builtin_amdgcn_sched_barrier(0); }
    }
};
struct EpiQup {
    static constexpr bool PERM = true;
    bf16_t* Q; const float* RQ; const float* COS; const float* SIN; int tok0;
    __device__ __forceinline__ void operator()(Acc& acc, const Unit& u, int wv) const {
        const int wr = wv >> 2, wc = wv & 3, ln_ = opaque_lane(), fr = ln_ & 15, fq = ln_ >> 4;
        const int row0 = u.pm * BM + wr * 64 + fr;
        float sc[8];
#pragma unroll
        for (int i = 0; i < 8; ++i) sc[i] = RQ[(size_t)tok0 + row0 + (i >> 2) * HALF + (i & 3) * 16];
#pragma unroll
        for (int i = 0; i < 8; ++i) sc[i] = rsqrtf(sc[i] * (1.f / 384.f) + EPS);
#pragma unroll
        for (int bj = 0; bj < 2; ++bj) {
            const int c = u.pn * 256 + bj * 128 + wc * 32 + 8 * fq, o = c % 192; const bool rope = o >= 128; const int i0 = (o - 128) >> 1;
            if (!rope) {
#pragma unroll
                for (int i = 0; i < 8; ++i) { const int row = row0 + (i >> 2) * HALF + (i & 3) * 16; store8_bf16(Q + (size_t)row * 3072 + c, acc[i >> 2][bj][i & 3][0], acc[i >> 2][bj][i & 3][1], sc[i]); }
            } else {
#pragma unroll
                for (int ai = 0; ai < 2; ++ai) {
                    f32x4 cs[4], sn[4];
#pragma unroll
                    for (int m = 0; m < 4; ++m) { const size_t tok = (size_t)tok0 + row0 + ai * HALF + m * 16; cs[m] = *(const f32x4*)(COS + tok * 32 + i0); sn[m] = *(const f32x4*)(SIN + tok * 32 + i0); }
#pragma unroll
                    for (int m = 0; m < 4; ++m) { const int row = row0 + ai * HALF + m * 16; const float s = sc[ai * 4 + m];
                        const f32x4 v0 = acc[ai][bj][m][0] * s, v1 = acc[ai][bj][m][1] * s; f32x4 w0, w1;
                        w0[0] = v0[0] * cs[m][0] - v0[1] * sn[m][0]; w0[1] = v0[1] * cs[m][0] + v0[0] * sn[m][0];
                        w0[2] = v0[2] * cs[m][1] - v0[3] * sn[m][1]; w0[3] = v0[3] * cs[m][1] + v0[2] * sn[m][1];
                        w1[0] = v1[0] * cs[m][2] - v1[1] * sn[m][2]; w1[1] = v1[1] * cs[m][2] + v1[0] * sn[m][2];
                        w1[2] = v1[2] * cs[m][3] - v1[3] * sn[m][3]; w1[3] = v1[3] * cs[m][3] + v1[2] * sn[m][3];
                        store8_bf16(Q + (size_t)row * 3072 + c, w0, w1, 1.f); }
                    __builtin_amdgcn_sched_barrier(0);
                }
            }
        }
    }
};
struct EpiKVup {
    static constexpr bool PERM = true;
    bf16_t* KN; bf16_t* V; const float* RKV; int tok0;
    __device__ __forceinline__ void operator()(Acc& acc, const Unit& u, int wv) const {
        const int wr = wv >> 2, wc = wv & 3, ln_ = opaque_lane(), fr = ln_ & 15, fq = ln_ >> 4;
        bf16_t* base = u.pn < 8 ? KN + u.pn * 256 : V + (u.pn - 8) * 256;
        const int row0 = u.pm * BM + wr * 64 + fr, col0 = wc * 32 + 8 * fq;
        float sc[8];
#pragma unroll
        for (int i = 0; i < 8; ++i) sc[i] = RKV[(size_t)tok0 + row0 + (i >> 2) * HALF + (i & 3) * 16];
#pragma unroll
        for (int i = 0; i < 8; ++i) sc[i] = rsqrtf(sc[i] * (1.f / 256.f) + EPS);
#pragma unroll
        for (int i = 0; i < 8; ++i) { const int row = row0 + (i >> 2) * HALF + (i & 3) * 16; bf16_t* rowp = base + (size_t)row * 2048 + col0;
#pragma unroll
            for (int bj = 0; bj < 2; ++bj) store8_bf16(rowp + bj * HALF, acc[i >> 2][bj][i & 3][0], acc[i >> 2][bj][i & 3][1], sc[i]); }
    }
};
struct EpiRes {
    static constexpr bool PERM = false;
    float* XRES; const float* XIN; const f32x2* ST; const float* G; const float* B; bool nowrite;
    __device__ __forceinline__ void operator()(const Acc& acc, const Unit& u, int wv) const {
        const int wr = wv >> 2, wc = wv & 3, ln_ = opaque_lane(), fr = ln_ & 15, fq = ln_ >> 4;
        const int row0 = u.pm * BM + wr * 64 + fr, col0 = u.pn * BM + wc * 32 + 4 * fq;
#pragma unroll
        for (int pr = 0; pr < 4; ++pr) {
            f32x4 xi[2][4]; f32x2 st[2];
#pragma unroll
            for (int q = 0; q < 2; ++q) { const int i = pr * 2 + q, row = row0 + (i >> 2) * HALF + (i & 3) * 16; const size_t ro = (size_t)row * 1024 + col0;
                st[q] = (f32x2){0.f, 1.f}; if (ST) st[q] = ST[row];
#pragma unroll
                for (int c4 = 0; c4 < 4; ++c4) xi[q][c4] = *(const f32x4*)(XIN + ro + (c4 >> 1) * HALF + (c4 & 1) * 16); }
#pragma unroll
            for (int q = 0; q < 2; ++q) { const int i = pr * 2 + q, row = row0 + (i >> 2) * HALF + (i & 3) * 16; const size_t ro = (size_t)row * 1024 + col0;
#pragma unroll
                for (int c4 = 0; c4 < 4; ++c4) { const int co = (c4 >> 1) * HALF + (c4 & 1) * 16; f32x4 x = xi[q][c4];
                    if (ST) { const f32x4 g = *(const f32x4*)(G + col0 + co), b = *(const f32x4*)(B + col0 + co); x = (x - st[q][0]) * st[q][1] * g + b; }
                    if (!nowrite) *(f32x4*)(XRES + ro + co) = acc[i >> 2][c4 >> 1][i & 3][c4 & 1] + x * ALPHA; } }
            __builtin_amdgcn_sched_barrier(0);
        }
    }
};
}

enum { MAP_ID = 0, MAP_MLAIN = 1, MAP_UQ = 2, MAP_UKV = 3 };
__device__ __forceinline__ int map_col(int mode, int nd, int nsrc) {
    if (mode == MAP_ID) return nd < nsrc ? nd : -1;
    if (mode == MAP_MLAIN) { if (nd < 2048) return 704 + nd; if (nd < 2304) return 384 + (nd - 2048); if (nd < 2688) return nd - 2304; if (nd < 2752) { const int p_ = nd - 2688; return 640 + (p_ >> 1) + ((p_ & 1) ? 32 : 0); } return -1; }
    if (mode == MAP_UQ) { const int h = nd / 192, o = nd % 192; if (o < 128) return h * 192 + o; const int p = o - 128, i = p >> 1; return (p & 1) ? h * 192 + 160 + i : h * 192 + 128 + i; }
    { if (nd < 2048) return (nd >> 7) * 256 + (nd & 127); const int n2 = nd - 2048; return (n2 >> 7) * 256 + 128 + (n2 & 127); }
}
__device__ __forceinline__ void transpose_job(const float* src, bf16_t* dst, int K, int nsrc, int ndst, int mode, const float* rs, float* tile  , int wv) {
    const int tid = opaque_tid(wv), tk = K / 64, tn = ndst / 64, ntiles = tk * tn;
    for (int t = blockIdx.x; t < ntiles; t += gridDim.x) {
        const int k0 = (t % tk) * 64, n0 = (t / tk) * 64;
        const int nn = tid & 63, sc = map_col(mode, n0 + nn, nsrc);
        __syncthreads();
#pragma unroll
        for (int i = 0; i < 8; ++i) { const int kk = (tid >> 6) + 8 * i; float v = 0.f; if (sc >= 0) { v = src[(size_t)(k0 + kk) * nsrc + sc]; if (rs) v *= rs[k0 + kk]; } tile[kk * 65 + nn] = v; }
        __syncthreads();
        const int on = tid >> 3, ok = (tid & 7) * 8;
        float v[8];
#pragma unroll
        for (int i = 0; i < 8; ++i) v[i] = tile[(ok + i) * 65 + on];
        u32x4 w = {cvt_pk_bf16(v[0], v[1]), cvt_pk_bf16(v[2], v[3]), cvt_pk_bf16(v[4], v[5]), cvt_pk_bf16(v[6], v[7])};
        *(u32x4*)(dst + (size_t)(n0 + on) * K + k0 + ok) = w;
    }
}
__device__ __forceinline__ void phase_prep(const __attribute__((address_space(4))) Params* pp, unsigned char* lds, int wv) {
    float* tile = (float*)lds;
    struct { const float* x; const int* pos; const float* gla_w_in; const float* gla_w_out; const float* mla_w_in; const float* mla_qn_g; const float* mla_kvn_g; const float* mla_w_uq; const float* mla_w_ukv; const float* mla_w_out; unsigned char* ws; } p;
    p.x = pp->x; p.pos = pp->pos; p.gla_w_in = pp->gla_w_in; p.gla_w_out = pp->gla_w_out; p.mla_w_in = pp->mla_w_in; p.mla_qn_g = pp->mla_qn_g; p.mla_kvn_g = pp->mla_kvn_g; p.mla_w_uq = pp->mla_w_uq; p.mla_w_ukv = pp->mla_w_ukv; p.mla_w_out = pp->mla_w_out; p.ws = pp->ws;
    unsigned char* ws = p.ws;
    const size_t gtid = (size_t)blockIdx.x * 512 + opaque_tid(wv), gsz = (size_t)gridDim.x * 512;
    for (size_t i = gtid; i < (size_t)T * DM / 8; i += gsz) {
        const f32x4 a = *(const f32x4*)(p.x + i * 8), b = *(const f32x4*)(p.x + i * 8 + 4);
        u32x4 w = {cvt_pk_bf16(a[0], a[1]), cvt_pk_bf16(a[2], a[3]), cvt_pk_bf16(b[0], b[1]), cvt_pk_bf16(b[2], b[3])};
        *(u32x4*)(ws + WS_XB + i * 16) = w;
    }
    for (size_t i = gtid; i < (size_t)(MiB / 16); i += gsz) *(u32x4*)(ws + WS_RQ + i * 16) = (u32x4){0u, 0u, 0u, 0u};
    for (size_t i = gtid; i < (size_t)T * 32; i += gsz) {
        const int tok = (int)(i >> 5), f = (int)(i & 31);
        const float inv = 1.0f / powf(10000.0f, (float)(2 * f) / 64.0f);
        const float ang = (float)p.pos[tok] * inv;
        ((float*)(ws + WS_COS))[i] = cosf(ang); ((float*)(ws + WS_SIN))[i] = sinf(ang);
    }
    for (int j = 0; j < 2; ++j) {
        transpose_job(p.gla_w_in + (size_t)j * 1024 * 5152, (bf16_t*)(ws + W_GIN + j * W_GIN_SZ), 1024, 5152, GLA_NPAD, MAP_ID, nullptr, tile, wv);
        transpose_job(p.gla_w_out + (size_t)j * 2048 * 1024, (bf16_t*)(ws + W_GOUT + j * W_OUT_SZ), 2048, 1024, 1024, MAP_ID, nullptr, tile, wv);
        transpose_job(p.mla_w_in + (size_t)j * 1024 * 2752, (bf16_t*)(ws + W_MIN + j * W_MIN_SZ), 1024, 2752, MLA_NPAD, MAP_MLAIN, nullptr, tile, wv);
        transpose_job(p.mla_w_uq + (size_t)j * 384 * 3072, (bf16_t*)(ws + W_MUQ + j * W_MUQ_SZ), 384, 3072, 3072, MAP_UQ, p.mla_qn_g + j * 384, tile, wv);
        transpose_job(p.mla_w_ukv + (size_t)j * 256 * 4096, (bf16_t*)(ws + W_MUKV + j * W_MUKV_SZ), 256, 4096, 4096, MAP_UKV, p.mla_kvn_g + j * 256, tile, wv);
        transpose_job(p.mla_w_out + (size_t)j * 2048 * 1024, (bf16_t*)(ws + W_MOUT + j * W_OUT_SZ), 2048, 1024, 1024, MAP_ID, nullptr, tile, wv);
    }
    __syncthreads();
}

__device__ __forceinline__ void phase_ln(float* xres, bf16_t* xb, f32x2* stats, const float* g, const float* b, int wv, bool nowrite, bool final_) {
    const int tid = opaque_tid(wv); const int lane = tid & 63, gw = blockIdx.x * 8 + (tid >> 6), nw = gridDim.x * 8;
    f32x4 gv[4], bv[4];
#pragma unroll
    for (int i = 0; i < 4; ++i) { gv[i] = *(const f32x4*)(g + i * 256 + lane * 4); bv[i] = *(const f32x4*)(b + i * 256 + lane * 4); }
    for (int row0 = gw; row0 < T; row0 += 4 * nw) {
        f32x4 v[4][4];
#pragma unroll
        for (int u = 0; u < 4; ++u) { const float* rp = xres + (size_t)(row0 + u * nw) * 1024;
#pragma unroll
            for (int i = 0; i < 4; ++i) v[u][i] = *(const f32x4*)(rp + i * 256 + lane * 4); }
#pragma unroll
        for (int u = 0; u < 4; ++u) {
            const int row = row0 + u * nw; float* rp = xres + (size_t)row * 1024;
            float s = 0.f;
#pragma unroll
            for (int i = 0; i < 4; ++i) s += v[u][i][0] + v[u][i][1] + v[u][i][2] + v[u][i][3];
            const float mu = wave_sum(s) * (1.f / 1024.f);
            float q = 0.f;
#pragma unroll
            for (int i = 0; i < 4; ++i) { v[u][i] = v[u][i] - mu; q += v[u][i][0] * v[u][i][0] + v[u][i][1] * v[u][i][1] + v[u][i][2] * v[u][i][2] + v[u][i][3] * v[u][i][3]; }
            const float rstd = rsqrtf(wave_sum(q) * (1.f / 1024.f) + EPS);
            if (!final_ && lane == 0 && !nowrite) stats[row] = (f32x2){mu, rstd};
#pragma unroll
            for (int i = 0; i < 4; ++i) { const f32x4 y = v[u][i] * rstd * gv[i] + bv[i]; if (!nowrite) { if (final_) *(f32x4*)(rp + i * 256 + lane * 4) = y;
                else { u32x2 w = {cvt_pk_bf16(y[0], y[1]), cvt_pk_bf16(y[2], y[3])}; *(u32x2*)(xb + (size_t)row * 1024 + i * 256 + lane * 4) = w; } } }
        }
    }
}

__device__ __forceinline__ void phase_gla_gate(const bf16_t* O, bf16_t* Z, const float* gn, int wv, bool nowrite) {
    const int tid = opaque_tid(wv); const int lane = tid & 63, h = wv & 3;
    const f32x4 g0 = *(const f32x4*)(gn + h * 512 + lane * 8), g1 = *(const f32x4*)(gn + h * 512 + lane * 8 + 4);
    const int rw = blockIdx.x * 2 + (wv >> 2), nrw = gridDim.x * 2;
    for (int row0 = rw; row0 < T; row0 += 4 * nrw) {
        u32x4 ov[4], zv[4];
#pragma unroll
        for (int u = 0; u < 4; ++u) { const size_t off = (size_t)(row0 + u * nrw) * 2048 + h * 512 + lane * 8; ov[u] = *(const u32x4*)(O + off); zv[u] = *(const u32x4*)(Z + off); }
#pragma unroll
        for (int u = 0; u < 4; ++u) {
            const size_t off = (size_t)(row0 + u * nrw) * 2048 + h * 512 + lane * 8;
            float o[8], z[8];
#pragma unroll
            for (int i = 0; i < 4; ++i) { o[2 * i] = bflo(ov[u][i]); o[2 * i + 1] = bfhi(ov[u][i]); z[2 * i] = bflo(zv[u][i]); z[2 * i + 1] = bfhi(zv[u][i]); }
            float ss = 0.f;
#pragma unroll
            for (int i = 0; i < 8; ++i) ss += o[i] * o[i];
            const float r = rsqrtf(wave_sum(ss) * (1.f / 512.f) + EPS);
            float y[8];
#pragma unroll
            for (int i = 0; i < 8; ++i) y[i] = o[i] * r * (i < 4 ? g0[i] : g1[i - 4]) * silu_f(z[i]);
            u32x4 w = {cvt_pk_bf16(y[0], y[1]), cvt_pk_bf16(y[2], y[3]), cvt_pk_bf16(y[4], y[5]), cvt_pk_bf16(y[6], y[7])};
            if (!nowrite) *(u32x4*)(Z + off) = w;
        }
    }
}

__device__ __forceinline__ void phase_mla_stats(const bf16_t* CQ, const bf16_t* CKV, const float* KRR, bf16_t* KRO, float* RQ, float* RKV, const float* COS, const float* SIN, int wv) {
    const int tid = opaque_tid(wv); const int lane = tid & 63, gw = blockIdx.x * 8 + (tid >> 6), nw = gridDim.x * 8;
    for (int row = gw; row < T; row += nw) {
        float sq = 0.f, sk = 0.f;
        if (lane < 48) { const u32x4 v = *(const u32x4*)(CQ + (size_t)row * 384 + lane * 8);
#pragma unroll
            for (int i = 0; i < 4; ++i) { const float a = bflo(v[i]), b = bfhi(v[i]); sq += a * a + b * b; } }
        if (lane < 32) { const u32x4 v = *(const u32x4*)(CKV + (size_t)row * 256 + lane * 8);
#pragma unroll
            for (int i = 0; i < 4; ++i) { const float a = bflo(v[i]), b = bfhi(v[i]); sk += a * a + b * b; } }
        sq = wave_sum(sq); sk = wave_sum(sk);
        if (lane == 0) { RQ[row] = rsqrtf(sq * (1.f / 384.f) + EPS); RKV[row] = rsqrtf(sk * (1.f / 256.f) + EPS); }
        if (lane < 32) { const float x1 = KRR[(size_t)row * 64 + lane], x2 = KRR[(size_t)row * 64 + 32 + lane];
            const float c = COS[(size_t)row * 32 + lane], s = SIN[(size_t)row * 32 + lane];
            *(unsigned*)(KRO + (size_t)row * 64 + 2 * lane) = cvt_pk_bf16(x1 * c - x2 * s, x2 * c + x1 * s); }
    }
}

namespace att {
constexpr int NW = 8, QBLK = 32, KVBLK = 64;
constexpr int LDQ = 3072, LDK = 2048, LDR = 64, LDZ = 2048;
constexpr float SCALE = 0.07216878364870322f;
constexpr float THR = 8.f;
constexpr int SHM_V = 16384, SHM_K = 16384, SHM_R = 8192;
constexpr int OFF_V = 0, OFF_K = 2 * SHM_V, OFF_R = OFF_K + 2 * SHM_K, OFF_WS = OFF_R + 2 * SHM_R, OFF_QR = OFF_WS + 2048;
#define KSWZ(row, colB) ((row) * 256 + ((colB) ^ (((row) & 7) << 4)))
#define RSWZ(row, colB) ((row) * 128 + ((colB) ^ ((((row) >> 1) & 7) << 4)))
#define SBAR() __builtin_amdgcn_sched_barrier(0)
__device__ __forceinline__ int crow(int r, int hi) { return (r & 3) + 8 * (r >> 2) + 4 * hi; }
__device__ __forceinline__ void partialSM(f32x16& p0, f32x16& p1, float& m_reg, float& mn, float& alpha) {
    constexpr float C = SCALE * 1.4426950408889634f;
    float pmax = p0[0];
#pragma unroll
    for (int r = 1; r < 16; ++r) pmax = fmaxf(pmax, p0[r]);
#pragma unroll
    for (int r = 0; r < 16; ++r) pmax = fmaxf(pmax, p1[r]);
    { auto rr = __builtin_amdgcn_permlane32_swap(__float_as_uint(pmax), __float_as_uint(pmax), false, false);
      pmax = fmaxf(__uint_as_float(rr[0]), __uint_as_float(rr[1])); }
    if (__builtin_expect(__all(pmax - m_reg <= THR / SCALE), 1)) { mn = m_reg; alpha = 1.f; }
    else { mn = fmaxf(m_reg, pmax); alpha = __builtin_amdgcn_exp2f((m_reg - mn) * C); m_reg = mn; }
    const float mnC = -mn * C;
#pragma unroll
    for (int r = 0; r < 16; ++r) p0[r] = fmaf(p0[r], C, mnC);
#pragma unroll
    for (int r = 0; r < 16; ++r) p1[r] = fmaf(p1[r], C, mnC);
#pragma unroll
    for (int r = 0; r < 16; ++r) p0[r] = __builtin_amdgcn_exp2f(p0[r]);
}
__device__ __forceinline__ void finishSM(f32x16& p0, f32x16& p1, float alpha, float& l_reg, bf16x8& pa0, bf16x8& pa1, bf16x8& pa2, bf16x8& pa3) {
#pragma unroll
    for (int r = 0; r < 16; ++r) p1[r] = __builtin_amdgcn_exp2f(p1[r]);
    float ps = 0;
#pragma unroll
    for (int r = 0; r < 16; ++r) ps += p0[r];
#pragma unroll
    for (int r = 0; r < 16; ++r) ps += p1[r];
    { auto rr = __builtin_amdgcn_permlane32_swap(__float_as_uint(ps), __float_as_uint(ps), false, false);
      ps = __uint_as_float(rr[0]) + __uint_as_float(rr[1]); }
    l_reg = l_reg * alpha + ps;
#define PK4(P, BASE, OUT) do { unsigned a0 = cvt_pk_bf16(P[BASE + 0], P[BASE + 1]), a1 = cvt_pk_bf16(P[BASE + 2], P[BASE + 3]);   \
    unsigned b0 = cvt_pk_bf16(P[BASE + 4], P[BASE + 5]), b1 = cvt_pk_bf16(P[BASE + 6], P[BASE + 7]);                              \
    auto r0 = __builtin_amdgcn_permlane32_swap(a0, b0, false, false); auto r1 = __builtin_amdgcn_permlane32_swap(a1, b1, false, false); \
    u32x4 w = {r0[0], r1[0], r0[1], r1[1]}; OUT = *reinterpret_cast<bf16x8*>(&w); } while (0)
    PK4(p0, 0, pa0); PK4(p0, 8, pa1); PK4(p1, 0, pa2); PK4(p1, 8, pa3);
#undef PK4
}
__device__ __forceinline__ void qkt(f32x16& p0, f32x16& p1, const char* Ks, const char* Rs, const bf16x8* qr, const char* Qp, int r32, int hi) {
    p0 = f32x16{}; p1 = f32x16{};
#pragma unroll
    for (int d0 = 0; d0 < 8; ++d0) { const int cb = (d0 * 16 + hi * 8) * 2;
        const bf16x8 b0 = *reinterpret_cast<const bf16x8*>(Ks + KSWZ(r32, cb));
        const bf16x8 b1 = *reinterpret_cast<const bf16x8*>(Ks + KSWZ(32 + r32, cb));
        p0 = __builtin_amdgcn_mfma_f32_32x32x16_bf16(b0, qr[d0], p0, 0, 0, 0);
        p1 = __builtin_amdgcn_mfma_f32_32x32x16_bf16(b1, qr[d0], p1, 0, 0, 0); }
#pragma unroll
    for (int d0 = 0; d0 < 4; ++d0) { const int cb = (d0 * 16 + hi * 8) * 2;
        const bf16x8 b0 = *reinterpret_cast<const bf16x8*>(Rs + RSWZ(r32, cb));
        const bf16x8 b1 = *reinterpret_cast<const bf16x8*>(Rs + RSWZ(32 + r32, cb));
        const bf16x8 qq = *reinterpret_cast<const bf16x8*>(Qp + RSWZ(r32, cb));
        p0 = __builtin_amdgcn_mfma_f32_32x32x16_bf16(b0, qq, p0, 0, 0, 0);
        p1 = __builtin_amdgcn_mfma_f32_32x32x16_bf16(b1, qq, p1, 0, 0, 0); }
}
__device__ __forceinline__ int v_st(int k, int c) { const int kk = (k & ~0xC) | ((k & 4) << 1) | ((k & 8) >> 1); return ((kk >> 3) * 4 + (c >> 5)) * 512 + ((kk & 7) * 32 + (c & 31)) * 2; }
__device__ __forceinline__ int v_rd_base(int lane) { return ((lane & 3) << 3) | (((lane >> 2) & 3) << 6) | (((lane >> 4) & 1) << 5) | (((lane >> 5) & 1) << 8); }
constexpr int v_rd_off(int d0, int ks, int half) { return d0 * 512 + ks * 4096 + half * 2048; }
template <int OFF> __device__ __forceinline__ s16x4 tr_read(int vb) {
    s16x4 r; asm volatile("ds_read_b64_tr_b16 %0, %1 offset:%2" : "=&v"(r) : "v"(vb), "i"(OFF) : "memory"); return r;
}
template <int D0> __device__ __forceinline__ void pv_one(f32x16& od, int vb, bf16x8 pa0, bf16x8 pa1, bf16x8 pa2, bf16x8 pa3) {
    const s16x4 l0 = tr_read<v_rd_off(D0, 0, 0)>(vb), h0 = tr_read<v_rd_off(D0, 0, 1)>(vb), l1 = tr_read<v_rd_off(D0, 1, 0)>(vb), h1 = tr_read<v_rd_off(D0, 1, 1)>(vb);
    const s16x4 l2 = tr_read<v_rd_off(D0, 2, 0)>(vb), h2 = tr_read<v_rd_off(D0, 2, 1)>(vb), l3 = tr_read<v_rd_off(D0, 3, 0)>(vb), h3 = tr_read<v_rd_off(D0, 3, 1)>(vb);
    asm volatile("s_waitcnt lgkmcnt(0)" ::: "memory"); SBAR();
#define PK(L, H) (bf16x8){L[0], L[1], L[2], L[3], H[0], H[1], H[2], H[3]}
    od = __builtin_amdgcn_mfma_f32_32x32x16_bf16(pa0, PK(l0, h0), od, 0, 0, 0);
    od = __builtin_amdgcn_mfma_f32_32x32x16_bf16(pa1, PK(l1, h1), od, 0, 0, 0);
    od = __builtin_amdgcn_mfma_f32_32x32x16_bf16(pa2, PK(l2, h2), od, 0, 0, 0);
    od = __builtin_amdgcn_mfma_f32_32x32x16_bf16(pa3, PK(l3, h3), od, 0, 0, 0);
#undef PK
}
__device__ __forceinline__ void pv_d0(f32x16* o, int vb, bf16x8 pa0, bf16x8 pa1, bf16x8 pa2, bf16x8 pa3) {
    pv_one<0>(o[0], vb, pa0, pa1, pa2, pa3); pv_one<1>(o[1], vb, pa0, pa1, pa2, pa3); pv_one<2>(o[2], vb, pa0, pa1, pa2, pa3); pv_one<3>(o[3], vb, pa0, pa1, pa2, pa3);
}
__device__ __forceinline__ void attn_body(const bf16_t* __restrict__ Qb, const bf16_t* __restrict__ Kh, const bf16_t* __restrict__ Vh, const bf16_t* __restrict__ Rh,
                                          bf16_t* __restrict__ Zb, int seq, char* lds, int wv, bool nowrite) {
    const int tid = opaque_tid(wv), wid = wv, lane = tid & 63, r32 = lane & 31, hi = lane >> 5;
    char* V_lds = lds + OFF_V; char* K_lds = lds + OFF_K; char* R_lds = lds + OFF_R;
    float* ws = (float*)(lds + OFF_WS) + wid * 64; float* li_l = ws; float* al_l = ws + 32;
    float m_reg = -1e30f, l_reg = 0; f32x16 o[4] = {}; bf16x8 qr[8];
    const bf16_t* Qw = Qb + (long)(wid * QBLK + r32) * LDQ + hi * 8;
    char* Qp = lds + OFF_QR + wid * 4096;
#pragma unroll
    for (int d0 = 0; d0 < 8; ++d0) qr[d0] = *reinterpret_cast<const bf16x8*>(Qw + d0 * 16);
#pragma unroll
    for (int d0 = 0; d0 < 4; ++d0) *reinterpret_cast<bf16x8*>(Qp + RSWZ(r32, (d0 * 16 + hi * 8) * 2)) = *reinterpret_cast<const bf16x8*>(Qw + 128 + d0 * 16);
    const int sr = tid >> 4, sc = (tid & 15) * 8, vst0 = v_st(sr, sc), vst1 = v_st(32 + sr, sc);
    const int rr = tid >> 3, rc = (tid & 7) * 8;
    const int vb0 = (int)(uintptr_t)(LAS char*)V_lds + v_rd_base(lane);
    bf16x8 vs0, vs1, ks0, ks1, rs0;
#define SLOAD(k0) do { vs0 = *reinterpret_cast<const bf16x8*>(&Vh[(long)((k0) + sr) * LDK + sc]); vs1 = *reinterpret_cast<const bf16x8*>(&Vh[(long)((k0) + 32 + sr) * LDK + sc]); \
    ks0 = *reinterpret_cast<const bf16x8*>(&Kh[(long)((k0) + sr) * LDK + sc]); ks1 = *reinterpret_cast<const bf16x8*>(&Kh[(long)((k0) + 32 + sr) * LDK + sc]); \
    rs0 = *reinterpret_cast<const bf16x8*>(&Rh[(long)((k0) + rr) * LDR + rc]); } while (0)
#define SWRITE(b) do { *(bf16x8*)(V_lds + (b) * SHM_V + vst0) = vs0; *(bf16x8*)(V_lds + (b) * SHM_V + vst1) = vs1; const int kc = sc * 2; \
    *(bf16x8*)(K_lds + (b) * SHM_K + KSWZ(sr, kc)) = ks0; *(bf16x8*)(K_lds + (b) * SHM_K + KSWZ(32 + sr, kc)) = ks1; \
    *(bf16x8*)(R_lds + (b) * SHM_R + RSWZ(rr, rc * 2)) = rs0; } while (0)
#define SWAIT() asm volatile("s_waitcnt vmcnt(0)" ::: "memory")
#define RESC(a) do { if (__any((a) < 1.f)) { if (hi == 0) al_l[r32] = (a); asm volatile("s_waitcnt lgkmcnt(0)" ::: "memory"); \
    _Pragma("unroll") for (int d = 0; d < 4; ++d) _Pragma("unroll") for (int r = 0; r < 16; ++r) o[d][r] *= al_l[crow(r, hi)]; } } while (0)
    f32x16 pA0, pA1, pB0, pB1; float mnA, mnB, alA, alB; bf16x8 pa0, pa1, pa2, pa3; const int NT = seq / KVBLK;
    SLOAD(0); SWAIT(); SWRITE(0); __syncthreads();
    qkt(pA0, pA1, K_lds, R_lds, qr, Qp, r32, hi); partialSM(pA0, pA1, m_reg, mnA, alA);
    SLOAD(KVBLK);
    SWAIT(); SWRITE(1); __syncthreads();
    for (int j = 1; j + 1 < NT; j += 2) {
        SBAR(); qkt(pB0, pB1, K_lds + SHM_K, R_lds + SHM_R, qr, Qp, r32, hi);
        finishSM(pA0, pA1, alA, l_reg, pa0, pa1, pa2, pa3); SBAR();
        SLOAD((j + 1) * KVBLK); SBAR();
        pv_d0(o, vb0, pa0, pa1, pa2, pa3); partialSM(pB0, pB1, m_reg, mnB, alB);
        __syncthreads(); SWAIT(); SWRITE(0);
        RESC(alB); __syncthreads();
        SBAR(); qkt(pA0, pA1, K_lds, R_lds, qr, Qp, r32, hi);
        finishSM(pB0, pB1, alB, l_reg, pa0, pa1, pa2, pa3); SBAR();
        SLOAD((j + 2) * KVBLK); SBAR();
        pv_d0(o, vb0 + SHM_V, pa0, pa1, pa2, pa3); partialSM(pA0, pA1, m_reg, mnA, alA);
        __syncthreads(); SWAIT(); SWRITE(1);
        RESC(alA); __syncthreads();
    }
    SBAR(); qkt(pB0, pB1, K_lds + SHM_K, R_lds + SHM_R, qr, Qp, r32, hi);
    finishSM(pA0, pA1, alA, l_reg, pa0, pa1, pa2, pa3); SBAR();
    pv_d0(o, vb0, pa0, pa1, pa2, pa3); partialSM(pB0, pB1, m_reg, mnB, alB);
    __syncthreads(); RESC(alB);
    finishSM(pB0, pB1, alB, l_reg, pa0, pa1, pa2, pa3); SBAR();
    pv_d0(o, vb0 + SHM_V, pa0, pa1, pa2, pa3);
    if (hi == 0) li_l[r32] = l_reg; asm volatile("s_waitcnt lgkmcnt(0)" ::: "memory");
    float rli[16];
#pragma unroll
    for (int r = 0; r < 16; ++r) rli[r] = __builtin_amdgcn_rcpf(li_l[crow(r, hi)]);
    bf16_t* Zw = Zb + (long)(wid * QBLK + 4 * hi) * LDZ + r32;
    unsigned short zq[16][4];
#pragma unroll
    for (int r = 0; r < 16; ++r)
#pragma unroll
        for (int d0 = 0; d0 < 4; ++d0) zq[r][d0] = Zw[(long)((r & 3) + 8 * (r >> 2)) * LDZ + d0 * 32];
    asm volatile("s_waitcnt vmcnt(0)" ::: "memory"); SBAR();
#pragma unroll
    for (int r = 0; r < 16; ++r) {
#pragma unroll
        for (int d0 = 0; d0 < 4; ++d0) { const float z = bf2f(zq[r][d0]);
            if (!nowrite) Zw[(long)((r & 3) + 8 * (r >> 2)) * LDZ + d0 * 32] = (bf16_t)(cvt_pk_bf16(o[d0][r] * rli[r] * silu_f(z), 0.f) & 0xffffu); } }
    __syncthreads();
#undef SLOAD
#undef SWRITE
#undef SWAIT
#undef RESC
}
__device__ __forceinline__ void phase_attn(const bf16_t* QH, const bf16_t* KNH, const bf16_t* VH, const bf16_t* KRO, bf16_t* Z, int half, char* lds, int wv, bool nowrite) {
    const int c = blockIdx.x, G = gridDim.x;
    const int per = 2048 / G;
    for (int i = 0; i < per; ++i) {
        int bh, qb;
        if (G == 256) { const int xcd = c & 7, slot = c >> 3; bh = i * 32 + xcd * 4 + (slot >> 3); qb = slot & 7; }
        else { const int u = i * G + c; bh = u >> 3; qb = u & 7; }
        const int bl = bh >> 4, h = bh & 15;
        const size_t lrow = (size_t)bl * SEQ, grow = (size_t)half * TH + lrow;
        attn_body(QH + (lrow + qb * 256) * LDQ + h * 192, KNH + lrow * LDK + h * 128, VH + lrow * LDK + h * 128, KRO + grow * 64,
                  Z + (grow + qb * 256) * LDZ + h * 128, SEQ, lds, wv, nowrite);
    }
}
}

#ifndef SC_MASK
#define SC_MASK 0xFFFF
#endif
#define SCB(i) do { if (SC_MASK & (1 << (i))) __builtin_amdgcn_sched_barrier(0); } while (0)
namespace scan {
constexpr int QE_ST = 272, KE_ST = 320, P_ST = 144, V_ST = 576, BC_ST = 528;
constexpr int OFF_QE = 0, OFF_KE = OFF_QE + 64 * QE_ST, OFF_P = OFF_KE + 64 * KE_ST, OFF_V = OFF_P + 64 * P_ST, OFF_BC = OFF_V + 64 * V_ST,
              OFF_GLR = OFF_BC + 64 * BC_ST, OFF_PART = OFF_GLR + 4096, OFF_EBT = OFF_PART + 2048, OFF_WG = OFF_EBT + 512, OFF_SSQW = OFF_WG + 8192, OFF_RN = OFF_SSQW + 2048, OFF_G = OFF_RN + 256, OFF_END = OFF_G + 1024;
static_assert(OFF_END <= LDS_BYTES, "scan LDS");
template <int OFF> __device__ __forceinline__ s16x4 tr_read(int vb) {
    s16x4 r; asm volatile("ds_read_b64_tr_b16 %0, %1 offset:%2" : "=&v"(r) : "v"(vb), "i"(OFF) : "memory"); return r;
}
#define PK8(L, H) (bf16x8){L[0], L[1], L[2], L[3], H[0], H[1], H[2], H[3]}
#define LAUNDER(t) const int t = opaque_tid(wv)
__device__ __forceinline__ void phase_scan(const bf16_t* QK, const bf16_t* V, const float* GLR, bf16_t* OFW, const float* wgate, const float* bgate, char* lds, int wv,
                                           bf16_t* Z, const float* gn, unsigned long long* X, unsigned tag) {
    const int wid = wv;
    if (wv >= 4) __builtin_amdgcn_s_setprio(1);
    for (int item = blockIdx.x; item < 256; item += gridDim.x) {
        const int b = item >> 3, h = (item >> 1) & 3, vh = item & 1;
        __syncthreads();
        { LAUNDER(t); if (t < 256) *(float*)(lds + OFF_G + t * 4) = gn[h * 512 + vh * 256 + t]; }
        for (int dir = 0; dir < 2; ++dir) {
            __syncthreads();
            float bgv; float wgb[8];
            { LAUNDER(t); const int ln = t & 63, r32_ = ln & 31, hi_ = ln >> 5, db_ = wid & 3;
#pragma unroll
              for (int kk = 0; kk < 8; ++kk) wgb[kk] = wgate[((size_t)dir * 16 + 2 * kk + hi_) * 512 + h * 128 + db_ * 32 + r32_];
              bgv = bgate[(size_t)dir * 512 + h * 128 + db_ * 32 + r32_]; }
            f32x16 S[4];
#pragma unroll
            for (int i = 0; i < 4; ++i) S[i] = f32x16{};
            bf16x8 rq[2], rk[2], rv[4]; f32x2 rg;
#define CLOAD_QK(n) do { LAUNDER(t_); const unsigned qo_ = (unsigned)((t_ >> 4) * 1024 + (t_ & 15) * 8) * 2u; const size_t t0_ = (size_t)b * SEQ + (size_t)(n) * 64; const char* qb_ = (const char*)QK + (t0_ * 1024 + h * 128) * 2; \
    rq[0] = *(const bf16x8*)(qb_ + qo_); rq[1] = *(const bf16x8*)(qb_ + 65536 + qo_); rk[0] = *(const bf16x8*)(qb_ + 1024 + qo_); rk[1] = *(const bf16x8*)(qb_ + 1024 + 65536 + qo_); } while (0)
#define CLOAD_VG(n) do { LAUNDER(t_); const unsigned vo_ = (unsigned)((t_ >> 5) * 2048 + (t_ & 31) * 8) * 2u, go_ = (unsigned)((t_ >> 3) * 32 + (t_ & 7) * 2) * 4u; const size_t t0_ = (size_t)b * SEQ + (size_t)(n) * 64; \
    const char* vb_ = (const char*)V + (t0_ * 2048 + h * 512 + vh * 256) * 2; const char* gb_ = (const char*)GLR + (t0_ * 32 + dir * 16) * 4; \
    _Pragma("unroll") for (int i = 0; i < 4; ++i) rv[i] = *(const bf16x8*)(vb_ + (size_t)i * 65536 + vo_); \
    rg = *(const f32x2*)(gb_ + go_); } while (0)
            CLOAD_QK(dir == 0 ? 0 : 31); CLOAD_VG(dir == 0 ? 0 : 31);
#define LBAR() do { asm volatile("s_waitcnt lgkmcnt(0)" ::: "memory"); __builtin_amdgcn_s_barrier(); asm volatile("" ::: "memory"); } while (0)
#define STAGE_VG() do { LAUNDER(t_); const int vr = t_ >> 5, vc = (t_ & 31) * 8, gr = t_ >> 3, gc = (t_ & 7) * 2; \
    _Pragma("unroll") for (int i = 0; i < 4; ++i) *(bf16x8*)(lds + OFF_V + (vr + 16 * i) * V_ST + vc * 2) = rv[i]; \
    *(f32x2*)(lds + OFF_GLR + gr * 64 + gc * 4) = rg; } while (0)
#define XSLOT(nc, half_) (X + ((((size_t)(b * 4 + h) * 32 + (nc)) * 2 + (half_)) * 64))
#define GN_PUBLISH(nc) do { if (wid == 0) { LAUNDER(t_); const int ln_ = t_ & 63; float own_ = 0.f; \
    _Pragma("unroll") for (int w_ = 0; w_ < 8; ++w_) own_ += *(const float*)(lds + OFF_SSQW + (w_ * 64 + ln_) * 4); hown = own_; \
    const unsigned long long g_ = ((unsigned long long)tag << 32) | (unsigned long long)__float_as_uint(own_); \
    __hip_atomic_store(XSLOT(nc, vh) + ln_, g_, __ATOMIC_RELAXED, __HIP_MEMORY_SCOPE_AGENT); } } while (0)
#define GN_POLL(nc) do { if (wid == 0) { LAUNDER(t_); const int ln_ = t_ & 63; unsigned long long g_ = 0ull; unsigned sp_ = 0u; \
    for (;;) { g_ = __hip_atomic_load(XSLOT(nc, vh ^ 1) + ln_, __ATOMIC_RELAXED, __HIP_MEMORY_SCOPE_AGENT); if ((unsigned)(g_ >> 32) == tag || ++sp_ > (1u << 22)) break; __builtin_amdgcn_s_sleep(1); } \
    const float tot_ = hown + __uint_as_float((unsigned)g_); *(float*)(lds + OFF_RN + ln_ * 4) = rsqrtf(tot_ * (1.f / 512.f) + EPS); } } while (0)
#define GN_FINAL(nc) do { LAUNDER(t_); const int ln_ = t_ & 63; const float r_ = *(const float*)(lds + OFF_RN + ln_ * 4); \
    bf16_t* zr_ = Z + ((size_t)b * SEQ + (size_t)(nc) * 64 + ln_) * 2048 + h * 512 + vh * 256 + wid * 32; \
    _Pragma("unroll") for (int j_ = 0; j_ < 4; ++j_) { const f32x4 g0_ = *(const f32x4*)(lds + OFF_G + (wid * 32 + j_ * 8) * 4), g1_ = *(const f32x4*)(lds + OFF_G + (wid * 32 + j_ * 8 + 4) * 4); \
        const f32x4 a_ = hs[2 * j_], c_ = hs[2 * j_ + 1]; const u32x4 z_ = hz[j_]; \
        u32x4 w_ = {cvt_pk_bf16(a_[0] * r_ * g0_[0] * silu_fast(bflo(z_[0])), a_[1] * r_ * g0_[1] * silu_fast(bfhi(z_[0]))), cvt_pk_bf16(a_[2] * r_ * g0_[2] * silu_fast(bflo(z_[1])), a_[3] * r_ * g0_[3] * silu_fast(bfhi(z_[1]))), \
                    cvt_pk_bf16(c_[0] * r_ * g1_[0] * silu_fast(bflo(z_[2])), c_[1] * r_ * g1_[1] * silu_fast(bfhi(z_[2]))), cvt_pk_bf16(c_[2] * r_ * g1_[2] * silu_fast(bflo(z_[3])), c_[3] * r_ * g1_[3] * silu_fast(bfhi(z_[3])))}; \
        *(u32x4*)(zr_ + j_ * 8) = w_; __builtin_amdgcn_sched_barrier(0); } } while (0)
            STAGE_VG();
            CLOAD_VG(dir == 0 ? 1 : 30);
            LBAR();
            for (int step = 0; step < 32; ++step) {
                const int n = dir == 0 ? step : 31 - step;
                const size_t t0 = (size_t)b * SEQ + (size_t)n * 64;
                {
                    LAUNDER(t); const int ln = t & 63, r32 = ln & 31, hi = ln >> 5, cb = wid >> 2, db = wid & 3, d = db * 32 + r32;
                    f32x4 ar[4];
#pragma unroll
                    for (int i = 0; i < 4; ++i) ar[i] = *(const f32x4*)(lds + OFF_GLR + (cb * 32 + r32) * 64 + i * 16);
                    asm volatile("s_waitcnt lgkmcnt(0)" ::: "memory"); __builtin_amdgcn_sched_barrier(0);
                    f32x16 pa, pb;
#pragma unroll
                    for (int r = 0; r < 16; ++r) pa[r] = bgv;
#pragma unroll
                    for (int kk = 0; kk < 8; kk += 2) {
                        const float a0 = hi ? ar[kk >> 1][1] : ar[kk >> 1][0], a1 = hi ? ar[kk >> 1][3] : ar[kk >> 1][2];
                        pa = __builtin_amdgcn_mfma_f32_32x32x2f32(a0, wgb[kk], pa, 0, 0, 0);
                        pb = __builtin_amdgcn_mfma_f32_32x32x2f32(a1, wgb[kk + 1], kk == 0 ? f32x16{} : pb, 0, 0, 0); }
                    pa += pb;
                    float lgv[16], pl[16];
#pragma unroll
                    for (int r = 0; r < 16; ++r) { const float pre = pa[r]; lgv[r] = -(fmaxf(-pre, 0.f) + __logf(1.f + __expf(-fabsf(pre)))) * (0.0625f * 1.4426950408889634f); }
#pragma unroll
                    for (int k = 0; k < 4; ++k) { pl[4 * k] = lgv[4 * k]; pl[4 * k + 1] = pl[4 * k] + lgv[4 * k + 1]; pl[4 * k + 2] = pl[4 * k + 1] + lgv[4 * k + 2]; pl[4 * k + 3] = pl[4 * k + 2] + lgv[4 * k + 3]; }
#pragma unroll
                    for (int k = 0; k < 4; ++k) *(float*)(lds + OFF_P + ((cb * 8 + 2 * k + hi) * 128 + d) * 4) = pl[4 * k + 3];
                    LBAR();
                    float gsv[16];
#pragma unroll
                    for (int g = 0; g < 16; ++g) gsv[g] = *(const float*)(lds + OFF_P + (g * 128 + d) * 4);
                    asm volatile("s_waitcnt lgkmcnt(0)" ::: "memory"); __builtin_amdgcn_sched_barrier(0);
                    float ex[16]; float run = 0.f;
#pragma unroll
                    for (int g = 0; g < 16; ++g) { ex[g] = run; run += gsv[g]; }
                    const float tot = run;
#pragma unroll
                    for (int k = 0; k < 4; ++k) { const float e0 = cb ? ex[8 + 2 * k] : ex[2 * k], e1 = cb ? ex[8 + 2 * k + 1] : ex[2 * k + 1]; const float off = hi ? e1 : e0;
#pragma unroll
                        for (int e = 0; e < 4; ++e) { const int r = 4 * k + e; const float bc = dir == 0 ? off + pl[r] : tot - (off + pl[r] - lgv[r]);
                            *(float*)(lds + OFF_BC + (cb * 32 + e + 8 * k + 4 * hi) * BC_ST + d * 4) = bc; } }
                    if (cb == 0 && hi == 0) *(float*)(lds + OFF_EBT + d * 4) = __builtin_amdgcn_exp2f(tot);
                }
                LBAR();
                { LAUNDER(t); const int sr = t >> 4, sc = (t & 15) * 8;
#pragma unroll
                  for (int i = 0; i < 2; ++i) { const int row = sr + 32 * i;
                    const f32x4 b0 = *(const f32x4*)(lds + OFF_BC + row * BC_ST + sc * 4), b1 = *(const f32x4*)(lds + OFF_BC + row * BC_ST + sc * 4 + 16);
                    const bf16x8 qv = rq[i], kv = rk[i];
                    float qf[8], kf[8];
#pragma unroll
                    for (int e = 0; e < 8; ++e) { const float bb = e < 4 ? b0[e] : b1[e - 4]; const float eb = __builtin_amdgcn_exp2f(bb), ei = __builtin_amdgcn_exp2f(-bb);
                        qf[e] = bf2f((unsigned short)qv[e]) * eb; kf[e] = bf2f((unsigned short)kv[e]) * ei; }
                    u32x4 qw = {cvt_pk_bf16(qf[0], qf[1]), cvt_pk_bf16(qf[2], qf[3]), cvt_pk_bf16(qf[4], qf[5]), cvt_pk_bf16(qf[6], qf[7])};
                    u32x4 kw = {cvt_pk_bf16(kf[0], kf[1]), cvt_pk_bf16(kf[2], kf[3]), cvt_pk_bf16(kf[4], kf[5]), cvt_pk_bf16(kf[6], kf[7])};
                    *(u32x4*)(lds + OFF_QE + row * QE_ST + sc * 2) = qw; *(u32x4*)(lds + OFF_KE + row * KE_ST + sc * 2) = kw; } }
                if (step + 1 < 32) { const int nn = dir == 0 ? step + 1 : 30 - step; CLOAD_QK(nn); }
                u32x4 pf[4];
                bf16_t* orow;
                { LAUNDER(t); const int ln = t & 63; orow = OFW + ((((size_t)item * 32 + n) * 8 + wid) * 256 + ln) * 8; }
                if (dir == 1) {
#pragma unroll
                    for (int j = 0; j < 4; ++j) pf[j] = *(const u32x4*)(orow + j * 512);
                }
                LBAR();
                { LAUNDER(t); const int fr = t & 15, fq = (t >> 4) & 3;
#pragma unroll
                  for (int tt = 0; tt < 2; ++tt) { const int tl = wid * 2 + tt, it = tl >> 2, jt = tl & 3;
                    f32x4 pc = {0.f, 0.f, 0.f, 0.f};
                    bf16x8 af[4], bfg[4];
#pragma unroll
                    for (int ks = 0; ks < 4; ++ks) {
                        af[ks] = *(const bf16x8*)(lds + OFF_KE + (jt * 16 + fr) * KE_ST + (ks * 32 + fq * 8) * 2);
                        bfg[ks] = *(const bf16x8*)(lds + OFF_QE + (it * 16 + fr) * QE_ST + (ks * 32 + fq * 8) * 2); }
                    asm volatile("s_waitcnt lgkmcnt(0)" ::: "memory"); SCB(1);
#pragma unroll
                    for (int ks = 0; ks < 4; ++ks) pc = __builtin_amdgcn_mfma_f32_16x16x32_bf16(af[ks], bfg[ks], pc, 0, 0, 0);
                    const int ii = it * 16 + fr, j0 = jt * 16 + fq * 4;
                    float pm[4];
#pragma unroll
                    for (int e = 0; e < 4; ++e) pm[e] = (dir == 0 ? (j0 + e <= ii) : (j0 + e >= ii)) ? pc[e] : 0.f;
                    u32x2 pw = {cvt_pk_bf16(pm[0], pm[1]), cvt_pk_bf16(pm[2], pm[3])};
                    *(u32x2*)(lds + OFF_P + ii * P_ST + j0 * 2) = pw; } }
                bf16x8 vf[4];
                f32x16 o0 = f32x16{}, o1 = f32x16{};
                {
                    LAUNDER(t); const int ln = t & 63, hi = ln >> 5, r32 = ln & 31, m16 = ln & 15, g16 = (ln >> 4) & 1;
                    const int ldsb = (int)(uintptr_t)(LAS char*)lds;
                    const int trv = ldsb + OFF_V + (8 * hi + (m16 >> 2)) * V_ST + (wid * 32 + 16 * g16 + 4 * (m16 & 3)) * 2;
                    const int trk = ldsb + OFF_KE + (8 * hi + (m16 >> 2)) * KE_ST + (16 * g16 + 4 * (m16 & 3)) * 2;
                    {
                    const s16x4 l0 = tr_read<0 * 16 * V_ST>(trv), h0 = tr_read<0 * 16 * V_ST + 4 * V_ST>(trv), l1 = tr_read<1 * 16 * V_ST>(trv), h1 = tr_read<1 * 16 * V_ST + 4 * V_ST>(trv);
                    const s16x4 l2 = tr_read<2 * 16 * V_ST>(trv), h2 = tr_read<2 * 16 * V_ST + 4 * V_ST>(trv), l3 = tr_read<3 * 16 * V_ST>(trv), h3 = tr_read<3 * 16 * V_ST + 4 * V_ST>(trv);
                    asm volatile("s_waitcnt lgkmcnt(0)" ::: "memory"); SCB(2);
                    vf[0] = PK8(l0, h0); vf[1] = PK8(l1, h1); vf[2] = PK8(l2, h2); vf[3] = PK8(l3, h3);
                    }
                    const char* qa = lds + OFF_QE + r32 * QE_ST + 8 * hi;
#pragma unroll
                    for (int db = 0; db < 4; ++db) {
                        s16x4 al[2][2], ah[2][2];
#pragma unroll
                        for (int s = 0; s < 2; ++s) { const int dcol = (db * 32 + 16 * s) * 2;
                            al[s][0] = *(const s16x4*)(qa + dcol); ah[s][0] = *(const s16x4*)(qa + dcol + 16);
                            al[s][1] = *(const s16x4*)(qa + 32 * QE_ST + dcol); ah[s][1] = *(const s16x4*)(qa + 32 * QE_ST + dcol + 16); }
                        bf16x8 bfr[2];
#pragma unroll
                        for (int s = 0; s < 2; ++s) {
                            u32x4 bw = {cvt_pk_bf16(S[db][8 * s + 0], S[db][8 * s + 1]), cvt_pk_bf16(S[db][8 * s + 2], S[db][8 * s + 3]),
                                        cvt_pk_bf16(S[db][8 * s + 4], S[db][8 * s + 5]), cvt_pk_bf16(S[db][8 * s + 6], S[db][8 * s + 7])};
                            bfr[s] = *reinterpret_cast<bf16x8*>(&bw); }
                        asm volatile("s_waitcnt lgkmcnt(0)" ::: "memory"); SCB(3);
#pragma unroll
                        for (int s = 0; s < 2; ++s) {
                            o0 = __builtin_amdgcn_mfma_f32_32x32x16_bf16(PK8(al[s][0], ah[s][0]), bfr[s], o0, 0, 0, 0);
                            o1 = __builtin_amdgcn_mfma_f32_32x32x16_bf16(PK8(al[s][1], ah[s][1]), bfr[s], o1, 0, 0, 0); }
                    }
                    const char* ebp = lds + OFF_EBT + 16 * hi;
#define SUPD(DB) do { \
    const s16x4 l0 = tr_read<(DB) * 64 + 0 * 16 * KE_ST>(trk), h0 = tr_read<(DB) * 64 + 0 * 16 * KE_ST + 4 * KE_ST>(trk), l1 = tr_read<(DB) * 64 + 1 * 16 * KE_ST>(trk), h1 = tr_read<(DB) * 64 + 1 * 16 * KE_ST + 4 * KE_ST>(trk); \
    const s16x4 l2 = tr_read<(DB) * 64 + 2 * 16 * KE_ST>(trk), h2 = tr_read<(DB) * 64 + 2 * 16 * KE_ST + 4 * KE_ST>(trk), l3 = tr_read<(DB) * 64 + 3 * 16 * KE_ST>(trk), h3 = tr_read<(DB) * 64 + 3 * 16 * KE_ST + 4 * KE_ST>(trk); \
    asm volatile("s_waitcnt lgkmcnt(0)" ::: "memory"); SCB(4); \
    S[DB] = __builtin_amdgcn_mfma_f32_32x32x16_bf16(PK8(l0, h0), vf[0], S[DB], 0, 0, 0); \
    S[DB] = __builtin_amdgcn_mfma_f32_32x32x16_bf16(PK8(l1, h1), vf[1], S[DB], 0, 0, 0); \
    S[DB] = __builtin_amdgcn_mfma_f32_32x32x16_bf16(PK8(l2, h2), vf[2], S[DB], 0, 0, 0); \
    S[DB] = __builtin_amdgcn_mfma_f32_32x32x16_bf16(PK8(l3, h3), vf[3], S[DB], 0, 0, 0); \
    _Pragma("unroll") for (int g = 0; g < 4; ++g) { const f32x4 eb = *(const f32x4*)(ebp + ((DB) * 32 + 8 * g) * 4); \
        S[DB][4 * g + 0] *= eb[0]; S[DB][4 * g + 1] *= eb[1]; S[DB][4 * g + 2] *= eb[2]; S[DB][4 * g + 3] *= eb[3]; } asm volatile("" : "+v"(S[DB])); } while (0)
                    SUPD(0); SUPD(1); SUPD(2); SUPD(3);
#undef SUPD
                }
                LBAR();
                if (step + 1 < 32) { STAGE_VG(); if (step + 2 < 32) { const int nn = dir == 0 ? step + 2 : 29 - step; CLOAD_VG(nn); } }

                {
                    LAUNDER(t); const int ln = t & 63, hi = ln >> 5, r32 = ln & 31;
                    const char* pa = lds + OFF_P + r32 * P_ST + 16 * hi;
                    bf16x8 pa0[4], pa1[4];
#pragma unroll
                    for (int ks = 0; ks < 4; ++ks) { pa0[ks] = *(const bf16x8*)(pa + ks * 32); pa1[ks] = *(const bf16x8*)(pa + 32 * P_ST + ks * 32); }
                    asm volatile("s_waitcnt lgkmcnt(0)" ::: "memory"); SCB(5);
#pragma unroll
                    for (int ks = 0; ks < 4; ++ks) {
                        o0 = __builtin_amdgcn_mfma_f32_32x32x16_bf16(pa0[ks], vf[ks], o0, 0, 0, 0);
                        o1 = __builtin_amdgcn_mfma_f32_32x32x16_bf16(pa1[ks], vf[ks], o1, 0, 0, 0);
                    }
                    if (dir == 0) {
#pragma unroll
                        for (int j = 0; j < 4; ++j) {
                            u32x4 w;
                            if (j < 2) w = (u32x4){cvt_pk_bf16(o0[8 * j + 0], o0[8 * j + 1]), cvt_pk_bf16(o0[8 * j + 2], o0[8 * j + 3]), cvt_pk_bf16(o0[8 * j + 4], o0[8 * j + 5]), cvt_pk_bf16(o0[8 * j + 6], o0[8 * j + 7])};
                            else { const int k = j - 2; w = (u32x4){cvt_pk_bf16(o1[8 * k + 0], o1[8 * k + 1]), cvt_pk_bf16(o1[8 * k + 2], o1[8 * k + 3]), cvt_pk_bf16(o1[8 * k + 4], o1[8 * k + 5]), cvt_pk_bf16(o1[8 * k + 6], o1[8 * k + 7])}; }
                            *(u32x4*)(orow + j * 512) = w;
                        }
                    } else {
#pragma unroll
                        for (int j = 0; j < 2; ++j)
#pragma unroll
                            for (int e = 0; e < 4; ++e) { o0[8 * j + 2 * e] += bflo(pf[j][e]); o0[8 * j + 2 * e + 1] += bfhi(pf[j][e]); o1[8 * j + 2 * e] += bflo(pf[2 + j][e]); o1[8 * j + 2 * e + 1] += bfhi(pf[2 + j][e]); }
                        char* ost = lds + (wid < 4 ? OFF_QE + wid * 8192 : OFF_BC + (wid - 4) * 8192);
#pragma unroll
                        for (int r = 0; r < 16; ++r) { const int ic = (r & 3) + 8 * (r >> 2) + 4 * hi;
                            const int sw = ((((r32 >> 2) ^ (ic & 7)) << 4) | ((r32 & 3) << 2));
                            *(float*)(ost + ic * 128 + sw) = o0[r]; *(float*)(ost + (32 + ic) * 128 + sw) = o1[r]; }
                        asm volatile("s_waitcnt lgkmcnt(0)" ::: "memory"); __builtin_amdgcn_sched_barrier(0);
                        f32x4 oa[4], oc[4];
#pragma unroll
                        for (int j = 0; j < 4; ++j) { oa[j] = *(const f32x4*)(ost + ln * 128 + (((2 * j) ^ (ln & 7)) << 4)); oc[j] = *(const f32x4*)(ost + ln * 128 + (((2 * j + 1) ^ (ln & 7)) << 4)); }
                        asm volatile("s_waitcnt lgkmcnt(0)" ::: "memory"); SCB(6);
                        f32x4 hs[8]; u32x4 hz[4]; float hown = 0.f;
                        float ss = 0.f;
#pragma unroll
                        for (int j = 0; j < 4; ++j) {
                            const f32x4 a = oa[j], c = oc[j];
                            ss += a[0] * a[0] + a[1] * a[1] + a[2] * a[2] + a[3] * a[3] + c[0] * c[0] + c[1] * c[1] + c[2] * c[2] + c[3] * c[3];
                            hs[2 * j] = a; hs[2 * j + 1] = c;
                        }
                        *(float*)(lds + OFF_SSQW + (wid * 64 + ln) * 4) = ss;
                        const bf16_t* zr = Z + (t0 + ln) * 2048 + h * 512 + vh * 256 + wid * 32;
#pragma unroll
                        for (int j = 0; j < 4; ++j) hz[j] = *(const u32x4*)(zr + j * 8);
                        LBAR();
                        GN_PUBLISH(n); GN_POLL(n);
                        LBAR();
                        GN_FINAL(n);
                    }
                }
                if (dir == 0) LBAR();
            }
#undef LBAR
#undef STAGE_VG
#undef XSLOT
#undef GN_PUBLISH
#undef GN_POLL
#undef GN_FINAL
#undef CLOAD_QK
#undef CLOAD_VG
        }
    }
    __builtin_amdgcn_s_setprio(0);
}
#undef LAUNDER
#undef PK8
}


#define XB_TMO      128
#define XB_XCNT(j)  (256  + 64 * (j))
#define XB_XSUB(j)  (1280 + 64 * (j))
#define XB_XGEN(j)  (2304 + 64 * (j))
#define XB_TOP      3328
#define XB_TOPGEN   3392
#define XCD_BAR_WORDS 3456
#define XB_SPIN_CAP (1u << 18)
__device__ __forceinline__ unsigned xb_ld(unsigned* p)              { return __hip_atomic_load(p, __ATOMIC_RELAXED, __HIP_MEMORY_SCOPE_AGENT); }
__device__ __forceinline__ unsigned xb_add(unsigned* p, unsigned v) { return __hip_atomic_fetch_add(p, v, __ATOMIC_RELAXED, __HIP_MEMORY_SCOPE_AGENT); }
__device__ __forceinline__ unsigned xb_xcc_id() { return (unsigned)__builtin_amdgcn_s_getreg((3 << 11) | 20) & 0xFu; }
#define XB_SPIN(cond, bar) do { unsigned _sp = 0; while (cond) { __builtin_amdgcn_s_sleep(1); \
    if ((++_sp & 255u) == 0u) { if (xb_ld(&(bar)[XB_TMO])) break; if (_sp > XB_SPIN_CAP) { atomicAdd(&(bar)[XB_TMO], 1u); break; } } } } while (0)
__device__ __forceinline__ void xcd_barrier_complete(unsigned* bar, unsigned x, unsigned& nloc, unsigned& nx) {
    const unsigned G = gridDim.x;
    unsigned sum, cnt, mine, sp = 0u;
    for (;;) {
        sum = 0u; cnt = 0u; mine = 0u;
#pragma unroll
        for (unsigned j = 0; j < 16; ++j) { const unsigned c = xb_ld(&bar[XB_XCNT(j)]); sum += c; cnt += (c > 0u) ? 1u : 0u; mine = (j == x) ? c : mine; }
        if (sum == G) break;
        __builtin_amdgcn_s_sleep(1);
        if ((++sp & 255u) == 0u) { if (xb_ld(&bar[XB_TMO])) break; if (sp > XB_SPIN_CAP) { atomicAdd(&bar[XB_TMO], 1u); break; } }
    }
    nloc = mine > 0u ? mine : 1u; nx = cnt > 0u ? cnt : 1u;
}
__device__ __forceinline__ void xcd_barrier(unsigned* bar, unsigned x, volatile LAS unsigned* st, int wv) {
    asm volatile("s_waitcnt vmcnt(0)" ::: "memory");
    __syncthreads();
    if (wv == 0 && opaque_lane() == 0) {
        __builtin_amdgcn_s_waitcnt(0);
        unsigned nloc = st[0], nx = st[1];
        if (nloc == 0u) { xcd_barrier_complete(bar, x, nloc, nx); st[0] = nloc; st[1] = nx; }
        const unsigned old = xb_add(&bar[XB_XSUB(x)], 1u);
        const unsigned gen = old / nloc;
        if (old + 1u == (gen + 1u) * nloc) {
            __builtin_amdgcn_fence(__ATOMIC_RELEASE, "agent");
            asm volatile("s_waitcnt vmcnt(0)" ::: "memory");
            const unsigned og = xb_add(&bar[XB_TOP], 1u);
            const unsigned tg = og / nx;
            if (og + 1u == (tg + 1u) * nx) xb_add(&bar[XB_TOPGEN], 1u);
            else XB_SPIN(xb_ld(&bar[XB_TOPGEN]) == tg, bar);
            __builtin_amdgcn_fence(__ATOMIC_ACQUIRE, "agent");
            xb_add(&bar[XB_XGEN(x)], 1u);
            asm volatile("s_waitcnt vmcnt(0)" ::: "memory");
        } else {
            XB_SPIN(xb_ld(&bar[XB_XGEN(x)]) == gen, bar);
            __builtin_amdgcn_fence(__ATOMIC_ACQUIRE, "agent");
            asm volatile("s_waitcnt vmcnt(0)" ::: "memory");
        }
    }
    __syncthreads();
}

constexpr int NPHASE = 23;
#ifndef MK_EN
#define MK_EN 0xFFFF
#endif
#ifndef MK_DUP
#define MK_DUP 0
#endif
#define REPS(bit) for (int rep_ = 0, nrep_ = (MK_DUP & (bit)) ? 2 : 1; rep_ < nrep_; ++rep_)
__global__ void __launch_bounds__(512, 2) mk_fwd(Params p) {
    extern __shared__ __attribute__((aligned(16))) unsigned char lds[];
    LAS unsigned char* lds3 = (LAS unsigned char*)lds;
    typedef const __attribute__((address_space(4))) Params* KP;
    const int wv = __builtin_amdgcn_readfirstlane((int)(threadIdx.x >> 6));
    volatile LAS unsigned* bst = (volatile LAS unsigned*)(lds3 + LDS_ST_OFF);
    if (threadIdx.x == 0) { bst[0] = 0u; bst[1] = 0u; }
    __syncthreads();
    const unsigned bx = xb_xcc_id();
    if (threadIdx.x == 0) (void)xb_add(&((unsigned*)(p.ws + WS_BAR))[XB_XCNT(bx)], 1u);
    const int ph_lo = p.ph_lo, ph_hi = p.ph_hi;
    if (ph_lo == 0) {
        KP pp0 = (KP)__builtin_amdgcn_kernarg_segment_ptr();
        if (MK_EN & 1) REPS(1) phase_prep(pp0, lds, wv);
        if (ph_hi > 1) cg::this_grid().sync();
    }
    const int nrounds = (MK_DUP & 4096) ? 2 : 1;
    for (int ph2 = ph_lo > 1 ? ph_lo : 1; ph2 < ph_hi * nrounds; ++ph2) {
        const int ph = ph2 >= ph_hi ? ph2 - ph_hi : ph2;
        if (ph == 0) { KP pp0 = (KP)__builtin_amdgcn_kernarg_segment_ptr(); phase_prep(pp0, lds, wv); xcd_barrier((unsigned*)(p.ws + WS_BAR), xb_xcc_id(), (volatile LAS unsigned*)(lds3 + LDS_ST_OFF), wv); continue; }
        int q = ph; asm volatile("" : "+s"(q));
        KP pp = (KP)__builtin_amdgcn_kernarg_segment_ptr(); asm volatile("" : "+s"(pp));
        unsigned char* ws = pp->ws;
        const int G = gridDim.x, c = blockIdx.x;
        int kind, L = 0, half = 0;
        if (q == 0) kind = 0;
        else { const int pr = (q - 1) / 11, r = (q - 1) % 11;
            if (r < 4) { L = 2 * pr; kind = r == 0 ? 1 : r == 1 ? 2 : r == 2 ? 4 : 5; } else { L = 2 * pr + 1; const int r2 = r - 4;
                if (r2 == 0) kind = 6; else if (r2 < 5) { half = (r2 - 1) >> 1; kind = 8 + ((r2 - 1) & 1); } else kind = r2 == 5 ? 4 : 5; } }
        const int j = L >> 1;
        float* XRES = pp->out;
        bf16_t* XB = (bf16_t*)(ws + WS_XB);
        if (kind == 1) { pg8::Gemm g{XB, (const bf16_t*)(ws + W_GIN + j * W_GIN_SZ), T, GLA_NPAD, 1024}; pg8::StaticOrder S; S.init(T, GLA_NPAD, G, c);
            pg8::EpiGlaIn E{(bf16_t*)(ws + WS_GQK), (bf16_t*)(ws + WS_GV), (bf16_t*)(ws + WS_GZ), (float*)(ws + WS_GLR)}; if (MK_EN & 2) REPS(2) pg8::gemm_phase(lds3, g, S, E, wv); }
        else if (kind == 2) { if (MK_EN & 4) scan::phase_scan((const bf16_t*)(ws + WS_GQK), (const bf16_t*)(ws + WS_GV), (const float*)(ws + WS_GLR), (bf16_t*)(ws + WS_OFW),
                                                              pp->gla_w_gate + (size_t)j * 2 * 16 * 512, pp->gla_b_gate + (size_t)j * 2 * 512, (char*)lds, wv,
                                                              (bf16_t*)(ws + WS_GZ), pp->gla_gn_g + (size_t)j * 2048, (unsigned long long*)(ws + WS_XCH), (unsigned)(j + 1)); }
        else if (kind == 3) { if (MK_EN & 8) REPS(8) phase_gla_gate((const bf16_t*)(ws + WS_OFW), (bf16_t*)(ws + WS_GZ), pp->gla_gn_g + (size_t)j * 2048, wv, rep_ + 1 < nrep_); }
        else if (kind == 4) { const bool gla = (L & 1) == 0; const float* xin = L == 0 ? pp->x : XRES;
            pg8::Gemm g{(const bf16_t*)(ws + (gla ? WS_GZ : WS_MZ)), (const bf16_t*)(ws + (gla ? W_GOUT : W_MOUT) + j * W_OUT_SZ), T, 1024, 2048}; pg8::StaticOrder S; S.init(T, 1024, G, c);
            if (MK_EN & 16) REPS(16) { pg8::EpiRes E{XRES, xin, L == 0 ? (const f32x2*)nullptr : (const f32x2*)(ws + WS_STATS), pp->ln_g + (L - 1) * 1024, pp->ln_b + (L - 1) * 1024, rep_ + 1 < nrep_}; pg8::gemm_phase(lds3, g, S, E, wv); } }
        else if (kind == 5) { if (MK_EN & 1024) REPS(1024) phase_ln(XRES, XB, (f32x2*)(ws + WS_STATS), pp->ln_g + L * 1024, pp->ln_b + L * 1024, wv, rep_ + 1 < nrep_, L == 3); }
        else if (kind == 6) { pg8::Gemm g{XB, (const bf16_t*)(ws + W_MIN + j * W_MIN_SZ), T, MLA_NPAD, 1024}; pg8::StaticOrder S; S.init(T, MLA_NPAD, G, c);
            pg8::EpiMlaIn E{(bf16_t*)(ws + WS_MZ), (bf16_t*)(ws + WS_CKV), (bf16_t*)(ws + WS_CQ), (bf16_t*)(ws + WS_KRO), (float*)(ws + WS_RQ + (size_t)j * 524288), (float*)(ws + WS_RQ + (size_t)j * 524288 + 262144), (const float*)(ws + WS_COS), (const float*)(ws + WS_SIN)}; if (MK_EN & 32) REPS(32) pg8::gemm_phase(lds3, g, S, E, wv); }
        else if (kind == 7) { if (MK_EN & 64) REPS(64) phase_mla_stats((const bf16_t*)(ws + WS_CQ), (const bf16_t*)(ws + WS_CKV), (const float*)(ws + WS_KRR), (bf16_t*)(ws + WS_KRO), (float*)(ws + WS_RQ), (float*)(ws + WS_RKV),
                                                              (const float*)(ws + WS_COS), (const float*)(ws + WS_SIN), wv); }
        else if (kind == 8) {
            { pg8::Gemm g{(const bf16_t*)(ws + WS_CQ) + (size_t)half * TH * 384, (const bf16_t*)(ws + W_MUQ + j * W_MUQ_SZ), TH, 3072, 384}; pg8::StaticOrder S; S.init(TH, 3072, G, c);
              pg8::EpiQup E{(bf16_t*)(ws + WS_QH), (const float*)(ws + WS_RQ + (size_t)j * 524288), (const float*)(ws + WS_COS), (const float*)(ws + WS_SIN), half * TH}; if (MK_EN & 128) REPS(128) pg8::gemm_phase(lds3, g, S, E, wv); }
            { pg8::Gemm g{(const bf16_t*)(ws + WS_CKV) + (size_t)half * TH * 256, (const bf16_t*)(ws + W_MUKV + j * W_MUKV_SZ), TH, 4096, 256}; pg8::StaticOrder S; S.init(TH, 4096, G, c);
              pg8::EpiKVup E{(bf16_t*)(ws + WS_KNH), (bf16_t*)(ws + WS_VH), (const float*)(ws + WS_RQ + (size_t)j * 524288 + 262144), half * TH}; if (MK_EN & 256) REPS(256) pg8::gemm_phase(lds3, g, S, E, wv); }
        }
        else { if (MK_EN & 512) REPS(512) att::phase_attn((const bf16_t*)(ws + WS_QH), (const bf16_t*)(ws + WS_KNH), (const bf16_t*)(ws + WS_VH), (const bf16_t*)(ws + WS_KRO), (bf16_t*)(ws + WS_MZ), half, (char*)lds, wv, rep_ + 1 < nrep_); }
        if (ph2 + 1 < ph_hi * nrounds) REPS(2048) xcd_barrier((unsigned*)(ws + WS_BAR), xb_xcc_id(), (volatile LAS unsigned*)(lds3 + LDS_ST_OFF), wv);
    }
}

#ifndef MK_MULTI
#define MK_MULTI 0
#endif
extern "C" void kernel_launch(void* const* d_in, const int* in_sizes, int n_in, void* d_out, int out_size, void* d_ws, size_t ws_size, hipStream_t stream) {
    static int grid = 0;
    if (grid == 0) {
        if (n_in != 15 || out_size != T * DM || ws_size < WS_END) { fprintf(stderr, "kernel_launch: unexpected shapes n_in %d out %d ws %zu (need %zu)\n", n_in, out_size, ws_size, (size_t)WS_END); grid = -1; return; }
        if (hipFuncSetAttribute((const void*)mk_fwd, hipFuncAttributeMaxDynamicSharedMemorySize, LDS_BYTES) != hipSuccess) { fprintf(stderr, "kernel_launch: hipFuncSetAttribute failed\n"); grid = -1; return; }
        int dev = 0, cus = 0, per_cu = 0;
        hipGetDevice(&dev); hipDeviceGetAttribute(&cus, hipDeviceAttributeMultiprocessorCount, dev);
        hipOccupancyMaxActiveBlocksPerMultiprocessor(&per_cu, (const void*)mk_fwd, 512, LDS_BYTES);
        if (per_cu < 1) { fprintf(stderr, "kernel_launch: occupancy query says %d blocks per CU\n", per_cu); }
        (void)hipGetLastError();
        grid = cus > 0 ? cus : 256;
    }
    if (grid < 0) return;
    Params p{};
    p.x = (const float*)d_in[0]; p.pos = (const int*)d_in[1]; p.ln_g = (const float*)d_in[2]; p.ln_b = (const float*)d_in[3];
    p.gla_w_in = (const float*)d_in[4]; p.gla_w_gate = (const float*)d_in[5]; p.gla_b_gate = (const float*)d_in[6]; p.gla_gn_g = (const float*)d_in[7]; p.gla_w_out = (const float*)d_in[8];
    p.mla_w_in = (const float*)d_in[9]; p.mla_qn_g = (const float*)d_in[10]; p.mla_kvn_g = (const float*)d_in[11]; p.mla_w_uq = (const float*)d_in[12]; p.mla_w_ukv = (const float*)d_in[13]; p.mla_w_out = (const float*)d_in[14];
    p.out = (float*)d_out; p.ws = (unsigned char*)d_ws;
    if (hipMemsetAsync((char*)d_ws + WS_XCH, 0, 4 * MiB, stream) != hipSuccess) { fprintf(stderr, "kernel_launch: memset failed\n"); return; }
    if (hipMemsetAsync((char*)d_ws + WS_BAR, 0, XCD_BAR_WORDS * 4, stream) != hipSuccess) { fprintf(stderr, "kernel_launch: memset failed\n"); return; }
#if MK_MULTI
    for (int ph = 0; ph < NPHASE; ++ph) {
        p.ph_lo = ph; p.ph_hi = ph + 1;
        hipLaunchKernelGGL(mk_fwd, dim3(grid), dim3(512), LDS_BYTES, stream, p);
    }
#else
    p.ph_lo = 0; p.ph_hi = NPHASE;
    void* args[] = {&p};
    hipError_t e = hipLaunchCooperativeKernel((const void*)mk_fwd, dim3(grid), dim3(512), args, LDS_BYTES, stream);
    if (e != hipSuccess) fprintf(stderr, "cooperative launch failed: %s (grid %d)\n", hipGetErrorString(e), grid);
#endif
    const hipError_t le = hipPeekAtLastError();
    if (le != hipSuccess) fprintf(stderr, "kernel_launch: launch failed: %s\n", hipGetErrorName(le));
}
```

```cpp
#include <hip/hip_runtime.h>
#include <hip/hip_cooperative_groups.h>
#include <cstdio>
#include <cstdint>
namespace cg = cooperative_groups;

#define LAS __attribute__((address_space(3)))
typedef unsigned short bf16_t;
typedef short bf16x8 __attribute__((ext_vector_type(8)));
typedef short s16x4 __attribute__((ext_vector_type(4)));
typedef float f32x4 __attribute__((ext_vector_type(4)));
typedef float f32x2 __attribute__((ext_vector_type(2)));
typedef float f32x16 __attribute__((ext_vector_type(16)));
typedef unsigned u32x4 __attribute__((ext_vector_type(4)));
typedef unsigned u32x2 __attribute__((ext_vector_type(2)));

constexpr int T = 65536, DM = 1024, SEQ = 2048, NBATCH = 32;
constexpr int TH = T / 2;
constexpr float ALPHA = 1.6817928305074290f;
constexpr float EPS = 1e-5f;
constexpr int GLA_NPAD = 5376, MLA_NPAD = 2816;
constexpr int LDS_BYTES = 143360;

constexpr size_t MiB = 1048576;
constexpr size_t W_GIN = 0, W_GIN_SZ = (size_t)GLA_NPAD * 1024 * 2;
constexpr size_t W_GOUT = W_GIN + 2 * W_GIN_SZ, W_OUT_SZ = (size_t)1024 * 2048 * 2;
constexpr size_t W_MIN = W_GOUT + 2 * W_OUT_SZ, W_MIN_SZ = (size_t)MLA_NPAD * 1024 * 2;
constexpr size_t W_MUQ = W_MIN + 2 * W_MIN_SZ, W_MUQ_SZ = (size_t)3072 * 384 * 2;
constexpr size_t W_MUKV = W_MUQ + 2 * W_MUQ_SZ, W_MUKV_SZ = (size_t)4096 * 256 * 2;
constexpr size_t W_MOUT = W_MUKV + 2 * W_MUKV_SZ;
static_assert(W_MOUT + 2 * W_OUT_SZ <= 64 * MiB, "weights region");
constexpr size_t WS_XB = 64 * MiB;
constexpr size_t WS_OFW = 64 * MiB, WS_GQK = 320 * MiB, WS_GV = 448 * MiB, WS_GZ = 704 * MiB, WS_GLR = 960 * MiB;
constexpr size_t WS_MZ = 192 * MiB, WS_QH = 448 * MiB, WS_KNH = 640 * MiB, WS_VH = 768 * MiB, WS_CQ = 896 * MiB, WS_CKV = 944 * MiB,
                 WS_KRR = 976 * MiB, WS_KRO = 992 * MiB, WS_RQ = 1000 * MiB, WS_RKV = 1000 * MiB + 262144;
constexpr size_t WS_COS = 1001 * MiB, WS_SIN = 1009 * MiB, WS_BAR = 1017 * MiB, WS_STATS = 1017 * MiB + 65536, WS_XCH = 1018 * MiB, WS_END = 1022 * MiB;
constexpr int LDS_ST_OFF = 143344;

struct Params {
    const float* x; const int* pos; const float* ln_g; const float* ln_b;
    const float* gla_w_in; const float* gla_w_gate; const float* gla_b_gate; const float* gla_gn_g; const float* gla_w_out;
    const float* mla_w_in; const float* mla_qn_g; const float* mla_kvn_g; const float* mla_w_uq; const float* mla_w_ukv; const float* mla_w_out;
    float* out; unsigned char* ws;
    int ph_lo, ph_hi;
};

__device__ __forceinline__ unsigned cvt_pk_bf16(float lo, float hi) { unsigned r; asm volatile("v_cvt_pk_bf16_f32 %0, %1, %2" : "=v"(r) : "v"(lo), "v"(hi)); return r; }
__device__ __forceinline__ float bf2f(unsigned short b) { return __uint_as_float(((unsigned)b) << 16); }
__device__ __forceinline__ float bflo(unsigned w) { return __uint_as_float(w << 16); }
__device__ __forceinline__ float bfhi(unsigned w) { return __uint_as_float(w & 0xffff0000u); }
__device__ __forceinline__ float silu_f(float z) { return z / (1.f + __expf(-z)); }
__device__ __forceinline__ float silu_fast(float z) { return z * __builtin_amdgcn_rcpf(1.f + __expf(-z)); }
__device__ __forceinline__ float wave_sum(float v) {
#pragma unroll
    for (int o = 32; o > 0; o >>= 1) v += __shfl_xor(v, o, 64);
    return v;
}

__device__ __forceinline__ int opaque_lane() { int l = __builtin_amdgcn_mbcnt_hi(~0u, __builtin_amdgcn_mbcnt_lo(~0u, 0u)); asm volatile("" : "+v"(l)); return l; }
__device__ __forceinline__ int opaque_tid(int wv) { return wv * 64 + opaque_lane(); }
namespace pg8 {
constexpr int BM = 256, BK = 64, HALF = 128, HTB = HALF * BK * 2, STAGE_BYTES = 8 * HTB, NXCD = 8, WGM = 8;
__host__ __device__ __forceinline__ int lds_byte(int r, int c) { const int st = (r >> 4) * 2 + (c >> 5), rr = r & 15, cc = c & 31, ob = rr * 64 + cc * 2; return st * 1024 + (ob ^ (((ob >> 9) & 1) << 5)); }
__host__ __device__ __forceinline__ void stage_rc(int b, int& R, int& C) { const int st = b / 1024, sb = b % 1024, swz = sb ^ (((sb >> 9) & 1) << 5); R = (st >> 1) * 16 + swz / 64; C = (st & 1) * 32 + (swz % 64) / 2; }
__host__ __device__ __forceinline__ int perm32(int rho) { const int n = rho >> 4, i = rho & 15; return 8 * (i >> 2) + 4 * n + (i & 3); }
struct Unit { int pm, pn; };
struct Gemm { const bf16_t* A; const bf16_t* Bt; int M, N, K; };
struct StaticOrder {
    int nM, nN, nwg, G, c;
    __device__ void init(int M, int N, int G_, int c_) { nM = M / BM; nN = N / BM; nwg = nM * nN; G = G_; c = c_; }
    __device__ bool next(int i, Unit& u) const {
        const long L = (long)i * G + c; if (L >= nwg) return false;
        int wgid = (int)L; { const int q = nwg / NXCD, r = nwg % NXCD, xcd = wgid % NXCD, off = wgid / NXCD; wgid = (xcd < r ? xcd * (q + 1) : r * (q + 1) + (xcd - r) * q) + off; }
        const int nig = WGM * nN, gid = wgid / nig, fm = gid * WGM, gsz = (nM - fm) < WGM ? (nM - fm) : WGM;
        u.pm = fm + ((wgid % nig) % gsz); u.pn = (wgid % nig) / gsz; return true;
    }
};

template <class Epi>
__device__ __forceinline__ void gemm_phase(LAS unsigned char* lds, const Gemm g, const StaticOrder& S, const Epi& E, int wv) {
    const int tid = opaque_tid(wv), wid = wv, lane = tid & 63, wr = wid >> 2, wc = wid & 3, fr = lane & 15, fq = lane >> 4;
    const int K = g.K, nt = K / BK;
    unsigned voffA[2], voffB[2];
#pragma unroll
    for (int i = 0; i < 2; ++i) { int R, C; stage_rc(tid * 16 + i * 8192, R, C); const int Rb = Epi::PERM ? ((R & ~31) + perm32(R & 31)) : R;
        voffA[i] = (unsigned)(R * K + C) * 2u; voffB[i] = (unsigned)(Rb * K + C) * 2u; }
    const size_t kstep = (size_t)(BK * 2);
    const size_t hstep = (size_t)HALF * K * 2;
    const size_t tstep = 2 * hstep;
    const unsigned ldsw = (unsigned)wid * 1024u;
    const int aoff = lds_byte(wr * 64 + fr, fq * 8), boff = lds_byte(wc * 32 + fr, fq * 8);
#define PG8_SA(b, h) (((b) * 2 + (h)) * HTB)
#define PG8_SB(b, h) ((4 + (b) * 2 + (h)) * HTB)
#define PG8_STAGE(bufoff, gbase, voff) do { _Pragma("unroll") for (int _i = 0; _i < 2; ++_i) \
        __builtin_amdgcn_global_load_lds((const unsigned*)((const char*)(gbase) + (voff)[_i]), (LAS unsigned*)(lds + (bufoff) + ldsw + _i * 8192), 16, 0, 0); } while (0)
#define PG8_LDA(dst, b, h) do { _Pragma("unroll") for (int m = 0; m < 4; ++m) _Pragma("unroll") for (int k = 0; k < 2; ++k) dst[m][k] = *(const LAS bf16x8*)(lds + PG8_SA(b, h) + aoff + m * 2048 + k * 1024); } while (0)
#define PG8_LDB(dst, b, h) do { _Pragma("unroll") for (int n = 0; n < 2; ++n) _Pragma("unroll") for (int k = 0; k < 2; ++k) dst[n][k] = *(const LAS bf16x8*)(lds + PG8_SB(b, h) + boff + n * 2048 + k * 1024); } while (0)
#define PG8_MMA(ai, bj, At, Bt) do { __builtin_amdgcn_s_setprio(1); _Pragma("unroll") for (int m = 0; m < 4; ++m) _Pragma("unroll") for (int n = 0; n < 2; ++n) _Pragma("unroll") for (int k = 0; k < 2; ++k) \
        acc[ai][bj][m][n] = __builtin_amdgcn_mfma_f32_16x16x32_bf16(Bt[n][k], At[m][k], acc[ai][bj][m][n], 0, 0, 0); __builtin_amdgcn_s_setprio(0); } while (0)
#define PG8_WAIT_V(n) asm volatile("s_waitcnt vmcnt(" #n ")" ::: "memory")
#define PG8_WAIT_L(n) asm volatile("s_waitcnt lgkmcnt(" #n ")" ::: "memory")
#define PG8_BAR __builtin_amdgcn_s_barrier()
#define PG8_SCHED __builtin_amdgcn_sched_barrier(0)
    Unit cur, nxt; int ui = 0;
    if (!S.next(0, cur)) return;
    f32x4 acc[2][2][4][2];
#pragma unroll
    for (int a = 0; a < 2; ++a)
#pragma unroll
        for (int b = 0; b < 2; ++b)
#pragma unroll
            for (int m = 0; m < 4; ++m)
#pragma unroll
                for (int n = 0; n < 2; ++n) acc[a][b][m][n] = (f32x4){0.f, 0.f, 0.f, 0.f};
    bf16x8 At[4][2], B0[2][2], B1[2][2];
    const char* cA = (const char*)g.A + (size_t)cur.pm * tstep; const char* cB = (const char*)g.Bt + (size_t)cur.pn * tstep;
    PG8_STAGE(PG8_SB(0, 0), cB, voffB); PG8_STAGE(PG8_SA(0, 0), cA, voffA); PG8_STAGE(PG8_SB(0, 1), cB + hstep, voffB); PG8_STAGE(PG8_SA(0, 1), cA + hstep, voffA);
    if (wr == 1) PG8_BAR;
    PG8_WAIT_V(4); PG8_BAR;
    PG8_STAGE(PG8_SB(1, 0), cB + kstep, voffB); PG8_STAGE(PG8_SA(1, 0), cA + kstep, voffA); PG8_STAGE(PG8_SB(1, 1), cB + hstep + kstep, voffB);
    PG8_WAIT_V(6); PG8_BAR;
    for (;;) {
        const bool has_next = S.next(ui + 1, nxt);
        const char* nA = has_next ? (const char*)g.A + (size_t)nxt.pm * tstep : cA; const char* nB = has_next ? (const char*)g.Bt + (size_t)nxt.pn * tstep : cB;
        for (int t = 0; t < nt; t += 2) {
            const bool last = (t == nt - 2);
            const char* a1 = cA + (size_t)(t + 1) * kstep;
            const char* a2 = last ? nA : cA + (size_t)(t + 2) * kstep; const char* b2 = last ? nB : cB + (size_t)(t + 2) * kstep;
            const char* a3 = a2 + kstep; const char* b3 = b2 + kstep;
            PG8_LDB(B0, 0, 0); PG8_SCHED; PG8_LDA(At, 0, 0); PG8_STAGE(PG8_SA(1, 1), a1 + hstep, voffA);
            PG8_WAIT_L(8); PG8_BAR; PG8_WAIT_L(0); PG8_MMA(0, 0, At, B0); PG8_BAR; PG8_SCHED;
            PG8_LDB(B1, 0, 1); PG8_STAGE(PG8_SB(0, 0), b2, voffB);
            PG8_BAR; PG8_WAIT_L(0); PG8_MMA(0, 1, At, B1); PG8_BAR;
            PG8_LDA(At, 0, 1); PG8_STAGE(PG8_SA(0, 0), a2, voffA);
            PG8_BAR; PG8_WAIT_L(0); PG8_MMA(1, 0, At, B0); PG8_BAR; PG8_SCHED;
            PG8_STAGE(PG8_SB(0, 1), b2 + hstep, voffB);
            PG8_WAIT_V(6); PG8_BAR; PG8_MMA(1, 1, At, B1); PG8_BAR;
            PG8_LDB(B0, 1, 0); PG8_SCHED; PG8_LDA(At, 1, 0); PG8_STAGE(PG8_SA(0, 1), a2 + hstep, voffA);
            PG8_WAIT_L(8); PG8_BAR; PG8_WAIT_L(0); PG8_MMA(0, 0, At, B0); PG8_BAR; PG8_SCHED;
            PG8_LDB(B1, 1, 1); PG8_STAGE(PG8_SB(1, 0), b3, voffB);
            PG8_BAR; PG8_WAIT_L(0); PG8_MMA(0, 1, At, B1); PG8_BAR;
            PG8_LDA(At, 1, 1); PG8_STAGE(PG8_SA(1, 0), a3, voffA);
            PG8_BAR; PG8_WAIT_L(0); PG8_MMA(1, 0, At, B0); PG8_BAR; PG8_SCHED;
            PG8_STAGE(PG8_SB(1, 1), b3 + hstep, voffB);
            PG8_WAIT_V(6); PG8_BAR; PG8_MMA(1, 1, At, B1); PG8_BAR;
        }
        E(acc, cur, wv);
        if (!has_next) break;
#pragma unroll
        for (int a = 0; a < 2; ++a)
#pragma unroll
            for (int b = 0; b < 2; ++b)
#pragma unroll
                for (int m = 0; m < 4; ++m)
#pragma unroll
                    for (int n = 0; n < 2; ++n) acc[a][b][m][n] = (f32x4){0.f, 0.f, 0.f, 0.f};
        cur = nxt; cA = nA; cB = nB; ++ui;
    }
    PG8_WAIT_V(0);
    if (wr == 0) PG8_BAR;
    PG8_BAR;
#undef PG8_SA
#undef PG8_SB
#undef PG8_STAGE
#undef PG8_LDA
#undef PG8_LDB
#undef PG8_MMA
#undef PG8_WAIT_V
#undef PG8_WAIT_L
#undef PG8_BAR
#undef PG8_SCHED
}

typedef f32x4 Acc[2][2][4][2];
__device__ __forceinline__ void store8_bf16(bf16_t* p, f32x4 v0, f32x4 v1, float s) {
    u32x4 w = {cvt_pk_bf16(v0[0] * s, v0[1] * s), cvt_pk_bf16(v0[2] * s, v0[3] * s), cvt_pk_bf16(v1[0] * s, v1[1] * s), cvt_pk_bf16(v1[2] * s, v1[3] * s)};
    *(u32x4*)p = w;
}
__device__ __forceinline__ void tile_store_bf16(const Acc& acc, bf16_t* base, int ld, int pm, int wr, int wc, int fr, int fq, float s) {
    const int row0 = pm * BM + wr * 64 + fr, col0 = wc * 32 + 8 * fq;
#pragma unroll
    for (int ai = 0; ai < 2; ++ai)
#pragma unroll
        for (int m = 0; m < 4; ++m) { bf16_t* rowp = base + (size_t)(row0 + ai * HALF + m * 16) * ld + col0;
#pragma unroll
            for (int bj = 0; bj < 2; ++bj) store8_bf16(rowp + bj * HALF, acc[ai][bj][m][0], acc[ai][bj][m][1], s); }
}
struct EpiGlaIn {
    static constexpr bool PERM = true;
    bf16_t* QK; bf16_t* V; bf16_t* Z; float* GLR;
    __device__ __forceinline__ void operator()(const Acc& acc, const Unit& u, int wv) const {
        const int wr = wv >> 2, wc = wv & 3, ln_ = opaque_lane(), fr = ln_ & 15, fq = ln_ >> 4;
        const int pn = u.pn;
        if (pn < 4) tile_store_bf16(acc, QK + pn * 256, 1024, u.pm, wr, wc, fr, fq, pn < 2 ? 0.08838834764831845f : 1.f);
        else if (pn < 12) tile_store_bf16(acc, V + (pn - 4) * 256, 2048, u.pm, wr, wc, fr, fq, 1.f);
        else if (pn < 20) tile_store_bf16(acc, Z + (pn - 12) * 256, 2048, u.pm, wr, wc, fr, fq, 1.f);
        else if (wc == 0) {
            const int row0 = u.pm * BM + wr * 64 + fr;
#pragma unroll
            for (int ai = 0; ai < 2; ++ai)
#pragma unroll
                for (int m = 0; m < 4; ++m) { float* rowp = GLR + (size_t)(row0 + ai * HALF + m * 16) * 32 + 8 * fq;
                    *(f32x4*)rowp = acc[ai][0][m][0]; *(f32x4*)(rowp + 4) = acc[ai][0][m][1]; }
        }
    }
};
__device__ __forceinline__ float sumsq8(f32x4 a, f32x4 b) { return a[0] * a[0] + a[1] * a[1] + a[2] * a[2] + a[3] * a[3] + b[0] * b[0] + b[1] * b[1] + b[2] * b[2] + b[3] * b[3]; }
struct EpiMlaIn {
    static constexpr bool PERM = true;
    bf16_t* Z; bf16_t* CKV; bf16_t* CQ; bf16_t* KRO; float* SSQ_Q; float* SSQ_KV; const float* COS; const float* SIN;
    __device__ __forceinline__ void operator()(const Acc& acc, const Unit& u, int wv) const {
        const int wr = wv >> 2, wc = wv & 3, ln_ = opaque_lane(), fr = ln_ & 15, fq = ln_ >> 4;
        const int pn = u.pn;
        if (pn < 8) { tile_store_bf16(acc, Z + pn * 256, 2048, u.pm, wr, wc, fr, fq, 1.f); return; }
        const int row0 = u.pm * BM + wr * 64 + fr, col0 = wc * 32 + 8 * fq;
#pragma unroll
        for (int ai = 0; ai < 2; ++ai)
#pragma unroll
            for (int m = 0; m < 4; ++m) { const size_t row = (size_t)(row0 + ai * HALF + m * 16);
                float ss;
                if (pn == 8) { bf16_t* rp = CKV + row * 256 + col0; store8_bf16(rp, acc[ai][0][m][0], acc[ai][0][m][1], 1.f); store8_bf16(rp + HALF, acc[ai][1][m][0], acc[ai][1][m][1], 1.f);
                    ss = sumsq8(acc[ai][0][m][0], acc[ai][0][m][1]) + sumsq8(acc[ai][1][m][0], acc[ai][1][m][1]); }
                else if (pn == 9) { bf16_t* rp = CQ + row * 384 + col0; store8_bf16(rp, acc[ai][0][m][0], acc[ai][0][m][1], 1.f); store8_bf16(rp + HALF, acc[ai][1][m][0], acc[ai][1][m][1], 1.f);
                    ss = sumsq8(acc[ai][0][m][0], acc[ai][0][m][1]) + sumsq8(acc[ai][1][m][0], acc[ai][1][m][1]); }
                else { store8_bf16(CQ + row * 384 + 256 + col0, acc[ai][0][m][0], acc[ai][0][m][1], 1.f);
                    ss = sumsq8(acc[ai][0][m][0], acc[ai][0][m][1]);
                    if (wc < 2) { const int i0 = col0 >> 1; const f32x4 cs = *(const f32x4*)(COS + row * 32 + i0), sn = *(const f32x4*)(SIN + row * 32 + i0);
                        const f32x4 v0 = acc[ai][1][m][0], v1 = acc[ai][1][m][1]; f32x4 w0, w1;
                        w0[0] = v0[0] * cs[0] - v0[1] * sn[0]; w0[1] = v0[1] * cs[0] + v0[0] * sn[0];
                        w0[2] = v0[2] * cs[1] - v0[3] * sn[1]; w0[3] = v0[3] * cs[1] + v0[2] * sn[1];
                        w1[0] = v1[0] * cs[2] - v1[1] * sn[2]; w1[1] = v1[1] * cs[2] + v1[0] * sn[2];
                        w1[2] = v1[2] * cs[3] - v1[3] * sn[3]; w1[3] = v1[3] * cs[3] + v1[2] * sn[3];
                        store8_bf16(KRO + row * 64 + col0, w0, w1, 1.f); } }
                ss += __shfl_xor(ss, 16, 64); ss += __shfl_xor(ss, 32, 64);
                if (fq == 0) atomicAdd((pn == 8 ? SSQ_KV : SSQ_Q) + row, ss);
                __builtin_amdgcn_sched_barrier(0); }
    }
};
struct EpiQup {
    static constexpr bool PERM = true;
    bf16_t* Q; const float* RQ; const float* COS; const float* SIN; int tok0;
    __device__ __forceinline__ void operator()(Acc& acc, const Unit& u, int wv) const {
        const int wr = wv >> 2, wc = wv & 3, ln_ = opaque_lane(), fr = ln_ & 15, fq = ln_ >> 4;
        const int row0 = u.pm * BM + wr * 64 + fr;
        float sc[8];
#pragma unroll
        for (int i = 0; i < 8; ++i) sc[i] = RQ[(size_t)tok0 + row0 + (i >> 2) * HALF + (i & 3) * 16];
#pragma unroll
        for (int i = 0; i < 8; ++i) sc[i] = rsqrtf(sc[i] * (1.f / 384.f) + EPS);
#pragma unroll
        for (int bj = 0; bj < 2; ++bj) {
            const int c = u.pn * 256 + bj * 128 + wc * 32 + 8 * fq, o = c % 192; const bool rope = o >= 128; const int i0 = (o - 128) >> 1;
            if (!rope) {
#pragma unroll
                for (int i = 0; i < 8; ++i) { const int row = row0 + (i >> 2) * HALF + (i & 3) * 16; store8_bf16(Q + (size_t)row * 3072 + c, acc[i >> 2][bj][i & 3][0], acc[i >> 2][bj][i & 3][1], sc[i]); }
            } else {
#pragma unroll
                for (int ai = 0; ai < 2; ++ai) {
                    f32x4 cs[4], sn[4];
#pragma unroll
                    for (int m = 0; m < 4; ++m) { const size_t tok = (size_t)tok0 + row0 + ai * HALF + m * 16; cs[m] = *(const f32x4*)(COS + tok * 32 + i0); sn[m] = *(const f32x4*)(SIN + tok * 32 + i0); }
#pragma unroll
                    for (int m = 0; m < 4; ++m) { const int row = row0 + ai * HALF + m * 16; const float s = sc[ai * 4 + m];
                        const f32x4 v0 = acc[ai][bj][m][0] * s, v1 = acc[ai][bj][m][1] * s; f32x4 w0, w1;
                        w0[0] = v0[0] * cs[m][0] - v0[1] * sn[m][0]; w0[1] = v0[1] * cs[m][0] + v0[0] * sn[m][0];
                        w0[2] = v0[2] * cs[m][1] - v0[3] * sn[m][1]; w0[3] = v0[3] * cs[m][1] + v0[2] * sn[m][1];
                        w1[0] = v1[0] * cs[m][2] - v1[1] * sn[m][2]; w1[1] = v1[1] * cs[m][2] + v1[0] * sn[m][2];
                        w1[2] = v1[2] * cs[m][3] - v1[3] * sn[m][3]; w1[3] = v1[3] * cs[m][3] + v1[2] * sn[m][3];
                        store8_bf16(Q + (size_t)row * 3072 + c, w0, w1, 1.f); }
                    __builtin_amdgcn_sched_barrier(0);
                }
            }
        }
    }
};
struct EpiKVup {
    static constexpr bool PERM = true;
    bf16_t* KN; bf16_t* V; const float* RKV; int tok0;
    __device__ __forceinline__ void operator()(Acc& acc, const Unit& u, int wv) const {
        const int wr = wv >> 2, wc = wv & 3, ln_ = opaque_lane(), fr = ln_ & 15, fq = ln_ >> 4;
        bf16_t* base = u.pn < 8 ? KN + u.pn * 256 : V + (u.pn - 8) * 256;
        const int row0 = u.pm * BM + wr * 64 + fr, col0 = wc * 32 + 8 * fq;
        float sc[8];
#pragma unroll
        for (int i = 0; i < 8; ++i) sc[i] = RKV[(size_t)tok0 + row0 + (i >> 2) * HALF + (i & 3) * 16];
#pragma unroll
        for (int i = 0; i < 8; ++i) sc[i] = rsqrtf(sc[i] * (1.f / 256.f) + EPS);
#pragma unroll
        for (int i = 0; i < 8; ++i) { const int row = row0 + (i >> 2) * HALF + (i & 3) * 16; bf16_t* rowp = base + (size_t)row * 2048 + col0;
#pragma unroll
            for (int bj = 0; bj < 2; ++bj) store8_bf16(rowp + bj * HALF, acc[i >> 2][bj][i & 3][0], acc[i >> 2][bj][i & 3][1], sc[i]); }
    }
};
struct EpiRes {
    static constexpr bool PERM = false;
    float* XRES; const float* XIN; const f32x2* ST; const float* G; const float* B; bool nowrite;
    __device__ __forceinline__ void operator()(const Acc& acc, const Unit& u, int wv) const {
        const int wr = wv >> 2, wc = wv & 3, ln_ = opaque_lane(), fr = ln_ & 15, fq = ln_ >> 4;
        const int row0 = u.pm * BM + wr * 64 + fr, col0 = u.pn * BM + wc * 32 + 4 * fq;
#pragma unroll
        for (int pr = 0; pr < 4; ++pr) {
            f32x4 xi[2][4]; f32x2 st[2];
#pragma unroll
            for (int q = 0; q < 2; ++q) { const int i = pr * 2 + q, row = row0 + (i >> 2) * HALF + (i & 3) * 16; const size_t ro = (size_t)row * 1024 + col0;
                st[q] = (f32x2){0.f, 1.f}; if (ST) st[q] = ST[row];
#pragma unroll
                for (int c4 = 0; c4 < 4; ++c4) xi[q][c4] = *(const f32x4*)(XIN + ro + (c4 >> 1) * HALF + (c4 & 1) * 16); }
#pragma unroll
            for (int q = 0; q < 2; ++q) { const int i = pr * 2 + q, row = row0 + (i >> 2) * HALF + (i & 3) * 16; const size_t ro = (size_t)row * 1024 + col0;
#pragma unroll
                for (int c4 = 0; c4 < 4; ++c4) { const int co = (c4 >> 1) * HALF + (c4 & 1) * 16; f32x4 x = xi[q][c4];
                    if (ST) { const f32x4 g = *(const f32x4*)(G + col0 + co), b = *(const f32x4*)(B + col0 + co); x = (x - st[q][0]) * st[q][1] * g + b; }
                    if (!nowrite) *(f32x4*)(XRES + ro + co) = acc[i >> 2][c4 >> 1][i & 3][c4 & 1] + x * ALPHA; } }
            __builtin_amdgcn_sched_barrier(0);
        }
    }
};
}

enum { MAP_ID = 0, MAP_MLAIN = 1, MAP_UQ = 2, MAP_UKV = 3 };
__device__ __forceinline__ int map_col(int mode, int nd, int nsrc) {
    if (mode == MAP_ID) return nd < nsrc ? nd : -1;
    if (mode == MAP_MLAIN) { if (nd < 2048) return 704 + nd; if (nd < 2304) return 384 + (nd - 2048); if (nd < 2688) return nd - 2304; if (nd < 2752) { const int p_ = nd - 2688; return 640 + (p_ >> 1) + ((p_ & 1) ? 32 : 0); } return -1; }
    if (mode == MAP_UQ) { const int h = nd / 192, o = nd % 192; if (o < 128) return h * 192 + o; const int p = o - 128, i = p >> 1; return (p & 1) ? h * 192 + 160 + i : h * 192 + 128 + i; }
    { if (nd < 2048) return (nd >> 7) * 256 + (nd & 127); const int n2 = nd - 2048; return (n2 >> 7) * 256 + 128 + (n2 & 127); }
}
__device__ __forceinline__ void transpose_job(const float* src, bf16_t* dst, int K, int nsrc, int ndst, int mode, const float* rs, float* tile  , int wv) {
    const int tid = opaque_tid(wv), tk = K / 64, tn = ndst / 64, ntiles = tk * tn;
    for (int t = blockIdx.x; t < ntiles; t += gridDim.x) {
        const int k0 = (t % tk) * 64, n0 = (t / tk) * 64;
        const int nn = tid & 63, sc = map_col(mode, n0 + nn, nsrc);
        __syncthreads();
#pragma unroll
        for (int i = 0; i < 8; ++i) { const int kk = (tid >> 6) + 8 * i; float v = 0.f; if (sc >= 0) { v = src[(size_t)(k0 + kk) * nsrc + sc]; if (rs) v *= rs[k0 + kk]; } tile[kk * 65 + nn] = v; }
        __syncthreads();
        const int on = tid >> 3, ok = (tid & 7) * 8;
        float v[8];
#pragma unroll
        for (int i = 0; i < 8; ++i) v[i] = tile[(ok + i) * 65 + on];
        u32x4 w = {cvt_pk_bf16(v[0], v[1]), cvt_pk_bf16(v[2], v[3]), cvt_pk_bf16(v[4], v[5]), cvt_pk_bf16(v[6], v[7])};
        *(u32x4*)(dst + (size_t)(n0 + on) * K + k0 + ok) = w;
    }
}
__device__ __forceinline__ void phase_prep(const __attribute__((address_space(4))) Params* pp, unsigned char* lds, int wv) {
    float* tile = (float*)lds;
    struct { const float* x; const int* pos; const float* gla_w_in; const float* gla_w_out; const float* mla_w_in; const float* mla_qn_g; const float* mla_kvn_g; const float* mla_w_uq; const float* mla_w_ukv; const float* mla_w_out; unsigned char* ws; } p;
    p.x = pp->x; p.pos = pp->pos; p.gla_w_in = pp->gla_w_in; p.gla_w_out = pp->gla_w_out; p.mla_w_in = pp->mla_w_in; p.mla_qn_g = pp->mla_qn_g; p.mla_kvn_g = pp->mla_kvn_g; p.mla_w_uq = pp->mla_w_uq; p.mla_w_ukv = pp->mla_w_ukv; p.mla_w_out = pp->mla_w_out; p.ws = pp->ws;
    unsigned char* ws = p.ws;
    const size_t gtid = (size_t)blockIdx.x * 512 + opaque_tid(wv), gsz = (size_t)gridDim.x * 512;
    for (size_t i = gtid; i < (size_t)T * DM / 8; i += gsz) {
        const f32x4 a = *(const f32x4*)(p.x + i * 8), b = *(const f32x4*)(p.x + i * 8 + 4);
        u32x4 w = {cvt_pk_bf16(a[0], a[1]), cvt_pk_bf16(a[2], a[3]), cvt_pk_bf16(b[0], b[1]), cvt_pk_bf16(b[2], b[3])};
        *(u32x4*)(ws + WS_XB + i * 16) = w;
    }
    for (size_t i = gtid; i < (size_t)(MiB / 16); i += gsz) *(u32x4*)(ws + WS_RQ + i * 16) = (u32x4){0u, 0u, 0u, 0u};
    for (size_t i = gtid; i < (size_t)T * 32; i += gsz) {
        const int tok = (int)(i >> 5), f = (int)(i & 31);
        const float inv = exp2f(-(float)(2 * f) * (13.287712379549449f / 64.0f));
        const float ang = (float)p.pos[tok] * inv;
        ((float*)(ws + WS_COS))[i] = cosf(ang); ((float*)(ws + WS_SIN))[i] = sinf(ang);
    }
    for (int j = 0; j < 2; ++j) {
        transpose_job(p.gla_w_in + (size_t)j * 1024 * 5152, (bf16_t*)(ws + W_GIN + j * W_GIN_SZ), 1024, 5152, GLA_NPAD, MAP_ID, nullptr, tile, wv);
        transpose_job(p.gla_w_out + (size_t)j * 2048 * 1024, (bf16_t*)(ws + W_GOUT + j * W_OUT_SZ), 2048, 1024, 1024, MAP_ID, nullptr, tile, wv);
        transpose_job(p.mla_w_in + (size_t)j * 1024 * 2752, (bf16_t*)(ws + W_MIN + j * W_MIN_SZ), 1024, 2752, MLA_NPAD, MAP_MLAIN, nullptr, tile, wv);
        transpose_job(p.mla_w_uq + (size_t)j * 384 * 3072, (bf16_t*)(ws + W_MUQ + j * W_MUQ_SZ), 384, 3072, 3072, MAP_UQ, p.mla_qn_g + j * 384, tile, wv);
        transpose_job(p.mla_w_ukv + (size_t)j * 256 * 4096, (bf16_t*)(ws + W_MUKV + j * W_MUKV_SZ), 256, 4096, 4096, MAP_UKV, p.mla_kvn_g + j * 256, tile, wv);
        transpose_job(p.mla_w_out + (size_t)j * 2048 * 1024, (bf16_t*)(ws + W_MOUT + j * W_OUT_SZ), 2048, 1024, 1024, MAP_ID, nullptr, tile, wv);
    }
    __syncthreads();
}

__device__ __forceinline__ void phase_ln(float* xres, bf16_t* xb, f32x2* stats, const float* g, const float* b, int wv, bool nowrite, bool final_) {
    const int tid = opaque_tid(wv); const int lane = tid & 63, gw = blockIdx.x * 8 + (tid >> 6), nw = gridDim.x * 8;
    f32x4 gv[4], bv[4];
#pragma unroll
    for (int i = 0; i < 4; ++i) { gv[i] = *(const f32x4*)(g + i * 256 + lane * 4); bv[i] = *(const f32x4*)(b + i * 256 + lane * 4); }
    for (int row0 = gw; row0 < T; row0 += 4 * nw) {
        f32x4 v[4][4];
#pragma unroll
        for (int u = 0; u < 4; ++u) { const float* rp = xres + (size_t)(row0 + u * nw) * 1024;
#pragma unroll
            for (int i = 0; i < 4; ++i) v[u][i] = *(const f32x4*)(rp + i * 256 + lane * 4); }
#pragma unroll
        for (int u = 0; u < 4; ++u) {
            const int row = row0 + u * nw; float* rp = xres + (size_t)row * 1024;
            float s = 0.f;
#pragma unroll
            for (int i = 0; i < 4; ++i) s += v[u][i][0] + v[u][i][1] + v[u][i][2] + v[u][i][3];
            const float mu = wave_sum(s) * (1.f / 1024.f);
            float q = 0.f;
#pragma unroll
            for (int i = 0; i < 4; ++i) { v[u][i] = v[u][i] - mu; q += v[u][i][0] * v[u][i][0] + v[u][i][1] * v[u][i][1] + v[u][i][2] * v[u][i][2] + v[u][i][3] * v[u][i][3]; }
            const float rstd = rsqrtf(wave_sum(q) * (1.f / 1024.f) + EPS);
            if (!final_ && lane == 0 && !nowrite) stats[row] = (f32x2){mu, rstd};
#pragma unroll
            for (int i = 0; i < 4; ++i) { const f32x4 y = v[u][i] * rstd * gv[i] + bv[i]; if (!nowrite) { if (final_) *(f32x4*)(rp + i * 256 + lane * 4) = y;
                else { u32x2 w = {cvt_pk_bf16(y[0], y[1]), cvt_pk_bf16(y[2], y[3])}; *(u32x2*)(xb + (size_t)row * 1024 + i * 256 + lane * 4) = w; } } }
        }
    }
}

__device__ __forceinline__ void phase_gla_gate(const bf16_t* O, bf16_t* Z, const float* gn, int wv, bool nowrite) {
    const int tid = opaque_tid(wv); const int lane = tid & 63, h = wv & 3;
    const f32x4 g0 = *(const f32x4*)(gn + h * 512 + lane * 8), g1 = *(const f32x4*)(gn + h * 512 + lane * 8 + 4);
    const int rw = blockIdx.x * 2 + (wv >> 2), nrw = gridDim.x * 2;
    for (int row0 = rw; row0 < T; row0 += 4 * nrw) {
        u32x4 ov[4], zv[4];
#pragma unroll
        for (int u = 0; u < 4; ++u) { const size_t off = (size_t)(row0 + u * nrw) * 2048 + h * 512 + lane * 8; ov[u] = *(const u32x4*)(O + off); zv[u] = *(const u32x4*)(Z + off); }
#pragma unroll
        for (int u = 0; u < 4; ++u) {
            const size_t off = (size_t)(row0 + u * nrw) * 2048 + h * 512 + lane * 8;
            float o[8], z[8];
#pragma unroll
            for (int i = 0; i < 4; ++i) { o[2 * i] = bflo(ov[u][i]); o[2 * i + 1] = bfhi(ov[u][i]); z[2 * i] = bflo(zv[u][i]); z[2 * i + 1] = bfhi(zv[u][i]); }
            float ss = 0.f;
#pragma unroll
            for (int i = 0; i < 8; ++i) ss += o[i] * o[i];
            const float r = rsqrtf(wave_sum(ss) * (1.f / 512.f) + EPS);
            float y[8];
#pragma unroll
            for (int i = 0; i < 8; ++i) y[i] = o[i] * r * (i < 4 ? g0[i] : g1[i - 4]) * silu_f(z[i]);
            u32x4 w = {cvt_pk_bf16(y[0], y[1]), cvt_pk_bf16(y[2], y[3]), cvt_pk_bf16(y[4], y[5]), cvt_pk_bf16(y[6], y[7])};
            if (!nowrite) *(u32x4*)(Z + off) = w;
        }
    }
}

__device__ __forceinline__ void phase_mla_stats(const bf16_t* CQ, const bf16_t* CKV, const float* KRR, bf16_t* KRO, float* RQ, float* RKV, const float* COS, const float* SIN, int wv) {
    const int tid = opaque_tid(wv); const int lane = tid & 63, gw = blockIdx.x * 8 + (tid >> 6), nw = gridDim.x * 8;
    for (int row = gw; row < T; row += nw) {
        float sq = 0.f, sk = 0.f;
        if (lane < 48) { const u32x4 v = *(const u32x4*)(CQ + (size_t)row * 384 + lane * 8);
#pragma unroll
            for (int i = 0; i < 4; ++i) { const float a = bflo(v[i]), b = bfhi(v[i]); sq += a * a + b * b; } }
        if (lane < 32) { const u32x4 v = *(const u32x4*)(CKV + (size_t)row * 256 + lane * 8);
#pragma unroll
            for (int i = 0; i < 4; ++i) { const float a = bflo(v[i]), b = bfhi(v[i]); sk += a * a + b * b; } }
        sq = wave_sum(sq); sk = wave_sum(sk);
        if (lane == 0) { RQ[row] = rsqrtf(sq * (1.f / 384.f) + EPS); RKV[row] = rsqrtf(sk * (1.f / 256.f) + EPS); }
        if (lane < 32) { const float x1 = KRR[(size_t)row * 64 + lane], x2 = KRR[(size_t)row * 64 + 32 + lane];
            const float c = COS[(size_t)row * 32 + lane], s = SIN[(size_t)row * 32 + lane];
            *(unsigned*)(KRO + (size_t)row * 64 + 2 * lane) = cvt_pk_bf16(x1 * c - x2 * s, x2 * c + x1 * s); }
    }
}

namespace att {
constexpr int NW = 8, QBLK = 32, KVBLK = 64;
constexpr int LDQ = 3072, LDK = 2048, LDR = 64, LDZ = 2048;
constexpr float SCALE = 0.07216878364870322f;
constexpr float THR = 8.f;
constexpr int SHM_V = 16384, SHM_K = 16384, SHM_R = 8192;
constexpr int OFF_V = 0, OFF_K = 2 * SHM_V, OFF_R = OFF_K + 2 * SHM_K, OFF_WS = OFF_R + 2 * SHM_R, OFF_QR = OFF_WS + 2048;
#define KSWZ(row, colB) ((row) * 256 + ((colB) ^ (((row) & 7) << 4)))
#define RSWZ(row, colB) ((row) * 128 + ((colB) ^ ((((row) >> 1) & 7) << 4)))
#define SBAR() __builtin_amdgcn_sched_barrier(0)
__device__ __forceinline__ int crow(int r, int hi) { return (r & 3) + 8 * (r >> 2) + 4 * hi; }
__device__ __forceinline__ void partialSM(f32x16& p0, f32x16& p1, float& m_reg, float& mn, float& alpha) {
    constexpr float C = SCALE * 1.4426950408889634f;
    float pmax = p0[0];
#pragma unroll
    for (int r = 1; r < 16; ++r) pmax = fmaxf(pmax, p0[r]);
#pragma unroll
    for (int r = 0; r < 16; ++r) pmax = fmaxf(pmax, p1[r]);
    { auto rr = __builtin_amdgcn_permlane32_swap(__float_as_uint(pmax), __float_as_uint(pmax), false, false);
      pmax = fmaxf(__uint_as_float(rr[0]), __uint_as_float(rr[1])); }
    if (__builtin_expect(__all(pmax - m_reg <= THR / SCALE), 1)) { mn = m_reg; alpha = 1.f; }
    else { mn = fmaxf(m_reg, pmax); alpha = __builtin_amdgcn_exp2f((m_reg - mn) * C); m_reg = mn; }
    const float mnC = -mn * C;
#pragma unroll
    for (int r = 0; r < 16; ++r) p0[r] = fmaf(p0[r], C, mnC);
#pragma unroll
    for (int r = 0; r < 16; ++r) p1[r] = fmaf(p1[r], C, mnC);
#pragma unroll
    for (int r = 0; r < 16; ++r) p0[r] = __builtin_amdgcn_exp2f(p0[r]);
}
__device__ __forceinline__ void finishSM(f32x16& p0, f32x16& p1, float alpha, float& l_reg, bf16x8& pa0, bf16x8& pa1, bf16x8& pa2, bf16x8& pa3) {
#pragma unroll
    for (int r = 0; r < 16; ++r) p1[r] = __builtin_amdgcn_exp2f(p1[r]);
    float ps = 0;
#pragma unroll
    for (int r = 0; r < 16; ++r) ps += p0[r];
#pragma unroll
    for (int r = 0; r < 16; ++r) ps += p1[r];
    { auto rr = __builtin_amdgcn_permlane32_swap(__float_as_uint(ps), __float_as_uint(ps), false, false);
      ps = __uint_as_float(rr[0]) + __uint_as_float(rr[1]); }
    l_reg = l_reg * alpha + ps;
#define PK4(P, BASE, OUT) do { unsigned a0 = cvt_pk_bf16(P[BASE + 0], P[BASE + 1]), a1 = cvt_pk_bf16(P[BASE + 2], P[BASE + 3]);   \
    unsigned b0 = cvt_pk_bf16(P[BASE + 4], P[BASE + 5]), b1 = cvt_pk_bf16(P[BASE + 6], P[BASE + 7]);                              \
    auto r0 = __builtin_amdgcn_permlane32_swap(a0, b0, false, false); auto r1 = __builtin_amdgcn_permlane32_swap(a1, b1, false, false); \
    u32x4 w = {r0[0], r1[0], r0[1], r1[1]}; OUT = *reinterpret_cast<bf16x8*>(&w); } while (0)
    PK4(p0, 0, pa0); PK4(p0, 8, pa1); PK4(p1, 0, pa2); PK4(p1, 8, pa3);
#undef PK4
}
__device__ __forceinline__ void qkt(f32x16& p0, f32x16& p1, const char* Ks, const char* Rs, const bf16x8* qr, const char* Qp, int r32, int hi) {
    p0 = f32x16{}; p1 = f32x16{};
#pragma unroll
    for (int d0 = 0; d0 < 8; ++d0) { const int cb = (d0 * 16 + hi * 8) * 2;
        const bf16x8 b0 = *reinterpret_cast<const bf16x8*>(Ks + KSWZ(r32, cb));
        const bf16x8 b1 = *reinterpret_cast<const bf16x8*>(Ks + KSWZ(32 + r32, cb));
        p0 = __builtin_amdgcn_mfma_f32_32x32x16_bf16(b0, qr[d0], p0, 0, 0, 0);
        p1 = __builtin_amdgcn_mfma_f32_32x32x16_bf16(b1, qr[d0], p1, 0, 0, 0); }
#pragma unroll
    for (int d0 = 0; d0 < 4; ++d0) { const int cb = (d0 * 16 + hi * 8) * 2;
        const bf16x8 b0 = *reinterpret_cast<const bf16x8*>(Rs + RSWZ(r32, cb));
        const bf16x8 b1 = *reinterpret_cast<const bf16x8*>(Rs + RSWZ(32 + r32, cb));
        const bf16x8 qq = *reinterpret_cast<const bf16x8*>(Qp + RSWZ(r32, cb));
        p0 = __builtin_amdgcn_mfma_f32_32x32x16_bf16(b0, qq, p0, 0, 0, 0);
        p1 = __builtin_amdgcn_mfma_f32_32x32x16_bf16(b1, qq, p1, 0, 0, 0); }
}
__device__ __forceinline__ int v_st(int k, int c) { const int kk = (k & ~0xC) | ((k & 4) << 1) | ((k & 8) >> 1); return ((kk >> 3) * 4 + (c >> 5)) * 512 + ((kk & 7) * 32 + (c & 31)) * 2; }
__device__ __forceinline__ int v_rd_base(int lane) { return ((lane & 3) << 3) | (((lane >> 2) & 3) << 6) | (((lane >> 4) & 1) << 5) | (((lane >> 5) & 1) << 8); }
constexpr int v_rd_off(int d0, int ks, int half) { return d0 * 512 + ks * 4096 + half * 2048; }
template <int OFF> __device__ __forceinline__ s16x4 tr_read(int vb) {
    s16x4 r; asm volatile("ds_read_b64_tr_b16 %0, %1 offset:%2" : "=&v"(r) : "v"(vb), "i"(OFF) : "memory"); return r;
}
template <int D0> __device__ __forceinline__ void pv_one(f32x16& od, int vb, bf16x8 pa0, bf16x8 pa1, bf16x8 pa2, bf16x8 pa3) {
    const s16x4 l0 = tr_read<v_rd_off(D0, 0, 0)>(vb), h0 = tr_read<v_rd_off(D0, 0, 1)>(vb), l1 = tr_read<v_rd_off(D0, 1, 0)>(vb), h1 = tr_read<v_rd_off(D0, 1, 1)>(vb);
    const s16x4 l2 = tr_read<v_rd_off(D0, 2, 0)>(vb), h2 = tr_read<v_rd_off(D0, 2, 1)>(vb), l3 = tr_read<v_rd_off(D0, 3, 0)>(vb), h3 = tr_read<v_rd_off(D0, 3, 1)>(vb);
    asm volatile("s_waitcnt lgkmcnt(0)" ::: "memory"); SBAR();
#define PK(L, H) (bf16x8){L[0], L[1], L[2], L[3], H[0], H[1], H[2], H[3]}
    od = __builtin_amdgcn_mfma_f32_32x32x16_bf16(pa0, PK(l0, h0), od, 0, 0, 0);
    od = __builtin_amdgcn_mfma_f32_32x32x16_bf16(pa1, PK(l1, h1), od, 0, 0, 0);
    od = __builtin_amdgcn_mfma_f32_32x32x16_bf16(pa2, PK(l2, h2), od, 0, 0, 0);
    od = __builtin_amdgcn_mfma_f32_32x32x16_bf16(pa3, PK(l3, h3), od, 0, 0, 0);
#undef PK
}
__device__ __forceinline__ void pv_d0(f32x16* o, int vb, bf16x8 pa0, bf16x8 pa1, bf16x8 pa2, bf16x8 pa3) {
    pv_one<0>(o[0], vb, pa0, pa1, pa2, pa3); pv_one<1>(o[1], vb, pa0, pa1, pa2, pa3); pv_one<2>(o[2], vb, pa0, pa1, pa2, pa3); pv_one<3>(o[3], vb, pa0, pa1, pa2, pa3);
}
__device__ __forceinline__ void attn_body(const bf16_t* __restrict__ Qb, const bf16_t* __restrict__ Kh, const bf16_t* __restrict__ Vh, const bf16_t* __restrict__ Rh,
                                          bf16_t* __restrict__ Zb, int seq, char* lds, int wv, bool nowrite) {
    const int tid = opaque_tid(wv), wid = wv, lane = tid & 63, r32 = lane & 31, hi = lane >> 5;
    char* V_lds = lds + OFF_V; char* K_lds = lds + OFF_K; char* R_lds = lds + OFF_R;
    float* ws = (float*)(lds + OFF_WS) + wid * 64; float* li_l = ws; float* al_l = ws + 32;
    float m_reg = -1e30f, l_reg = 0; f32x16 o[4] = {}; bf16x8 qr[8];
    const bf16_t* Qw = Qb + (long)(wid * QBLK + r32) * LDQ + hi * 8;
    char* Qp = lds + OFF_QR + wid * 4096;
#pragma unroll
    for (int d0 = 0; d0 < 8; ++d0) qr[d0] = *reinterpret_cast<const bf16x8*>(Qw + d0 * 16);
#pragma unroll
    for (int d0 = 0; d0 < 4; ++d0) *reinterpret_cast<bf16x8*>(Qp + RSWZ(r32, (d0 * 16 + hi * 8) * 2)) = *reinterpret_cast<const bf16x8*>(Qw + 128 + d0 * 16);
    const int sr = tid >> 4, sc = (tid & 15) * 8, vst0 = v_st(sr, sc), vst1 = v_st(32 + sr, sc);
    const int rr = tid >> 3, rc = (tid & 7) * 8;
    const int vb0 = (int)(uintptr_t)(LAS char*)V_lds + v_rd_base(lane);
    bf16x8 vs0, vs1, ks0, ks1, rs0;
#define SLOAD(k0) do { vs0 = *reinterpret_cast<const bf16x8*>(&Vh[(long)((k0) + sr) * LDK + sc]); vs1 = *reinterpret_cast<const bf16x8*>(&Vh[(long)((k0) + 32 + sr) * LDK + sc]); \
    ks0 = *reinterpret_cast<const bf16x8*>(&Kh[(long)((k0) + sr) * LDK + sc]); ks1 = *reinterpret_cast<const bf16x8*>(&Kh[(long)((k0) + 32 + sr) * LDK + sc]); \
    rs0 = *reinterpret_cast<const bf16x8*>(&Rh[(long)((k0) + rr) * LDR + rc]); } while (0)
#define SWRITE(b) do { *(bf16x8*)(V_lds + (b) * SHM_V + vst0) = vs0; *(bf16x8*)(V_lds + (b) * SHM_V + vst1) = vs1; const int kc = sc * 2; \
    *(bf16x8*)(K_lds + (b) * SHM_K + KSWZ(sr, kc)) = ks0; *(bf16x8*)(K_lds + (b) * SHM_K + KSWZ(32 + sr, kc)) = ks1; \
    *(bf16x8*)(R_lds + (b) * SHM_R + RSWZ(rr, rc * 2)) = rs0; } while (0)
#define SWAIT() asm volatile("s_waitcnt vmcnt(0)" ::: "memory")
#define RESC(a) do { if (__any((a) < 1.f)) { if (hi == 0) al_l[r32] = (a); asm volatile("s_waitcnt lgkmcnt(0)" ::: "memory"); \
    _Pragma("unroll") for (int d = 0; d < 4; ++d) _Pragma("unroll") for (int r = 0; r < 16; ++r) o[d][r] *= al_l[crow(r, hi)]; } } while (0)
    f32x16 pA0, pA1, pB0, pB1; float mnA, mnB, alA, alB; bf16x8 pa0, pa1, pa2, pa3; const int NT = seq / KVBLK;
    SLOAD(0); SWAIT(); SWRITE(0); __syncthreads();
    qkt(pA0, pA1, K_lds, R_lds, qr, Qp, r32, hi); partialSM(pA0, pA1, m_reg, mnA, alA);
    SLOAD(KVBLK);
    SWAIT(); SWRITE(1); __syncthreads();
    for (int j = 1; j + 1 < NT; j += 2) {
        SBAR(); qkt(pB0, pB1, K_lds + SHM_K, R_lds + SHM_R, qr, Qp, r32, hi);
        finishSM(pA0, pA1, alA, l_reg, pa0, pa1, pa2, pa3); SBAR();
        SLOAD((j + 1) * KVBLK); SBAR();
        pv_d0(o, vb0, pa0, pa1, pa2, pa3); partialSM(pB0, pB1, m_reg, mnB, alB);
        __syncthreads(); SWAIT(); SWRITE(0);
        RESC(alB); __syncthreads();
        SBAR(); qkt(pA0, pA1, K_lds, R_lds, qr, Qp, r32, hi);
        finishSM(pB0, pB1, alB, l_reg, pa0, pa1, pa2, pa3); SBAR();
        SLOAD((j + 2) * KVBLK); SBAR();
        pv_d0(o, vb0 + SHM_V, pa0, pa1, pa2, pa3); partialSM(pA0, pA1, m_reg, mnA, alA);
        __syncthreads(); SWAIT(); SWRITE(1);
        RESC(alA); __syncthreads();
    }
    SBAR(); qkt(pB0, pB1, K_lds + SHM_K, R_lds + SHM_R, qr, Qp, r32, hi);
    finishSM(pA0, pA1, alA, l_reg, pa0, pa1, pa2, pa3); SBAR();
    pv_d0(o, vb0, pa0, pa1, pa2, pa3); partialSM(pB0, pB1, m_reg, mnB, alB);
    __syncthreads(); RESC(alB);
    finishSM(pB0, pB1, alB, l_reg, pa0, pa1, pa2, pa3); SBAR();
    pv_d0(o, vb0 + SHM_V, pa0, pa1, pa2, pa3);
    if (hi == 0) li_l[r32] = l_reg; asm volatile("s_waitcnt lgkmcnt(0)" ::: "memory");
    float rli[16];
#pragma unroll
    for (int r = 0; r < 16; ++r) rli[r] = __builtin_amdgcn_rcpf(li_l[crow(r, hi)]);
    bf16_t* Zw = Zb + (long)(wid * QBLK + 4 * hi) * LDZ + r32;
    unsigned short zq[16][4];
#pragma unroll
    for (int r = 0; r < 16; ++r)
#pragma unroll
        for (int d0 = 0; d0 < 4; ++d0) zq[r][d0] = Zw[(long)((r & 3) + 8 * (r >> 2)) * LDZ + d0 * 32];
    asm volatile("s_waitcnt vmcnt(0)" ::: "memory"); SBAR();
#pragma unroll
    for (int r = 0; r < 16; ++r) {
#pragma unroll
        for (int d0 = 0; d0 < 4; ++d0) { const float z = bf2f(zq[r][d0]);
            if (!nowrite) Zw[(long)((r & 3) + 8 * (r >> 2)) * LDZ + d0 * 32] = (bf16_t)(cvt_pk_bf16(o[d0][r] * rli[r] * silu_f(z), 0.f) & 0xffffu); } }
    __syncthreads();
#undef SLOAD
#undef SWRITE
#undef SWAIT
#undef RESC
}
__device__ __forceinline__ void phase_attn(const bf16_t* QH, const bf16_t* KNH, const bf16_t* VH, const bf16_t* KRO, bf16_t* Z, int half, char* lds, int wv, bool nowrite) {
    const int c = blockIdx.x, G = gridDim.x;
    const int per = 2048 / G;
    for (int i = 0; i < per; ++i) {
        int bh, qb;
        if (G == 256) { const int xcd = c & 7, slot = c >> 3; bh = i * 32 + xcd * 4 + (slot >> 3); qb = slot & 7; }
        else { const int u = i * G + c; bh = u >> 3; qb = u & 7; }
        const int bl = bh >> 4, h = bh & 15;
        const size_t lrow = (size_t)bl * SEQ, grow = (size_t)half * TH + lrow;
        attn_body(QH + (lrow + qb * 256) * LDQ + h * 192, KNH + lrow * LDK + h * 128, VH + lrow * LDK + h * 128, KRO + grow * 64,
                  Z + (grow + qb * 256) * LDZ + h * 128, SEQ, lds, wv, nowrite);
    }
}
}

#ifndef SC_MASK
#define SC_MASK 0xFFFF
#endif
#define SCB(i) do { if (SC_MASK & (1 << (i))) __builtin_amdgcn_sched_barrier(0); } while (0)
namespace scan {
constexpr int QE_ST = 272, KE_ST = 320, P_ST = 144, V_ST = 576, BC_ST = 528;
constexpr int OFF_QE = 0, OFF_KE = OFF_QE + 64 * QE_ST, OFF_P = OFF_KE + 64 * KE_ST, OFF_V = OFF_P + 64 * P_ST, OFF_BC = OFF_V + 64 * V_ST,
              OFF_GLR = OFF_BC + 64 * BC_ST, OFF_PART = OFF_GLR + 4096, OFF_EBT = OFF_PART + 2048, OFF_WG = OFF_EBT + 512, OFF_SSQW = OFF_WG + 8192, OFF_RN = OFF_SSQW + 2048, OFF_G = OFF_RN + 256, OFF_END = OFF_G + 1024;
static_assert(OFF_END <= LDS_BYTES, "scan LDS");
template <int OFF> __device__ __forceinline__ s16x4 tr_read(int vb) {
    s16x4 r; asm volatile("ds_read_b64_tr_b16 %0, %1 offset:%2" : "=&v"(r) : "v"(vb), "i"(OFF) : "memory"); return r;
}
#define PK8(L, H) (bf16x8){L[0], L[1], L[2], L[3], H[0], H[1], H[2], H[3]}
#define LAUNDER(t) const int t = opaque_tid(wv)
__device__ __forceinline__ void phase_scan(const bf16_t* QK, const bf16_t* V, const float* GLR, bf16_t* OFW, const float* wgate, const float* bgate, char* lds, int wv,
                                           bf16_t* Z, const float* gn, unsigned long long* X, unsigned tag) {
    const int wid = wv;
    for (int item = blockIdx.x; item < 256; item += gridDim.x) {
        const int b = item >> 3, h = (item >> 1) & 3, vh = item & 1;
        __syncthreads();
        { LAUNDER(t); if (t < 256) *(float*)(lds + OFF_G + t * 4) = gn[h * 512 + vh * 256 + t]; }
        for (int dir = 0; dir < 2; ++dir) {
            __syncthreads();
            float bgv; float wgb[8];
            { LAUNDER(t); const int ln = t & 63, r32_ = ln & 31, hi_ = ln >> 5, db_ = wid & 3;
#pragma unroll
              for (int kk = 0; kk < 8; ++kk) wgb[kk] = wgate[((size_t)dir * 16 + 2 * kk + hi_) * 512 + h * 128 + db_ * 32 + r32_];
              bgv = bgate[(size_t)dir * 512 + h * 128 + db_ * 32 + r32_]; }
            f32x16 S[4];
#pragma unroll
            for (int i = 0; i < 4; ++i) S[i] = f32x16{};
            bf16x8 rq[2], rk[2], rv[4]; f32x2 rg;
#define CLOAD_QK(n) do { LAUNDER(t_); const unsigned qo_ = (unsigned)((t_ >> 4) * 1024 + (t_ & 15) * 8) * 2u; const size_t t0_ = (size_t)b * SEQ + (size_t)(n) * 64; const char* qb_ = (const char*)QK + (t0_ * 1024 + h * 128) * 2; \
    rq[0] = *(const bf16x8*)(qb_ + qo_); rq[1] = *(const bf16x8*)(qb_ + 65536 + qo_); rk[0] = *(const bf16x8*)(qb_ + 1024 + qo_); rk[1] = *(const bf16x8*)(qb_ + 1024 + 65536 + qo_); } while (0)
#define CLOAD_VG(n) do { LAUNDER(t_); const unsigned vo_ = (unsigned)((t_ >> 5) * 2048 + (t_ & 31) * 8) * 2u, go_ = (unsigned)((t_ >> 3) * 32 + (t_ & 7) * 2) * 4u; const size_t t0_ = (size_t)b * SEQ + (size_t)(n) * 64; \
    const char* vb_ = (const char*)V + (t0_ * 2048 + h * 512 + vh * 256) * 2; const char* gb_ = (const char*)GLR + (t0_ * 32 + dir * 16) * 4; \
    _Pragma("unroll") for (int i = 0; i < 4; ++i) rv[i] = *(const bf16x8*)(vb_ + (size_t)i * 65536 + vo_); \
    rg = *(const f32x2*)(gb_ + go_); } while (0)
            CLOAD_QK(dir == 0 ? 0 : 31); CLOAD_VG(dir == 0 ? 0 : 31);
#define LBAR() do { asm volatile("s_waitcnt lgkmcnt(0)" ::: "memory"); __builtin_amdgcn_s_barrier(); asm volatile("" ::: "memory"); } while (0)
#define STAGE_VG() do { LAUNDER(t_); const int vr = t_ >> 5, vc = (t_ & 31) * 8, gr = t_ >> 3, gc = (t_ & 7) * 2; \
    _Pragma("unroll") for (int i = 0; i < 4; ++i) *(bf16x8*)(lds + OFF_V + (vr + 16 * i) * V_ST + vc * 2) = rv[i]; \
    *(f32x2*)(lds + OFF_GLR + gr * 64 + gc * 4) = rg; } while (0)
#define XSLOT(nc, half_) (X + ((((size_t)(b * 4 + h) * 32 + (nc)) * 2 + (half_)) * 64))
#define GN_PUBLISH(nc) do { if (wid == 0) { LAUNDER(t_); const int ln_ = t_ & 63; float own_ = 0.f; \
    _Pragma("unroll") for (int w_ = 0; w_ < 8; ++w_) own_ += *(const float*)(lds + OFF_SSQW + (w_ * 64 + ln_) * 4); hown = own_; \
    const unsigned long long g_ = ((unsigned long long)tag << 32) | (unsigned long long)__float_as_uint(own_); \
    __hip_atomic_store(XSLOT(nc, vh) + ln_, g_, __ATOMIC_RELAXED, __HIP_MEMORY_SCOPE_AGENT); } } while (0)
#define GN_POLL(nc) do { if (wid == 0) { LAUNDER(t_); const int ln_ = t_ & 63; unsigned long long g_ = 0ull; unsigned sp_ = 0u; \
    for (;;) { g_ = __hip_atomic_load(XSLOT(nc, vh ^ 1) + ln_, __ATOMIC_RELAXED, __HIP_MEMORY_SCOPE_AGENT); if ((unsigned)(g_ >> 32) == tag || ++sp_ > (1u << 22)) break; __builtin_amdgcn_s_sleep(1); } \
    const float tot_ = hown + __uint_as_float((unsigned)g_); *(float*)(lds + OFF_RN + ln_ * 4) = rsqrtf(tot_ * (1.f / 512.f) + EPS); } } while (0)
#define GN_FINAL(nc) do { LAUNDER(t_); const int ln_ = t_ & 63; const float r_ = *(const float*)(lds + OFF_RN + ln_ * 4); \
    bf16_t* zr_ = Z + ((size_t)b * SEQ + (size_t)(nc) * 64 + ln_) * 2048 + h * 512 + vh * 256 + wid * 32; \
    _Pragma("unroll") for (int j_ = 0; j_ < 4; ++j_) { const f32x4 g0_ = *(const f32x4*)(lds + OFF_G + (wid * 32 + j_ * 8) * 4), g1_ = *(const f32x4*)(lds + OFF_G + (wid * 32 + j_ * 8 + 4) * 4); \
        const f32x4 a_ = hs[2 * j_], c_ = hs[2 * j_ + 1]; const u32x4 z_ = hz[j_]; \
        u32x4 w_ = {cvt_pk_bf16(a_[0] * r_ * g0_[0] * silu_fast(bflo(z_[0])), a_[1] * r_ * g0_[1] * silu_fast(bfhi(z_[0]))), cvt_pk_bf16(a_[2] * r_ * g0_[2] * silu_fast(bflo(z_[1])), a_[3] * r_ * g0_[3] * silu_fast(bfhi(z_[1]))), \
                    cvt_pk_bf16(c_[0] * r_ * g1_[0] * silu_fast(bflo(z_[2])), c_[1] * r_ * g1_[1] * silu_fast(bfhi(z_[2]))), cvt_pk_bf16(c_[2] * r_ * g1_[2] * silu_fast(bflo(z_[3])), c_[3] * r_ * g1_[3] * silu_fast(bfhi(z_[3])))}; \
        *(u32x4*)(zr_ + j_ * 8) = w_; __builtin_amdgcn_sched_barrier(0); } } while (0)
            STAGE_VG();
            CLOAD_VG(dir == 0 ? 1 : 30);
            LBAR();
            for (int step = 0; step < 32; ++step) {
                const int n = dir == 0 ? step : 31 - step;
                const size_t t0 = (size_t)b * SEQ + (size_t)n * 64;
                {
                    LAUNDER(t); const int ln = t & 63, r32 = ln & 31, hi = ln >> 5, cb = wid >> 2, db = wid & 3, d = db * 32 + r32;
                    f32x4 ar[4];
#pragma unroll
                    for (int i = 0; i < 4; ++i) ar[i] = *(const f32x4*)(lds + OFF_GLR + (cb * 32 + r32) * 64 + i * 16);
                    asm volatile("s_waitcnt lgkmcnt(0)" ::: "memory"); __builtin_amdgcn_sched_barrier(0);
                    f32x16 pa;
#pragma unroll
                    for (int r = 0; r < 16; ++r) pa[r] = bgv;
#pragma unroll
                    for (int kk = 0; kk < 8; ++kk) { const float a = hi ? ar[kk >> 1][2 * (kk & 1) + 1] : ar[kk >> 1][2 * (kk & 1)];
                        pa = __builtin_amdgcn_mfma_f32_32x32x2f32(a, wgb[kk], pa, 0, 0, 0); }
                    float lgv[16], pl[16];
#pragma unroll
                    for (int r = 0; r < 16; ++r) { const float pre = pa[r]; lgv[r] = -(fmaxf(-pre, 0.f) + __logf(1.f + __expf(-fabsf(pre)))) * (0.0625f * 1.4426950408889634f); }
#pragma unroll
                    for (int k = 0; k < 4; ++k) { pl[4 * k] = lgv[4 * k]; pl[4 * k + 1] = pl[4 * k] + lgv[4 * k + 1]; pl[4 * k + 2] = pl[4 * k + 1] + lgv[4 * k + 2]; pl[4 * k + 3] = pl[4 * k + 2] + lgv[4 * k + 3]; }
#pragma unroll
                    for (int k = 0; k < 4; ++k) *(float*)(lds + OFF_P + ((cb * 8 + 2 * k + hi) * 128 + d) * 4) = pl[4 * k + 3];
                    LBAR();
                    float gsv[16];
#pragma unroll
                    for (int g = 0; g < 16; ++g) gsv[g] = *(const float*)(lds + OFF_P + (g * 128 + d) * 4);
                    asm volatile("s_waitcnt lgkmcnt(0)" ::: "memory"); __builtin_amdgcn_sched_barrier(0);
                    float ex[16]; float run = 0.f;
#pragma unroll
                    for (int g = 0; g < 16; ++g) { ex[g] = run; run += gsv[g]; }
                    const float tot = run;
#pragma unroll
                    for (int k = 0; k < 4; ++k) { const float e0 = cb ? ex[8 + 2 * k] : ex[2 * k], e1 = cb ? ex[8 + 2 * k + 1] : ex[2 * k + 1]; const float off = hi ? e1 : e0;
#pragma unroll
                        for (int e = 0; e < 4; ++e) { const int r = 4 * k + e; const float bc = dir == 0 ? off + pl[r] : tot - (off + pl[r] - lgv[r]);
                            *(float*)(lds + OFF_BC + (cb * 32 + e + 8 * k + 4 * hi) * BC_ST + d * 4) = bc; } }
                    if (cb == 0 && hi == 0) *(float*)(lds + OFF_EBT + d * 4) = __builtin_amdgcn_exp2f(tot);
                }
                LBAR();
                { LAUNDER(t); const int sr = t >> 4, sc = (t & 15) * 8;
#pragma unroll
                  for (int i = 0; i < 2; ++i) { const int row = sr + 32 * i;
                    const f32x4 b0 = *(const f32x4*)(lds + OFF_BC + row * BC_ST + sc * 4), b1 = *(const f32x4*)(lds + OFF_BC + row * BC_ST + sc * 4 + 16);
                    const bf16x8 qv = rq[i], kv = rk[i];
                    float qf[8], kf[8];
#pragma unroll
                    for (int e = 0; e < 8; ++e) { const float bb = e < 4 ? b0[e] : b1[e - 4]; const float eb = __builtin_amdgcn_exp2f(bb), ei = __builtin_amdgcn_exp2f(-bb);
                        qf[e] = bf2f((unsigned short)qv[e]) * eb; kf[e] = bf2f((unsigned short)kv[e]) * ei; }
                    u32x4 qw = {cvt_pk_bf16(qf[0], qf[1]), cvt_pk_bf16(qf[2], qf[3]), cvt_pk_bf16(qf[4], qf[5]), cvt_pk_bf16(qf[6], qf[7])};
                    u32x4 kw = {cvt_pk_bf16(kf[0], kf[1]), cvt_pk_bf16(kf[2], kf[3]), cvt_pk_bf16(kf[4], kf[5]), cvt_pk_bf16(kf[6], kf[7])};
                    *(u32x4*)(lds + OFF_QE + row * QE_ST + sc * 2) = qw; *(u32x4*)(lds + OFF_KE + row * KE_ST + sc * 2) = kw; } }
                if (step + 1 < 32) { const int nn = dir == 0 ? step + 1 : 30 - step; CLOAD_QK(nn); }
                u32x4 pf[4];
                bf16_t* orow;
                { LAUNDER(t); const int ln = t & 63; orow = OFW + ((((size_t)item * 32 + n) * 8 + wid) * 256 + ln) * 8; }
                if (dir == 1) {
#pragma unroll
                    for (int j = 0; j < 4; ++j) pf[j] = *(const u32x4*)(orow + j * 512);
                }
                LBAR();
                { LAUNDER(t); const int fr = t & 15, fq = (t >> 4) & 3;
#pragma unroll
                  for (int tt = 0; tt < 2; ++tt) { const int tl = wid * 2 + tt, it = tl >> 2, jt = tl & 3;
                    f32x4 pc = {0.f, 0.f, 0.f, 0.f};
                    bf16x8 af[4], bfg[4];
#pragma unroll
                    for (int ks = 0; ks < 4; ++ks) {
                        af[ks] = *(const bf16x8*)(lds + OFF_KE + (jt * 16 + fr) * KE_ST + (ks * 32 + fq * 8) * 2);
                        bfg[ks] = *(const bf16x8*)(lds + OFF_QE + (it * 16 + fr) * QE_ST + (ks * 32 + fq * 8) * 2); }
                    asm volatile("s_waitcnt lgkmcnt(0)" ::: "memory"); SCB(1);
#pragma unroll
                    for (int ks = 0; ks < 4; ++ks) pc = __builtin_amdgcn_mfma_f32_16x16x32_bf16(af[ks], bfg[ks], pc, 0, 0, 0);
                    const int ii = it * 16 + fr, j0 = jt * 16 + fq * 4;
                    float pm[4];
#pragma unroll
                    for (int e = 0; e < 4; ++e) pm[e] = (dir == 0 ? (j0 + e <= ii) : (j0 + e >= ii)) ? pc[e] : 0.f;
                    u32x2 pw = {cvt_pk_bf16(pm[0], pm[1]), cvt_pk_bf16(pm[2], pm[3])};
                    *(u32x2*)(lds + OFF_P + ii * P_ST + j0 * 2) = pw; } }
                bf16x8 vf[4];
                f32x16 o0 = f32x16{}, o1 = f32x16{};
                {
                    LAUNDER(t); const int ln = t & 63, hi = ln >> 5, r32 = ln & 31, m16 = ln & 15, g16 = (ln >> 4) & 1;
                    const int ldsb = (int)(uintptr_t)(LAS char*)lds;
                    const int trv = ldsb + OFF_V + (8 * hi + (m16 >> 2)) * V_ST + (wid * 32 + 16 * g16 + 4 * (m16 & 3)) * 2;
                    const int trk = ldsb + OFF_KE + (8 * hi + (m16 >> 2)) * KE_ST + (16 * g16 + 4 * (m16 & 3)) * 2;
                    {
                    const s16x4 l0 = tr_read<0 * 16 * V_ST>(trv), h0 = tr_read<0 * 16 * V_ST + 4 * V_ST>(trv), l1 = tr_read<1 * 16 * V_ST>(trv), h1 = tr_read<1 * 16 * V_ST + 4 * V_ST>(trv);
                    const s16x4 l2 = tr_read<2 * 16 * V_ST>(trv), h2 = tr_read<2 * 16 * V_ST + 4 * V_ST>(trv), l3 = tr_read<3 * 16 * V_ST>(trv), h3 = tr_read<3 * 16 * V_ST + 4 * V_ST>(trv);
                    asm volatile("s_waitcnt lgkmcnt(0)" ::: "memory"); SCB(2);
                    vf[0] = PK8(l0, h0); vf[1] = PK8(l1, h1); vf[2] = PK8(l2, h2); vf[3] = PK8(l3, h3);
                    }
                    const char* qa = lds + OFF_QE + r32 * QE_ST + 8 * hi;
#pragma unroll
                    for (int db = 0; db < 4; ++db) {
                        s16x4 al[2][2], ah[2][2];
#pragma unroll
                        for (int s = 0; s < 2; ++s) { const int dcol = (db * 32 + 16 * s) * 2;
                            al[s][0] = *(const s16x4*)(qa + dcol); ah[s][0] = *(const s16x4*)(qa + dcol + 16);
                            al[s][1] = *(const s16x4*)(qa + 32 * QE_ST + dcol); ah[s][1] = *(const s16x4*)(qa + 32 * QE_ST + dcol + 16); }
                        bf16x8 bfr[2];
#pragma unroll
                        for (int s = 0; s < 2; ++s) {
                            u32x4 bw = {cvt_pk_bf16(S[db][8 * s + 0], S[db][8 * s + 1]), cvt_pk_bf16(S[db][8 * s + 2], S[db][8 * s + 3]),
                                        cvt_pk_bf16(S[db][8 * s + 4], S[db][8 * s + 5]), cvt_pk_bf16(S[db][8 * s + 6], S[db][8 * s + 7])};
                            bfr[s] = *reinterpret_cast<bf16x8*>(&bw); }
                        asm volatile("s_waitcnt lgkmcnt(0)" ::: "memory"); SCB(3);
#pragma unroll
                        for (int s = 0; s < 2; ++s) {
                            o0 = __builtin_amdgcn_mfma_f32_32x32x16_bf16(PK8(al[s][0], ah[s][0]), bfr[s], o0, 0, 0, 0);
                            o1 = __builtin_amdgcn_mfma_f32_32x32x16_bf16(PK8(al[s][1], ah[s][1]), bfr[s], o1, 0, 0, 0); }
                    }
                    const char* ebp = lds + OFF_EBT + 16 * hi;
#define SUPD(DB) do { \
    const s16x4 l0 = tr_read<(DB) * 64 + 0 * 16 * KE_ST>(trk), h0 = tr_read<(DB) * 64 + 0 * 16 * KE_ST + 4 * KE_ST>(trk), l1 = tr_read<(DB) * 64 + 1 * 16 * KE_ST>(trk), h1 = tr_read<(DB) * 64 + 1 * 16 * KE_ST + 4 * KE_ST>(trk); \
    const s16x4 l2 = tr_read<(DB) * 64 + 2 * 16 * KE_ST>(trk), h2 = tr_read<(DB) * 64 + 2 * 16 * KE_ST + 4 * KE_ST>(trk), l3 = tr_read<(DB) * 64 + 3 * 16 * KE_ST>(trk), h3 = tr_read<(DB) * 64 + 3 * 16 * KE_ST + 4 * KE_ST>(trk); \
    asm volatile("s_waitcnt lgkmcnt(0)" ::: "memory"); SCB(4); \
    S[DB] = __builtin_amdgcn_mfma_f32_32x32x16_bf16(PK8(l0, h0), vf[0], S[DB], 0, 0, 0); \
    S[DB] = __builtin_amdgcn_mfma_f32_32x32x16_bf16(PK8(l1, h1), vf[1], S[DB], 0, 0, 0); \
    S[DB] = __builtin_amdgcn_mfma_f32_32x32x16_bf16(PK8(l2, h2), vf[2], S[DB], 0, 0, 0); \
    S[DB] = __builtin_amdgcn_mfma_f32_32x32x16_bf16(PK8(l3, h3), vf[3], S[DB], 0, 0, 0); \
    _Pragma("unroll") for (int g = 0; g < 4; ++g) { const f32x4 eb = *(const f32x4*)(ebp + ((DB) * 32 + 8 * g) * 4); \
        S[DB][4 * g + 0] *= eb[0]; S[DB][4 * g + 1] *= eb[1]; S[DB][4 * g + 2] *= eb[2]; S[DB][4 * g + 3] *= eb[3]; } asm volatile("" : "+v"(S[DB])); } while (0)
                    SUPD(0); SUPD(1); SUPD(2); SUPD(3);
#undef SUPD
                }
                LBAR();
                if (step + 1 < 32) { STAGE_VG(); if (step + 2 < 32) { const int nn = dir == 0 ? step + 2 : 29 - step; CLOAD_VG(nn); } }

                {
                    LAUNDER(t); const int ln = t & 63, hi = ln >> 5, r32 = ln & 31;
                    const char* pa = lds + OFF_P + r32 * P_ST + 16 * hi;
                    bf16x8 pa0[4], pa1[4];
#pragma unroll
                    for (int ks = 0; ks < 4; ++ks) { pa0[ks] = *(const bf16x8*)(pa + ks * 32); pa1[ks] = *(const bf16x8*)(pa + 32 * P_ST + ks * 32); }
                    asm volatile("s_waitcnt lgkmcnt(0)" ::: "memory"); SCB(5);
#pragma unroll
                    for (int ks = 0; ks < 4; ++ks) {
                        o0 = __builtin_amdgcn_mfma_f32_32x32x16_bf16(pa0[ks], vf[ks], o0, 0, 0, 0);
                        o1 = __builtin_amdgcn_mfma_f32_32x32x16_bf16(pa1[ks], vf[ks], o1, 0, 0, 0);
                    }
                    if (dir == 0) {
#pragma unroll
                        for (int j = 0; j < 4; ++j) {
                            u32x4 w;
                            if (j < 2) w = (u32x4){cvt_pk_bf16(o0[8 * j + 0], o0[8 * j + 1]), cvt_pk_bf16(o0[8 * j + 2], o0[8 * j + 3]), cvt_pk_bf16(o0[8 * j + 4], o0[8 * j + 5]), cvt_pk_bf16(o0[8 * j + 6], o0[8 * j + 7])};
                            else { const int k = j - 2; w = (u32x4){cvt_pk_bf16(o1[8 * k + 0], o1[8 * k + 1]), cvt_pk_bf16(o1[8 * k + 2], o1[8 * k + 3]), cvt_pk_bf16(o1[8 * k + 4], o1[8 * k + 5]), cvt_pk_bf16(o1[8 * k + 6], o1[8 * k + 7])}; }
                            *(u32x4*)(orow + j * 512) = w;
                        }
                    } else {
#pragma unroll
                        for (int j = 0; j < 2; ++j)
#pragma unroll
                            for (int e = 0; e < 4; ++e) { o0[8 * j + 2 * e] += bflo(pf[j][e]); o0[8 * j + 2 * e + 1] += bfhi(pf[j][e]); o1[8 * j + 2 * e] += bflo(pf[2 + j][e]); o1[8 * j + 2 * e + 1] += bfhi(pf[2 + j][e]); }
                        char* ost = lds + (wid < 4 ? OFF_QE + wid * 8192 : OFF_BC + (wid - 4) * 8192);
#pragma unroll
                        for (int r = 0; r < 16; ++r) { const int ic = (r & 3) + 8 * (r >> 2) + 4 * hi;
                            const int sw = ((((r32 >> 2) ^ (ic & 7)) << 4) | ((r32 & 3) << 2));
                            *(float*)(ost + ic * 128 + sw) = o0[r]; *(float*)(ost + (32 + ic) * 128 + sw) = o1[r]; }
                        asm volatile("s_waitcnt lgkmcnt(0)" ::: "memory"); __builtin_amdgcn_sched_barrier(0);
                        f32x4 oa[4], oc[4];
#pragma unroll
                        for (int j = 0; j < 4; ++j) { oa[j] = *(const f32x4*)(ost + ln * 128 + (((2 * j) ^ (ln & 7)) << 4)); oc[j] = *(const f32x4*)(ost + ln * 128 + (((2 * j + 1) ^ (ln & 7)) << 4)); }
                        asm volatile("s_waitcnt lgkmcnt(0)" ::: "memory"); SCB(6);
                        f32x4 hs[8]; u32x4 hz[4]; float hown = 0.f;
                        float ss = 0.f;
#pragma unroll
                        for (int j = 0; j < 4; ++j) {
                            const f32x4 a = oa[j], c = oc[j];
                            ss += a[0] * a[0] + a[1] * a[1] + a[2] * a[2] + a[3] * a[3] + c[0] * c[0] + c[1] * c[1] + c[2] * c[2] + c[3] * c[3];
                            hs[2 * j] = a; hs[2 * j + 1] = c;
                        }
                        *(float*)(lds + OFF_SSQW + (wid * 64 + ln) * 4) = ss;
                        const bf16_t* zr = Z + (t0 + ln) * 2048 + h * 512 + vh * 256 + wid * 32;
#pragma unroll
                        for (int j = 0; j < 4; ++j) hz[j] = *(const u32x4*)(zr + j * 8);
                        LBAR();
                        GN_PUBLISH(n); GN_POLL(n);
                        LBAR();
                        GN_FINAL(n);
                    }
                }
                if (dir == 0) LBAR();
            }
#undef LBAR
#undef STAGE_VG
#undef XSLOT
#undef GN_PUBLISH
#undef GN_POLL
#undef GN_FINAL
#undef CLOAD_QK
#undef CLOAD_VG
        }
    }
}
#undef LAUNDER
#undef PK8
}


#define XB_TMO      128
#define XB_XCNT(j)  (256  + 64 * (j))
#define XB_XSUB(j)  (1280 + 64 * (j))
#define XB_XGEN(j)  (2304 + 64 * (j))
#define XB_TOP      3328
#define XB_TOPGEN   3392
#define XCD_BAR_WORDS 3456
#define XB_SPIN_CAP (1u << 18)
__device__ __forceinline__ unsigned xb_ld(unsigned* p)              { return __hip_atomic_load(p, __ATOMIC_RELAXED, __HIP_MEMORY_SCOPE_AGENT); }
__device__ __forceinline__ unsigned xb_add(unsigned* p, unsigned v) { return __hip_atomic_fetch_add(p, v, __ATOMIC_RELAXED, __HIP_MEMORY_SCOPE_AGENT); }
__device__ __forceinline__ unsigned xb_xcc_id() { return (unsigned)__builtin_amdgcn_s_getreg((3 << 11) | 20) & 0xFu; }
#define XB_SPIN(cond, bar) do { unsigned _sp = 0; while (cond) { __builtin_amdgcn_s_sleep(1); \
    if ((++_sp & 255u) == 0u) { if (xb_ld(&(bar)[XB_TMO])) break; if (_sp > XB_SPIN_CAP) { atomicAdd(&(bar)[XB_TMO], 1u); break; } } } } while (0)
__device__ __forceinline__ void xcd_barrier_complete(unsigned* bar, unsigned x, unsigned& nloc, unsigned& nx) {
    const unsigned G = gridDim.x;
    unsigned sum, cnt, mine, sp = 0u;
    for (;;) {
        sum = 0u; cnt = 0u; mine = 0u;
#pragma unroll
        for (unsigned j = 0; j < 16; ++j) { const unsigned c = xb_ld(&bar[XB_XCNT(j)]); sum += c; cnt += (c > 0u) ? 1u : 0u; mine = (j == x) ? c : mine; }
        if (sum == G) break;
        __builtin_amdgcn_s_sleep(1);
        if ((++sp & 255u) == 0u) { if (xb_ld(&bar[XB_TMO])) break; if (sp > XB_SPIN_CAP) { atomicAdd(&bar[XB_TMO], 1u); break; } }
    }
    nloc = mine > 0u ? mine : 1u; nx = cnt > 0u ? cnt : 1u;
}
__device__ __forceinline__ void xcd_barrier(unsigned* bar, unsigned x, volatile LAS unsigned* st, int wv) {
    asm volatile("s_waitcnt vmcnt(0)" ::: "memory");
    __syncthreads();
    if (wv == 0 && opaque_lane() == 0) {
        __builtin_amdgcn_s_waitcnt(0);
        unsigned nloc = st[0], nx = st[1];
        if (nloc == 0u) { xcd_barrier_complete(bar, x, nloc, nx); st[0] = nloc; st[1] = nx; }
        const unsigned old = xb_add(&bar[XB_XSUB(x)], 1u);
        const unsigned gen = old / nloc;
        if (old + 1u == (gen + 1u) * nloc) {
            __builtin_amdgcn_fence(__ATOMIC_RELEASE, "agent");
            asm volatile("s_waitcnt vmcnt(0)" ::: "memory");
            const unsigned og = xb_add(&bar[XB_TOP], 1u);
            const unsigned tg = og / nx;
            if (og + 1u == (tg + 1u) * nx) xb_add(&bar[XB_TOPGEN], 1u);
            else XB_SPIN(xb_ld(&bar[XB_TOPGEN]) == tg, bar);
            __builtin_amdgcn_fence(__ATOMIC_ACQUIRE, "agent");
            xb_add(&bar[XB_XGEN(x)], 1u);
            asm volatile("s_waitcnt vmcnt(0)" ::: "memory");
        } else {
            XB_SPIN(xb_ld(&bar[XB_XGEN(x)]) == gen, bar);
            __builtin_amdgcn_fence(__ATOMIC_ACQUIRE, "agent");
            asm volatile("s_waitcnt vmcnt(0)" ::: "memory");
        }
    }
    __syncthreads();
}

constexpr int NPHASE = 23;
#ifndef MK_EN
#define MK_EN 0xFFFF
#endif
#ifndef MK_DUP
#define MK_DUP 0
#endif
#define REPS(bit) for (int rep_ = 0, nrep_ = (MK_DUP & (bit)) ? 2 : 1; rep_ < nrep_; ++rep_)
__global__ void __launch_bounds__(512, 2) mk_fwd(Params p) {
    extern __shared__ __attribute__((aligned(16))) unsigned char lds[];
    LAS unsigned char* lds3 = (LAS unsigned char*)lds;
    typedef const __attribute__((address_space(4))) Params* KP;
    const int wv = __builtin_amdgcn_readfirstlane((int)(threadIdx.x >> 6));
    volatile LAS unsigned* bst = (volatile LAS unsigned*)(lds3 + LDS_ST_OFF);
    if (threadIdx.x == 0) { bst[0] = 0u; bst[1] = 0u; }
    __syncthreads();
    const unsigned bx = xb_xcc_id();
    if (threadIdx.x == 0) (void)xb_add(&((unsigned*)(p.ws + WS_BAR))[XB_XCNT(bx)], 1u);
    const int ph_lo = p.ph_lo, ph_hi = p.ph_hi;
    if (ph_lo == 0) {
        KP pp0 = (KP)__builtin_amdgcn_kernarg_segment_ptr();
        if (MK_EN & 1) REPS(1) phase_prep(pp0, lds, wv);
        if (ph_hi > 1) cg::this_grid().sync();
    }
    const int nrounds = (MK_DUP & 4096) ? 2 : 1;
    for (int ph2 = ph_lo > 1 ? ph_lo : 1; ph2 < ph_hi * nrounds; ++ph2) {
        const int ph = ph2 >= ph_hi ? ph2 - ph_hi : ph2;
        if (ph == 0) { KP pp0 = (KP)__builtin_amdgcn_kernarg_segment_ptr(); phase_prep(pp0, lds, wv); xcd_barrier((unsigned*)(p.ws + WS_BAR), xb_xcc_id(), (volatile LAS unsigned*)(lds3 + LDS_ST_OFF), wv); continue; }
        int q = ph; asm volatile("" : "+s"(q));
        KP pp = (KP)__builtin_amdgcn_kernarg_segment_ptr(); asm volatile("" : "+s"(pp));
        unsigned char* ws = pp->ws;
        const int G = gridDim.x, c = blockIdx.x;
        int kind, L = 0, half = 0;
        if (q == 0) kind = 0;
        else { const int pr = (q - 1) / 11, r = (q - 1) % 11;
            if (r < 4) { L = 2 * pr; kind = r == 0 ? 1 : r == 1 ? 2 : r == 2 ? 4 : 5; } else { L = 2 * pr + 1; const int r2 = r - 4;
                if (r2 == 0) kind = 6; else if (r2 < 5) { half = (r2 - 1) >> 1; kind = 8 + ((r2 - 1) & 1); } else kind = r2 == 5 ? 4 : 5; } }
        const int j = L >> 1;
        float* XRES = pp->out;
        bf16_t* XB = (bf16_t*)(ws + WS_XB);
        if (kind == 1) { pg8::Gemm g{XB, (const bf16_t*)(ws + W_GIN + j * W_GIN_SZ), T, GLA_NPAD, 1024}; pg8::StaticOrder S; S.init(T, GLA_NPAD, G, c);
            pg8::EpiGlaIn E{(bf16_t*)(ws + WS_GQK), (bf16_t*)(ws + WS_GV), (bf16_t*)(ws + WS_GZ), (float*)(ws + WS_GLR)}; if (MK_EN & 2) REPS(2) pg8::gemm_phase(lds3, g, S, E, wv); }
        else if (kind == 2) { if (MK_EN & 4) scan::phase_scan((const bf16_t*)(ws + WS_GQK), (const bf16_t*)(ws + WS_GV), (const float*)(ws + WS_GLR), (bf16_t*)(ws + WS_OFW),
                                                              pp->gla_w_gate + (size_t)j * 2 * 16 * 512, pp->gla_b_gate + (size_t)j * 2 * 512, (char*)lds, wv,
                                                              (bf16_t*)(ws + WS_GZ), pp->gla_gn_g + (size_t)j * 2048, (unsigned long long*)(ws + WS_XCH), (unsigned)(j + 1)); }
        else if (kind == 3) { if (MK_EN & 8) REPS(8) phase_gla_gate((const bf16_t*)(ws + WS_OFW), (bf16_t*)(ws + WS_GZ), pp->gla_gn_g + (size_t)j * 2048, wv, rep_ + 1 < nrep_); }
        else if (kind == 4) { const bool gla = (L & 1) == 0; const float* xin = L == 0 ? pp->x : XRES;
            pg8::Gemm g{(const bf16_t*)(ws + (gla ? WS_GZ : WS_MZ)), (const bf16_t*)(ws + (gla ? W_GOUT : W_MOUT) + j * W_OUT_SZ), T, 1024, 2048}; pg8::StaticOrder S; S.init(T, 1024, G, c);
            if (MK_EN & 16) REPS(16) { pg8::EpiRes E{XRES, xin, L == 0 ? (const f32x2*)nullptr : (const f32x2*)(ws + WS_STATS), pp->ln_g + (L - 1) * 1024, pp->ln_b + (L - 1) * 1024, rep_ + 1 < nrep_}; pg8::gemm_phase(lds3, g, S, E, wv); } }
        else if (kind == 5) { if (MK_EN & 1024) REPS(1024) phase_ln(XRES, XB, (f32x2*)(ws + WS_STATS), pp->ln_g + L * 1024, pp->ln_b + L * 1024, wv, rep_ + 1 < nrep_, L == 3); }
        else if (kind == 6) { pg8::Gemm g{XB, (const bf16_t*)(ws + W_MIN + j * W_MIN_SZ), T, MLA_NPAD, 1024}; pg8::StaticOrder S; S.init(T, MLA_NPAD, G, c);
            pg8::EpiMlaIn E{(bf16_t*)(ws + WS_MZ), (bf16_t*)(ws + WS_CKV), (bf16_t*)(ws + WS_CQ), (bf16_t*)(ws + WS_KRO), (float*)(ws + WS_RQ + (size_t)j * 524288), (float*)(ws + WS_RQ + (size_t)j * 524288 + 262144), (const float*)(ws + WS_COS), (const float*)(ws + WS_SIN)}; if (MK_EN & 32) REPS(32) pg8::gemm_phase(lds3, g, S, E, wv); }
        else if (kind == 7) { if (MK_EN & 64) REPS(64) phase_mla_stats((const bf16_t*)(ws + WS_CQ), (const bf16_t*)(ws + WS_CKV), (const float*)(ws + WS_KRR), (bf16_t*)(ws + WS_KRO), (float*)(ws + WS_RQ), (float*)(ws + WS_RKV),
                                                              (const float*)(ws + WS_COS), (const float*)(ws + WS_SIN), wv); }
        else if (kind == 8) {
            { pg8::Gemm g{(const bf16_t*)(ws + WS_CQ) + (size_t)half * TH * 384, (const bf16_t*)(ws + W_MUQ + j * W_MUQ_SZ), TH, 3072, 384}; pg8::StaticOrder S; S.init(TH, 3072, G, c);
              pg8::EpiQup E{(bf16_t*)(ws + WS_QH), (const float*)(ws + WS_RQ + (size_t)j * 524288), (const float*)(ws + WS_COS), (const float*)(ws + WS_SIN), half * TH}; if (MK_EN & 128) REPS(128) pg8::gemm_phase(lds3, g, S, E, wv); }
            { pg8::Gemm g{(const bf16_t*)(ws + WS_CKV) + (size_t)half * TH * 256, (const bf16_t*)(ws + W_MUKV + j * W_MUKV_SZ), TH, 4096, 256}; pg8::StaticOrder S; S.init(TH, 4096, G, c);
              pg8::EpiKVup E{(bf16_t*)(ws + WS_KNH), (bf16_t*)(ws + WS_VH), (const float*)(ws + WS_RQ + (size_t)j * 524288 + 262144), half * TH}; if (MK_EN & 256) REPS(256) pg8::gemm_phase(lds3, g, S, E, wv); }
        }
        else { if (MK_EN & 512) REPS(512) att::phase_attn((const bf16_t*)(ws + WS_QH), (const bf16_t*)(ws + WS_KNH), (const bf16_t*)(ws + WS_VH), (const bf16_t*)(ws + WS_KRO), (bf16_t*)(ws + WS_MZ), half, (char*)lds, wv, rep_ + 1 < nrep_); }
        if (ph2 + 1 < ph_hi * nrounds) REPS(2048) xcd_barrier((unsigned*)(ws + WS_BAR), xb_xcc_id(), (volatile LAS unsigned*)(lds3 + LDS_ST_OFF), wv);
    }
}

#ifndef MK_MULTI
#define MK_MULTI 0
#endif
extern "C" void kernel_launch(void* const* d_in, const int* in_sizes, int n_in, void* d_out, int out_size, void* d_ws, size_t ws_size, hipStream_t stream) {
    static int grid = 0;
    if (grid == 0) {
        if (n_in != 15 || out_size != T * DM || ws_size < WS_END) { fprintf(stderr, "kernel_launch: unexpected shapes n_in %d out %d ws %zu (need %zu)\n", n_in, out_size, ws_size, (size_t)WS_END); grid = -1; return; }
        if (hipFuncSetAttribute((const void*)mk_fwd, hipFuncAttributeMaxDynamicSharedMemorySize, LDS_BYTES) != hipSuccess) { fprintf(stderr, "kernel_launch: hipFuncSetAttribute failed\n"); grid = -1; return; }
        int dev = 0, cus = 0, per_cu = 0;
        hipGetDevice(&dev); hipDeviceGetAttribute(&cus, hipDeviceAttributeMultiprocessorCount, dev);
        hipOccupancyMaxActiveBlocksPerMultiprocessor(&per_cu, (const void*)mk_fwd, 512, LDS_BYTES);
        if (per_cu < 1) { fprintf(stderr, "kernel_launch: occupancy query says %d blocks per CU\n", per_cu); }
        (void)hipGetLastError();
        grid = cus > 0 ? cus : 256;
    }
    if (grid < 0) return;
    Params p{};
    p.x = (const float*)d_in[0]; p.pos = (const int*)d_in[1]; p.ln_g = (const float*)d_in[2]; p.ln_b = (const float*)d_in[3];
    p.gla_w_in = (const float*)d_in[4]; p.gla_w_gate = (const float*)d_in[5]; p.gla_b_gate = (const float*)d_in[6]; p.gla_gn_g = (const float*)d_in[7]; p.gla_w_out = (const float*)d_in[8];
    p.mla_w_in = (const float*)d_in[9]; p.mla_qn_g = (const float*)d_in[10]; p.mla_kvn_g = (const float*)d_in[11]; p.mla_w_uq = (const float*)d_in[12]; p.mla_w_ukv = (const float*)d_in[13]; p.mla_w_out = (const float*)d_in[14];
    p.out = (float*)d_out; p.ws = (unsigned char*)d_ws;
    if (hipMemsetAsync((char*)d_ws + WS_XCH, 0, 4 * MiB, stream) != hipSuccess) { fprintf(stderr, "kernel_launch: memset failed\n"); return; }
    if (hipMemsetAsync((char*)d_ws + WS_BAR, 0, XCD_BAR_WORDS * 4, stream) != hipSuccess) { fprintf(stderr, "kernel_launch: memset failed\n"); return; }
#if MK_MULTI
    for (int ph = 0; ph < NPHASE; ++ph) {
        p.ph_lo = ph; p.ph_hi = ph + 1;
        hipLaunchKernelGGL(mk_fwd, dim3(grid), dim3(512), LDS_BYTES, stream, p);
    }
#else
    p.ph_lo = 0; p.ph_hi = NPHASE;
    void* args[] = {&p};
    hipError_t e = hipLaunchCooperativeKernel((const void*)mk_fwd, dim3(grid), dim3(512), args, LDS_BYTES, stream);
    if (e != hipSuccess) fprintf(stderr, "cooperative launch failed: %s (grid %d)\n", hipGetErrorString(e), grid);
#endif
    const hipError_t le = hipPeekAtLastError();
    if (le != hipSuccess) fprintf(stderr, "kernel_launch: launch failed: %s\n", hipGetErrorName(le));
}
```

```cpp
#include <hip/hip_runtime.h>
#include <hip/hip_cooperative_groups.h>
#include <cstdio>
#include <cstdint>
namespace cg = cooperative_groups;

#define LAS __attribute__((address_space(3)))
typedef unsigned short bf16_t;
typedef short bf16x8 __attribute__((ext_vector_type(8)));
typedef short s16x4 __attribute__((ext_vector_type(4)));
typedef float f32x4 __attribute__((ext_vector_type(4)));
typedef float f32x2 __attribute__((ext_vector_type(2)));
typedef float f32x16 __attribute__((ext_vector_type(16)));
typedef unsigned u32x4 __attribute__((ext_vector_type(4)));
typedef unsigned u32x2 __attribute__((ext_vector_type(2)));

constexpr int T = 65536, DM = 1024, SEQ = 2048, NBATCH = 32;
constexpr int TH = T / 2;
constexpr float ALPHA = 1.6817928305074290f;
constexpr float EPS = 1e-5f;
constexpr int GLA_NPAD = 5376, MLA_NPAD = 2816;
constexpr int LDS_BYTES = 143360;

constexpr size_t MiB = 1048576;
constexpr size_t W_GIN = 0, W_GIN_SZ = (size_t)GLA_NPAD * 1024 * 2;
constexpr size_t W_GOUT = W_GIN + 2 * W_GIN_SZ, W_OUT_SZ = (size_t)1024 * 2048 * 2;
constexpr size_t W_MIN = W_GOUT + 2 * W_OUT_SZ, W_MIN_SZ = (size_t)MLA_NPAD * 1024 * 2;
constexpr size_t W_MUQ = W_MIN + 2 * W_MIN_SZ, W_MUQ_SZ = (size_t)3072 * 384 * 2;
constexpr size_t W_MUKV = W_MUQ + 2 * W_MUQ_SZ, W_MUKV_SZ = (size_t)4096 * 256 * 2;
constexpr size_t W_MOUT = W_MUKV + 2 * W_MUKV_SZ;
static_assert(W_MOUT + 2 * W_OUT_SZ <= 64 * MiB, "weights region");
constexpr size_t WS_XB = 64 * MiB;
constexpr size_t WS_OFW = 64 * MiB, WS_GQK = 320 * MiB, WS_GV = 448 * MiB, WS_GZ = 704 * MiB, WS_GLR = 960 * MiB;
constexpr size_t WS_MZ = 192 * MiB, WS_QH = 448 * MiB, WS_KNH = 640 * MiB, WS_VH = 768 * MiB, WS_CQ = 896 * MiB, WS_CKV = 944 * MiB,
                 WS_KRR = 976 * MiB, WS_KRO = 992 * MiB, WS_RQ = 1000 * MiB, WS_RKV = 1000 * MiB + 262144;
constexpr size_t WS_COS = 1001 * MiB, WS_SIN = 1009 * MiB, WS_BAR = 1017 * MiB, WS_STATS = 1017 * MiB + 65536, WS_XCH = 1018 * MiB, WS_END = 1022 * MiB;
constexpr int LDS_ST_OFF = 143344;

struct Params {
    const float* x; const int* pos; const float* ln_g; const float* ln_b;
    const float* gla_w_in; const float* gla_w_gate; const float* gla_b_gate; const float* gla_gn_g; const float* gla_w_out;
    const float* mla_w_in; const float* mla_qn_g; const float* mla_kvn_g; const float* mla_w_uq; const float* mla_w_ukv; const float* mla_w_out;
    float* out; unsigned char* ws;
    int ph_lo, ph_hi;
};

__device__ __forceinline__ unsigned cvt_pk_bf16(float lo, float hi) { unsigned r; asm volatile("v_cvt_pk_bf16_f32 %0, %1, %2" : "=v"(r) : "v"(lo), "v"(hi)); return r; }
__device__ __forceinline__ float bf2f(unsigned short b) { return __uint_as_float(((unsigned)b) << 16); }
__device__ __forceinline__ float bflo(unsigned w) { return __uint_as_float(w << 16); }
__device__ __forceinline__ float bfhi(unsigned w) { return __uint_as_float(w & 0xffff0000u); }
__device__ __forceinline__ float silu_f(float z) { return z / (1.f + __expf(-z)); }
__device__ __forceinline__ float silu_fast(float z) { return z * __builtin_amdgcn_rcpf(1.f + __expf(-z)); }
__device__ __forceinline__ float wave_sum(float v) {
#pragma unroll
    for (int o = 32; o > 0; o >>= 1) v += __shfl_xor(v, o, 64);
    return v;
}

__device__ __forceinline__ int opaque_lane() { int l = __builtin_amdgcn_mbcnt_hi(~0u, __builtin_amdgcn_mbcnt_lo(~0u, 0u)); asm volatile("" : "+v"(l)); return l; }
__device__ __forceinline__ int opaque_tid(int wv) { return wv * 64 + opaque_lane(); }
namespace pg8 {
constexpr int BM = 256, BK = 64, HALF = 128, HTB = HALF * BK * 2, STAGE_BYTES = 8 * HTB, NXCD = 8, WGM = 8;
__host__ __device__ __forceinline__ int lds_byte(int r, int c) { const int st = (r >> 4) * 2 + (c >> 5), rr = r & 15, cc = c & 31, ob = rr * 64 + cc * 2; return st * 1024 + (ob ^ (((ob >> 9) & 1) << 5)); }
__host__ __device__ __forceinline__ void stage_rc(int b, int& R, int& C) { const int st = b / 1024, sb = b % 1024, swz = sb ^ (((sb >> 9) & 1) << 5); R = (st >> 1) * 16 + swz / 64; C = (st & 1) * 32 + (swz % 64) / 2; }
__host__ __device__ __forceinline__ int perm32(int rho) { const int n = rho >> 4, i = rho & 15; return 8 * (i >> 2) + 4 * n + (i & 3); }
struct Unit { int pm, pn; };
struct Gemm { const bf16_t* A; const bf16_t* Bt; int M, N, K; };
struct StaticOrder {
    int nM, nN, nwg, G, c;
    __device__ void init(int M, int N, int G_, int c_) { nM = M / BM; nN = N / BM; nwg = nM * nN; G = G_; c = c_; }
    __device__ bool next(int i, Unit& u) const {
        const long L = (long)i * G + c; if (L >= nwg) return false;
        int wgid = (int)L; { const int q = nwg / NXCD, r = nwg % NXCD, xcd = wgid % NXCD, off = wgid / NXCD; wgid = (xcd < r ? xcd * (q + 1) : r * (q + 1) + (xcd - r) * q) + off; }
        const int nig = WGM * nN, gid = wgid / nig, fm = gid * WGM, gsz = (nM - fm) < WGM ? (nM - fm) : WGM;
        u.pm = fm + ((wgid % nig) % gsz); u.pn = (wgid % nig) / gsz; return true;
    }
};

template <class Epi>
__device__ __forceinline__ void gemm_phase(LAS unsigned char* lds, const Gemm g, const StaticOrder& S, const Epi& E, int wv) {
    const int tid = opaque_tid(wv), wid = wv, lane = tid & 63, wr = wid >> 2, wc = wid & 3, fr = lane & 15, fq = lane >> 4;
    const int K = g.K, nt = K / BK;
    unsigned voffA[2], voffB[2];
#pragma unroll
    for (int i = 0; i < 2; ++i) { int R, C; stage_rc(tid * 16 + i * 8192, R, C); const int Rb = Epi::PERM ? ((R & ~31) + perm32(R & 31)) : R;
        voffA[i] = (unsigned)(R * K + C) * 2u; voffB[i] = (unsigned)(Rb * K + C) * 2u; }
    const size_t kstep = (size_t)(BK * 2);
    const size_t hstep = (size_t)HALF * K * 2;
    const size_t tstep = 2 * hstep;
    const unsigned ldsw = (unsigned)wid * 1024u;
    const int aoff = lds_byte(wr * 64 + fr, fq * 8), boff = lds_byte(wc * 32 + fr, fq * 8);
#define PG8_SA(b, h) (((b) * 2 + (h)) * HTB)
#define PG8_SB(b, h) ((4 + (b) * 2 + (h)) * HTB)
#define PG8_STAGE(bufoff, gbase, voff) do { _Pragma("unroll") for (int _i = 0; _i < 2; ++_i) \
        __builtin_amdgcn_global_load_lds((const unsigned*)((const char*)(gbase) + (voff)[_i]), (LAS unsigned*)(lds + (bufoff) + ldsw + _i * 8192), 16, 0, 0); } while (0)
#define PG8_LDA(dst, b, h) do { _Pragma("unroll") for (int m = 0; m < 4; ++m) _Pragma("unroll") for (int k = 0; k < 2; ++k) dst[m][k] = *(const LAS bf16x8*)(lds + PG8_SA(b, h) + aoff + m * 2048 + k * 1024); } while (0)
#define PG8_LDB(dst, b, h) do { _Pragma("unroll") for (int n = 0; n < 2; ++n) _Pragma("unroll") for (int k = 0; k < 2; ++k) dst[n][k] = *(const LAS bf16x8*)(lds + PG8_SB(b, h) + boff + n * 2048 + k * 1024); } while (0)
#define PG8_MMA(ai, bj, At, Bt) do { __builtin_amdgcn_s_setprio(1); _Pragma("unroll") for (int m = 0; m < 4; ++m) _Pragma("unroll") for (int n = 0; n < 2; ++n) _Pragma("unroll") for (int k = 0; k < 2; ++k) \
        acc[ai][bj][m][n] = __builtin_amdgcn_mfma_f32_16x16x32_bf16(Bt[n][k], At[m][k], acc[ai][bj][m][n], 0, 0, 0); __builtin_amdgcn_s_setprio(0); } while (0)
#define PG8_WAIT_V(n) asm volatile("s_waitcnt vmcnt(" #n ")" ::: "memory")
#define PG8_WAIT_L(n) asm volatile("s_waitcnt lgkmcnt(" #n ")" ::: "memory")
#define PG8_BAR __builtin_amdgcn_s_barrier()
#define PG8_SCHED __builtin_amdgcn_sched_barrier(0)
    Unit cur, nxt; int ui = 0;
    if (!S.next(0, cur)) return;
    f32x4 acc[2][2][4][2];
#pragma unroll
    for (int a = 0; a < 2; ++a)
#pragma unroll
        for (int b = 0; b < 2; ++b)
#pragma unroll
            for (int m = 0; m < 4; ++m)
#pragma unroll
                for (int n = 0; n < 2; ++n) acc[a][b][m][n] = (f32x4){0.f, 0.f, 0.f, 0.f};
    bf16x8 At[4][2], B0[2][2], B1[2][2];
    const char* cA = (const char*)g.A + (size_t)cur.pm * tstep; const char* cB = (const char*)g.Bt + (size_t)cur.pn * tstep;
    PG8_STAGE(PG8_SB(0, 0), cB, voffB); PG8_STAGE(PG8_SA(0, 0), cA, voffA); PG8_STAGE(PG8_SB(0, 1), cB + hstep, voffB); PG8_STAGE(PG8_SA(0, 1), cA + hstep, voffA);
    if (wr == 1) PG8_BAR;
    PG8_WAIT_V(4); PG8_BAR;
    PG8_STAGE(PG8_SB(1, 0), cB + kstep, voffB); PG8_STAGE(PG8_SA(1, 0), cA + kstep, voffA); PG8_STAGE(PG8_SB(1, 1), cB + hstep + kstep, voffB);
    PG8_WAIT_V(6); PG8_BAR;
    for (;;) {
        const bool has_next = S.next(ui + 1, nxt);
        const char* nA = has_next ? (const char*)g.A + (size_t)nxt.pm * tstep : cA; const char* nB = has_next ? (const char*)g.Bt + (size_t)nxt.pn * tstep : cB;
        for (int t = 0; t < nt; t += 2) {
            const bool last = (t == nt - 2);
            const char* a1 = cA + (size_t)(t + 1) * kstep;
            const char* a2 = last ? nA : cA + (size_t)(t + 2) * kstep; const char* b2 = last ? nB : cB + (size_t)(t + 2) * kstep;
            const char* a3 = a2 + kstep; const char* b3 = b2 + kstep;
            PG8_LDB(B0, 0, 0); PG8_SCHED; PG8_LDA(At, 0, 0); PG8_STAGE(PG8_SA(1, 1), a1 + hstep, voffA);
            PG8_WAIT_L(8); PG8_BAR; PG8_WAIT_L(0); PG8_MMA(0, 0, At, B0); PG8_BAR; PG8_SCHED;
            PG8_LDB(B1, 0, 1); PG8_STAGE(PG8_SB(0, 0), b2, voffB);
            PG8_BAR; PG8_WAIT_L(0); PG8_MMA(0, 1, At, B1); PG8_BAR;
            PG8_LDA(At, 0, 1); PG8_STAGE(PG8_SA(0, 0), a2, voffA);
            PG8_BAR; PG8_WAIT_L(0); PG8_MMA(1, 0, At, B0); PG8_BAR; PG8_SCHED;
            PG8_STAGE(PG8_SB(0, 1), b2 + hstep, voffB);
            PG8_WAIT_V(6); PG8_BAR; PG8_MMA(1, 1, At, B1); PG8_BAR;
            PG8_LDB(B0, 1, 0); PG8_SCHED; PG8_LDA(At, 1, 0); PG8_STAGE(PG8_SA(0, 1), a2 + hstep, voffA);
            PG8_WAIT_L(8); PG8_BAR; PG8_WAIT_L(0); PG8_MMA(0, 0, At, B0); PG8_BAR; PG8_SCHED;
            PG8_LDB(B1, 1, 1); PG8_STAGE(PG8_SB(1, 0), b3, voffB);
            PG8_BAR; PG8_WAIT_L(0); PG8_MMA(0, 1, At, B1); PG8_BAR;
            PG8_LDA(At, 1, 1); PG8_STAGE(PG8_SA(1, 0), a3, voffA);
            PG8_BAR; PG8_WAIT_L(0); PG8_MMA(1, 0, At, B0); PG8_BAR; PG8_SCHED;
            PG8_STAGE(PG8_SB(1, 1), b3 + hstep, voffB);
            PG8_WAIT_V(6); PG8_BAR; PG8_MMA(1, 1, At, B1); PG8_BAR;
        }
        E(acc, cur, wv);
        if (!has_next) break;
#pragma unroll
        for (int a = 0; a < 2; ++a)
#pragma unroll
            for (int b = 0; b < 2; ++b)
#pragma unroll
                for (int m = 0; m < 4; ++m)
#pragma unroll
                    for (int n = 0; n < 2; ++n) acc[a][b][m][n] = (f32x4){0.f, 0.f, 0.f, 0.f};
        cur = nxt; cA = nA; cB = nB; ++ui;
    }
    PG8_WAIT_V(0);
    if (wr == 0) PG8_BAR;
    PG8_BAR;
#undef PG8_SA
#undef PG8_SB
#undef PG8_STAGE
#undef PG8_LDA
#undef PG8_LDB
#undef PG8_MMA
#undef PG8_WAIT_V
#undef PG8_WAIT_L
#undef PG8_BAR
#undef PG8_SCHED
}

typedef f32x4 Acc[2][2][4][2];
__device__ __forceinline__ void store8_bf16(bf16_t* p, f32x4 v0, f32x4 v1, float s) {
    u32x4 w = {cvt_pk_bf16(v0[0] * s, v0[1] * s), cvt_pk_bf16(v0[2] * s, v0[3] * s), cvt_pk_bf16(v1[0] * s, v1[1] * s), cvt_pk_bf16(v1[2] * s, v1[3] * s)};
    *(u32x4*)p = w;
}
__device__ __forceinline__ void tile_store_bf16(const Acc& acc, bf16_t* base, int ld, int pm, int wr, int wc, int fr, int fq, float s) {
    const int row0 = pm * BM + wr * 64 + fr, col0 = wc * 32 + 8 * fq;
#pragma unroll
    for (int ai = 0; ai < 2; ++ai)
#pragma unroll
        for (int m = 0; m < 4; ++m) { bf16_t* rowp = base + (size_t)(row0 + ai * HALF + m * 16) * ld + col0;
#pragma unroll
            for (int bj = 0; bj < 2; ++bj) store8_bf16(rowp + bj * HALF, acc[ai][bj][m][0], acc[ai][bj][m][1], s); }
}
struct EpiGlaIn {
    static constexpr bool PERM = true;
    bf16_t* QK; bf16_t* V; bf16_t* Z; float* GLR;
    __device__ __forceinline__ void operator()(const Acc& acc, const Unit& u, int wv) const {
        const int wr = wv >> 2, wc = wv & 3, ln_ = opaque_lane(), fr = ln_ & 15, fq = ln_ >> 4;
        const int pn = u.pn;
        if (pn < 4) tile_store_bf16(acc, QK + pn * 256, 1024, u.pm, wr, wc, fr, fq, pn < 2 ? 0.08838834764831845f : 1.f);
        else if (pn < 12) tile_store_bf16(acc, V + (pn - 4) * 256, 2048, u.pm, wr, wc, fr, fq, 1.f);
        else if (pn < 20) tile_store_bf16(acc, Z + (pn - 12) * 256, 2048, u.pm, wr, wc, fr, fq, 1.f);
        else if (wc == 0) {
            const int row0 = u.pm * BM + wr * 64 + fr;
#pragma unroll
            for (int ai = 0; ai < 2; ++ai)
#pragma unroll
                for (int m = 0; m < 4; ++m) { float* rowp = GLR + (size_t)(row0 + ai * HALF + m * 16) * 32 + 8 * fq;
                    *(f32x4*)rowp = acc[ai][0][m][0]; *(f32x4*)(rowp + 4) = acc[ai][0][m][1]; }
        }
    }
};
__device__ __forceinline__ float sumsq8(f32x4 a, f32x4 b) { return a[0] * a[0] + a[1] * a[1] + a[2] * a[2] + a[3] * a[3] + b[0] * b[0] + b[1] * b[1] + b[2] * b[2] + b[3] * b[3]; }
struct EpiMlaIn {
    static constexpr bool PERM = true;
    bf16_t* Z; bf16_t* CKV; bf16_t* CQ; bf16_t* KRO; float* SSQ_Q; float* SSQ_KV; const float* COS; const float* SIN;
    __device__ __forceinline__ void operator()(const Acc& acc, const Unit& u, int wv) const {
        const int wr = wv >> 2, wc = wv & 3, ln_ = opaque_lane(), fr = ln_ & 15, fq = ln_ >> 4;
        const int pn = u.pn;
        if (pn < 8) { tile_store_bf16(acc, Z + pn * 256, 2048, u.pm, wr, wc, fr, fq, 1.f); return; }
        const int row0 = u.pm * BM + wr * 64 + fr, col0 = wc * 32 + 8 * fq;
#pragma unroll
        for (int ai = 0; ai < 2; ++ai)
#pragma unroll
            for (int m = 0; m < 4; ++m) { const size_t row = (size_t)(row0 + ai * HALF + m * 16);
                float ss;
                if (pn == 8) { bf16_t* rp = CKV + row * 256 + col0; store8_bf16(rp, acc[ai][0][m][0], acc[ai][0][m][1], 1.f); store8_bf16(rp + HALF, acc[ai][1][m][0], acc[ai][1][m][1], 1.f);
                    ss = sumsq8(acc[ai][0][m][0], acc[ai][0][m][1]) + sumsq8(acc[ai][1][m][0], acc[ai][1][m][1]); }
                else if (pn == 9) { bf16_t* rp = CQ + row * 384 + col0; store8_bf16(rp, acc[ai][0][m][0], acc[ai][0][m][1], 1.f); store8_bf16(rp + HALF, acc[ai][1][m][0], acc[ai][1][m][1], 1.f);
                    ss = sumsq8(acc[ai][0][m][0], acc[ai][0][m][1]) + sumsq8(acc[ai][1][m][0], acc[ai][1][m][1]); }
                else { store8_bf16(CQ + row * 384 + 256 + col0, acc[ai][0][m][0], acc[ai][0][m][1], 1.f);
                    ss = sumsq8(acc[ai][0][m][0], acc[ai][0][m][1]);
                    if (wc < 2) { const int i0 = col0 >> 1; const f32x4 cs = *(const f32x4*)(COS + row * 32 + i0), sn = *(const f32x4*)(SIN + row * 32 + i0);
                        const f32x4 v0 = acc[ai][1][m][0], v1 = acc[ai][1][m][1]; f32x4 w0, w1;
                        w0[0] = v0[0] * cs[0] - v0[1] * sn[0]; w0[1] = v0[1] * cs[0] + v0[0] * sn[0];
                        w0[2] = v0[2] * cs[1] - v0[3] * sn[1]; w0[3] = v0[3] * cs[1] + v0[2] * sn[1];
                        w1[0] = v1[0] * cs[2] - v1[1] * sn[2]; w1[1] = v1[1] * cs[2] + v1[0] * sn[2];
                        w1[2] = v1[2] * cs[3] - v1[3] * sn[3]; w1[3] = v1[3] * cs[3] + v1[2] * sn[3];
                        store8_bf16(KRO + row * 64 + col0, w0, w1, 1.f); } }
                ss += __shfl_xor(ss, 16, 64); ss += __shfl_xor(ss, 32, 64);
                if (fq == 0) atomicAdd((pn == 8 ? SSQ_KV : SSQ_Q) + row, ss);
                __builtin_amdgcn_sched_barrier(0); }
    }
};
struct EpiQup {
    static constexpr bool PERM = true;
    bf16_t* Q; const float* RQ; const float* COS; const float* SIN; int tok0;
    __device__ __forceinline__ void operator()(Acc& acc, const Unit& u, int wv) const {
        const int wr = wv >> 2, wc = wv & 3, ln_ = opaque_lane(), fr = ln_ & 15, fq = ln_ >> 4;
        const int row0 = u.pm * BM + wr * 64 + fr;
        float sc[8];
#pragma unroll
        for (int i = 0; i < 8; ++i) sc[i] = RQ[(size_t)tok0 + row0 + (i >> 2) * HALF + (i & 3) * 16];
#pragma unroll
        for (int i = 0; i < 8; ++i) sc[i] = rsqrtf(sc[i] * (1.f / 384.f) + EPS);
#pragma unroll
        for (int bj = 0; bj < 2; ++bj) {
            const int c = u.pn * 256 + bj * 128 + wc * 32 + 8 * fq, o = c % 192; const bool rope = o >= 128; const int i0 = (o - 128) >> 1;
            if (!rope) {
#pragma unroll
                for (int i = 0; i < 8; ++i) { const int row = row0 + (i >> 2) * HALF + (i & 3) * 16; store8_bf16(Q + (size_t)row * 3072 + c, acc[i >> 2][bj][i & 3][0], acc[i >> 2][bj][i & 3][1], sc[i]); }
            } else {
#pragma unroll
                for (int ai = 0; ai < 2; ++ai) {
                    f32x4 cs[4], sn[4];
#pragma unroll
                    for (int m = 0; m < 4; ++m) { const size_t tok = (size_t)tok0 + row0 + ai * HALF + m * 16; cs[m] = *(const f32x4*)(COS + tok * 32 + i0); sn[m] = *(const f32x4*)(SIN + tok * 32 + i0); }
#pragma unroll
                    for (int m = 0; m < 4; ++m) { const int row = row0 + ai * HALF + m * 16; const float s = sc[ai * 4 + m];
                        const f32x4 v0 = acc[ai][bj][m][0] * s, v1 = acc[ai][bj][m][1] * s; f32x4 w0, w1;
                        w0[0] = v0[0] * cs[m][0] - v0[1] * sn[m][0]; w0[1] = v0[1] * cs[m][0] + v0[0] * sn[m][0];
                        w0[2] = v0[2] * cs[m][1] - v0[3] * sn[m][1]; w0[3] = v0[3] * cs[m][1] + v0[2] * sn[m][1];
                        w1[0] = v1[0] * cs[m][2] - v1[1] * sn[m][2]; w1[1] = v1[1] * cs[m][2] + v1[0] * sn[m][2];
                        w1[2] = v1[2] * cs[m][3] - v1[3] * sn[m][3]; w1[3] = v1[3] * cs[m][3] + v1[2] * sn[m][3];
                        store8_bf16(Q + (size_t)row * 3072 + c, w0, w1, 1.f); }
                    __builtin_amdgcn_sched_barrier(0);
                }
            }
        }
    }
};
struct EpiKVup {
    static constexpr bool PERM = true;
    bf16_t* KN; bf16_t* V; const float* RKV; int tok0;
    __device__ __forceinline__ void operator()(Acc& acc, const Unit& u, int wv) const {
        const int wr = wv >> 2, wc = wv & 3, ln_ = opaque_lane(), fr = ln_ & 15, fq = ln_ >> 4;
        bf16_t* base = u.pn < 8 ? KN + u.pn * 256 : V + (u.pn - 8) * 256;
        const int row0 = u.pm * BM + wr * 64 + fr, col0 = wc * 32 + 8 * fq;
        float sc[8];
#pragma unroll
        for (int i = 0; i < 8; ++i) sc[i] = RKV[(size_t)tok0 + row0 + (i >> 2) * HALF + (i & 3) * 16];
#pragma unroll
        for (int i = 0; i < 8; ++i) sc[i] = rsqrtf(sc[i] * (1.f / 256.f) + EPS);
#pragma unroll
        for (int i = 0; i < 8; ++i) { const int row = row0 + (i >> 2) * HALF + (i & 3) * 16; bf16_t* rowp = base + (size_t)row * 2048 + col0;
#pragma unroll
            for (int bj = 0; bj < 2; ++bj) store8_bf16(rowp + bj * HALF, acc[i >> 2][bj][i & 3][0], acc[i >> 2][bj][i & 3][1], sc[i]); }
    }
};
struct EpiRes {
    static constexpr bool PERM = false;
    float* XRES; const float* XIN; const f32x2* ST; const float* G; const float* B; bool nowrite;
    __device__ __forceinline__ void operator()(const Acc& acc, const Unit& u, int wv) const {
        const int wr = wv >> 2, wc = wv & 3, ln_ = opaque_lane(), fr = ln_ & 15, fq = ln_ >> 4;
        const int row0 = u.pm * BM + wr * 64 + fr, col0 = u.pn * BM + wc * 32 + 4 * fq;
#pragma unroll
        for (int pr = 0; pr < 4; ++pr) {
            f32x4 xi[2][4]; f32x2 st[2];
#pragma unroll
            for (int q = 0; q < 2; ++q) { const int i = pr * 2 + q, row = row0 + (i >> 2) * HALF + (i & 3) * 16; const size_t ro = (size_t)row * 1024 + col0;
                st[q] = (f32x2){0.f, 1.f}; if (ST) st[q] = ST[row];
#pragma unroll
                for (int c4 = 0; c4 < 4; ++c4) xi[q][c4] = *(const f32x4*)(XIN + ro + (c4 >> 1) * HALF + (c4 & 1) * 16); }
#pragma unroll
            for (int q = 0; q < 2; ++q) { const int i = pr * 2 + q, row = row0 + (i >> 2) * HALF + (i & 3) * 16; const size_t ro = (size_t)row * 1024 + col0;
#pragma unroll
                for (int c4 = 0; c4 < 4; ++c4) { const int co = (c4 >> 1) * HALF + (c4 & 1) * 16; f32x4 x = xi[q][c4];
                    if (ST) { const f32x4 g = *(const f32x4*)(G + col0 + co), b = *(const f32x4*)(B + col0 + co); x = (x - st[q][0]) * st[q][1] * g + b; }
                    if (!nowrite) *(f32x4*)(XRES + ro + co) = acc[i >> 2][c4 >> 1][i & 3][c4 & 1] + x * ALPHA; } }
            __builtin_amdgcn_sched_barrier(0);
        }
    }
};
}

enum { MAP_ID = 0, MAP_MLAIN = 1, MAP_UQ = 2, MAP_UKV = 3 };
__device__ __forceinline__ int map_col(int mode, int nd, int nsrc) {
    if (mode == MAP_ID) return nd < nsrc ? nd : -1;
    if (mode == MAP_MLAIN) { if (nd < 2048) return 704 + nd; if (nd < 2304) return 384 + (nd - 2048); if (nd < 2688) return nd - 2304; if (nd < 2752) { const int p_ = nd - 2688; return 640 + (p_ >> 1) + ((p_ & 1) ? 32 : 0); } return -1; }
    if (mode == MAP_UQ) { const int h = nd / 192, o = nd % 192; if (o < 128) return h * 192 + o; const int p = o - 128, i = p >> 1; return (p & 1) ? h * 192 + 160 + i : h * 192 + 128 + i; }
    { if (nd < 2048) return (nd >> 7) * 256 + (nd & 127); const int n2 = nd - 2048; return (n2 >> 7) * 256 + 128 + (n2 & 127); }
}
__device__ __forceinline__ void transpose_job(const float* src, bf16_t* dst, int K, int nsrc, int ndst, int mode, const float* rs, float* tile  , int wv) {
    const int tid = opaque_tid(wv), tk = K / 64, tn = ndst / 64, ntiles = tk * tn;
    for (int t = blockIdx.x; t < ntiles; t += gridDim.x) {
        const int k0 = (t % tk) * 64, n0 = (t / tk) * 64;
        const int nn = tid & 63, sc = map_col(mode, n0 + nn, nsrc);
        __syncthreads();
#pragma unroll
        for (int i = 0; i < 8; ++i) { const int kk = (tid >> 6) + 8 * i; float v = 0.f; if (sc >= 0) { v = src[(size_t)(k0 + kk) * nsrc + sc]; if (rs) v *= rs[k0 + kk]; } tile[kk * 65 + nn] = v; }
        __syncthreads();
        const int on = tid >> 3, ok = (tid & 7) * 8;
        float v[8];
#pragma unroll
        for (int i = 0; i < 8; ++i) v[i] = tile[(ok + i) * 65 + on];
        u32x4 w = {cvt_pk_bf16(v[0], v[1]), cvt_pk_bf16(v[2], v[3]), cvt_pk_bf16(v[4], v[5]), cvt_pk_bf16(v[6], v[7])};
        *(u32x4*)(dst + (size_t)(n0 + on) * K + k0 + ok) = w;
    }
}
__device__ __forceinline__ void phase_prep(const __attribute__((address_space(4))) Params* pp, unsigned char* lds, int wv) {
    float* tile = (float*)lds;
    struct { const float* x; const int* pos; const float* gla_w_in; const float* gla_w_out; const float* mla_w_in; const float* mla_qn_g; const float* mla_kvn_g; const float* mla_w_uq; const float* mla_w_ukv; const float* mla_w_out; unsigned char* ws; } p;
    p.x = pp->x; p.pos = pp->pos; p.gla_w_in = pp->gla_w_in; p.gla_w_out = pp->gla_w_out; p.mla_w_in = pp->mla_w_in; p.mla_qn_g = pp->mla_qn_g; p.mla_kvn_g = pp->mla_kvn_g; p.mla_w_uq = pp->mla_w_uq; p.mla_w_ukv = pp->mla_w_ukv; p.mla_w_out = pp->mla_w_out; p.ws = pp->ws;
    unsigned char* ws = p.ws;
    const size_t gtid = (size_t)blockIdx.x * 512 + opaque_tid(wv), gsz = (size_t)gridDim.x * 512;
    for (size_t i = gtid; i < (size_t)T * DM / 8; i += gsz) {
        const f32x4 a = *(const f32x4*)(p.x + i * 8), b = *(const f32x4*)(p.x + i * 8 + 4);
        u32x4 w = {cvt_pk_bf16(a[0], a[1]), cvt_pk_bf16(a[2], a[3]), cvt_pk_bf16(b[0], b[1]), cvt_pk_bf16(b[2], b[3])};
        *(u32x4*)(ws + WS_XB + i * 16) = w;
    }
    for (size_t i = gtid; i < (size_t)(MiB / 16); i += gsz) *(u32x4*)(ws + WS_RQ + i * 16) = (u32x4){0u, 0u, 0u, 0u};
    for (size_t i = gtid; i < (size_t)T * 32; i += gsz) {
        const int tok = (int)(i >> 5), f = (int)(i & 31);
        const float inv = exp2f(-(float)(2 * f) * (13.287712379549449f / 64.0f));
        const float ang = (float)p.pos[tok] * inv;
        ((float*)(ws + WS_COS))[i] = cosf(ang); ((float*)(ws + WS_SIN))[i] = sinf(ang);
    }
    for (int j = 0; j < 2; ++j) {
        transpose_job(p.gla_w_in + (size_t)j * 1024 * 5152, (bf16_t*)(ws + W_GIN + j * W_GIN_SZ), 1024, 5152, GLA_NPAD, MAP_ID, nullptr, tile, wv);
        transpose_job(p.gla_w_out + (size_t)j * 2048 * 1024, (bf16_t*)(ws + W_GOUT + j * W_OUT_SZ), 2048, 1024, 1024, MAP_ID, nullptr, tile, wv);
        transpose_job(p.mla_w_in + (size_t)j * 1024 * 2752, (bf16_t*)(ws + W_MIN + j * W_MIN_SZ), 1024, 2752, MLA_NPAD, MAP_MLAIN, nullptr, tile, wv);
        transpose_job(p.mla_w_uq + (size_t)j * 384 * 3072, (bf16_t*)(ws + W_MUQ + j * W_MUQ_SZ), 384, 3072, 3072, MAP_UQ, p.mla_qn_g + j * 384, tile, wv);
        transpose_job(p.mla_w_ukv + (size_t)j * 256 * 4096, (bf16_t*)(ws + W_MUKV + j * W_MUKV_SZ), 256, 4096, 4096, MAP_UKV, p.mla_kvn_g + j * 256, tile, wv);
        transpose_job(p.mla_w_out + (size_t)j * 2048 * 1024, (bf16_t*)(ws + W_MOUT + j * W_OUT_SZ), 2048, 1024, 1024, MAP_ID, nullptr, tile, wv);
    }
    __syncthreads();
}

__device__ __forceinline__ void phase_ln(float* xres, bf16_t* xb, f32x2* stats, const float* g, const float* b, int wv, bool nowrite, bool final_) {
    const int tid = opaque_tid(wv); const int lane = tid & 63, gw = blockIdx.x * 8 + (tid >> 6), nw = gridDim.x * 8;
    f32x4 gv[4], bv[4];
#pragma unroll
    for (int i = 0; i < 4; ++i) { gv[i] = *(const f32x4*)(g + i * 256 + lane * 4); bv[i] = *(const f32x4*)(b + i * 256 + lane * 4); }
    for (int row0 = gw; row0 < T; row0 += 4 * nw) {
        f32x4 v[4][4];
#pragma unroll
        for (int u = 0; u < 4; ++u) { const float* rp = xres + (size_t)(row0 + u * nw) * 1024;
#pragma unroll
            for (int i = 0; i < 4; ++i) v[u][i] = *(const f32x4*)(rp + i * 256 + lane * 4); }
#pragma unroll
        for (int u = 0; u < 4; ++u) {
            const int row = row0 + u * nw; float* rp = xres + (size_t)row * 1024;
            float s = 0.f;
#pragma unroll
            for (int i = 0; i < 4; ++i) s += v[u][i][0] + v[u][i][1] + v[u][i][2] + v[u][i][3];
            const float mu = wave_sum(s) * (1.f / 1024.f);
            float q = 0.f;
#pragma unroll
            for (int i = 0; i < 4; ++i) { v[u][i] = v[u][i] - mu; q += v[u][i][0] * v[u][i][0] + v[u][i][1] * v[u][i][1] + v[u][i][2] * v[u][i][2] + v[u][i][3] * v[u][i][3]; }
            const float rstd = rsqrtf(wave_sum(q) * (1.f / 1024.f) + EPS);
            if (!final_ && lane == 0 && !nowrite) stats[row] = (f32x2){mu, rstd};
#pragma unroll
            for (int i = 0; i < 4; ++i) { const f32x4 y = v[u][i] * rstd * gv[i] + bv[i]; if (!nowrite) { if (final_) *(f32x4*)(rp + i * 256 + lane * 4) = y;
                else { u32x2 w = {cvt_pk_bf16(y[0], y[1]), cvt_pk_bf16(y[2], y[3])}; *(u32x2*)(xb + (size_t)row * 1024 + i * 256 + lane * 4) = w; } } }
        }
    }
}

__device__ __forceinline__ void phase_gla_gate(const bf16_t* O, bf16_t* Z, const float* gn, int wv, bool nowrite) {
    const int tid = opaque_tid(wv); const int lane = tid & 63, h = wv & 3;
    const f32x4 g0 = *(const f32x4*)(gn + h * 512 + lane * 8), g1 = *(const f32x4*)(gn + h * 512 + lane * 8 + 4);
    const int rw = blockIdx.x * 2 + (wv >> 2), nrw = gridDim.x * 2;
    for (int row0 = rw; row0 < T; row0 += 4 * nrw) {
        u32x4 ov[4], zv[4];
#pragma unroll
        for (int u = 0; u < 4; ++u) { const size_t off = (size_t)(row0 + u * nrw) * 2048 + h * 512 + lane * 8; ov[u] = *(const u32x4*)(O + off); zv[u] = *(const u32x4*)(Z + off); }
#pragma unroll
        for (int u = 0; u < 4; ++u) {
            const size_t off = (size_t)(row0 + u * nrw) * 2048 + h * 512 + lane * 8;
            float o[8], z[8];
#pragma unroll
            for (int i = 0; i < 4; ++i) { o[2 * i] = bflo(ov[u][i]); o[2 * i + 1] = bfhi(ov[u][i]); z[2 * i] = bflo(zv[u][i]); z[2 * i + 1] = bfhi(zv[u][i]); }
            float ss = 0.f;
#pragma unroll
            for (int i = 0; i < 8; ++i) ss += o[i] * o[i];
            const float r = rsqrtf(wave_sum(ss) * (1.f / 512.f) + EPS);
            float y[8];
#pragma unroll
            for (int i = 0; i < 8; ++i) y[i] = o[i] * r * (i < 4 ? g0[i] : g1[i - 4]) * silu_f(z[i]);
            u32x4 w = {cvt_pk_bf16(y[0], y[1]), cvt_pk_bf16(y[2], y[3]), cvt_pk_bf16(y[4], y[5]), cvt_pk_bf16(y[6], y[7])};
            if (!nowrite) *(u32x4*)(Z + off) = w;
        }
    }
}

__device__ __forceinline__ void phase_mla_stats(const bf16_t* CQ, const bf16_t* CKV, const float* KRR, bf16_t* KRO, float* RQ, float* RKV, const float* COS, const float* SIN, int wv) {
    const int tid = opaque_tid(wv); const int lane = tid & 63, gw = blockIdx.x * 8 + (tid >> 6), nw = gridDim.x * 8;
    for (int row = gw; row < T; row += nw) {
        float sq = 0.f, sk = 0.f;
        if (lane < 48) { const u32x4 v = *(const u32x4*)(CQ + (size_t)row * 384 + lane * 8);
#pragma unroll
            for (int i = 0; i < 4; ++i) { const float a = bflo(v[i]), b = bfhi(v[i]); sq += a * a + b * b; } }
        if (lane < 32) { const u32x4 v = *(const u32x4*)(CKV + (size_t)row * 256 + lane * 8);
#pragma unroll
            for (int i = 0; i < 4; ++i) { const float a = bflo(v[i]), b = bfhi(v[i]); sk += a * a + b * b; } }
        sq = wave_sum(sq); sk = wave_sum(sk);
        if (lane == 0) { RQ[row] = rsqrtf(sq * (1.f / 384.f) + EPS); RKV[row] = rsqrtf(sk * (1.f / 256.f) + EPS); }
        if (lane < 32) { const float x1 = KRR[(size_t)row * 64 + lane], x2 = KRR[(size_t)row * 64 + 32 + lane];
            const float c = COS[(size_t)row * 32 + lane], s = SIN[(size_t)row * 32 + lane];
            *(unsigned*)(KRO + (size_t)row * 64 + 2 * lane) = cvt_pk_bf16(x1 * c - x2 * s, x2 * c + x1 * s); }
    }
}

namespace att {
constexpr int NW = 8, QBLK = 32, KVBLK = 64;
constexpr int LDQ = 3072, LDK = 2048, LDR = 64, LDZ = 2048;
constexpr float SCALE = 0.07216878364870322f;
constexpr float THR = 8.f;
constexpr int SHM_V = 16384, SHM_K = 16384, SHM_R = 8192;
constexpr int OFF_V = 0, OFF_K = 2 * SHM_V, OFF_R = OFF_K + 2 * SHM_K, OFF_WS = OFF_R + 2 * SHM_R, OFF_QR = OFF_WS + 2048;
#define KSWZ(row, colB) ((row) * 256 + ((colB) ^ (((row) & 7) << 4)))
#define RSWZ(row, colB) ((row) * 128 + ((colB) ^ ((((row) >> 1) & 7) << 4)))
#define SBAR() __builtin_amdgcn_sched_barrier(0)
__device__ __forceinline__ int crow(int r, int hi) { return (r & 3) + 8 * (r >> 2) + 4 * hi; }
__device__ __forceinline__ void partialSM(f32x16& p0, f32x16& p1, float& m_reg, float& mn, float& alpha) {
    constexpr float C = SCALE * 1.4426950408889634f;
    float pmax = p0[0];
#pragma unroll
    for (int r = 1; r < 16; ++r) pmax = fmaxf(pmax, p0[r]);
#pragma unroll
    for (int r = 0; r < 16; ++r) pmax = fmaxf(pmax, p1[r]);
    { auto rr = __builtin_amdgcn_permlane32_swap(__float_as_uint(pmax), __float_as_uint(pmax), false, false);
      pmax = fmaxf(__uint_as_float(rr[0]), __uint_as_float(rr[1])); }
    if (__builtin_expect(__all(pmax - m_reg <= THR / SCALE), 1)) { mn = m_reg; alpha = 1.f; }
    else { mn = fmaxf(m_reg, pmax); alpha = __builtin_amdgcn_exp2f((m_reg - mn) * C); m_reg = mn; }
    const float mnC = -mn * C;
#pragma unroll
    for (int r = 0; r < 16; ++r) p0[r] = fmaf(p0[r], C, mnC);
#pragma unroll
    for (int r = 0; r < 16; ++r) p1[r] = fmaf(p1[r], C, mnC);
#pragma unroll
    for (int r = 0; r < 16; ++r) p0[r] = __builtin_amdgcn_exp2f(p0[r]);
}
__device__ __forceinline__ void finishSM(f32x16& p0, f32x16& p1, float alpha, float& l_reg, bf16x8& pa0, bf16x8& pa1, bf16x8& pa2, bf16x8& pa3) {
#pragma unroll
    for (int r = 0; r < 16; ++r) p1[r] = __builtin_amdgcn_exp2f(p1[r]);
    float ps = 0;
#pragma unroll
    for (int r = 0; r < 16; ++r) ps += p0[r];
#pragma unroll
    for (int r = 0; r < 16; ++r) ps += p1[r];
    { auto rr = __builtin_amdgcn_permlane32_swap(__float_as_uint(ps), __float_as_uint(ps), false, false);
      ps = __uint_as_float(rr[0]) + __uint_as_float(rr[1]); }
    l_reg = l_reg * alpha + ps;
#define PK4(P, BASE, OUT) do { unsigned a0 = cvt_pk_bf16(P[BASE + 0], P[BASE + 1]), a1 = cvt_pk_bf16(P[BASE + 2], P[BASE + 3]);   \
    unsigned b0 = cvt_pk_bf16(P[BASE + 4], P[BASE + 5]), b1 = cvt_pk_bf16(P[BASE + 6], P[BASE + 7]);                              \
    auto r0 = __builtin_amdgcn_permlane32_swap(a0, b0, false, false); auto r1 = __builtin_amdgcn_permlane32_swap(a1, b1, false, false); \
    u32x4 w = {r0[0], r1[0], r0[1], r1[1]}; OUT = *reinterpret_cast<bf16x8*>(&w); } while (0)
    PK4(p0, 0, pa0); PK4(p0, 8, pa1); PK4(p1, 0, pa2); PK4(p1, 8, pa3);
#undef PK4
}
__device__ __forceinline__ void qkt(f32x16& p0, f32x16& p1, const char* Ks, const char* Rs, const bf16x8* qr, const char* Qp, int r32, int hi) {
    p0 = f32x16{}; p1 = f32x16{};
#pragma unroll
    for (int d0 = 0; d0 < 8; ++d0) { const int cb = (d0 * 16 + hi * 8) * 2;
        const bf16x8 b0 = *reinterpret_cast<const bf16x8*>(Ks + KSWZ(r32, cb));
        const bf16x8 b1 = *reinterpret_cast<const bf16x8*>(Ks + KSWZ(32 + r32, cb));
        p0 = __builtin_amdgcn_mfma_f32_32x32x16_bf16(b0, qr[d0], p0, 0, 0, 0);
        p1 = __builtin_amdgcn_mfma_f32_32x32x16_bf16(b1, qr[d0], p1, 0, 0, 0); }
#pragma unroll
    for (int d0 = 0; d0 < 4; ++d0) { const int cb = (d0 * 16 + hi * 8) * 2;
        const bf16x8 b0 = *reinterpret_cast<const bf16x8*>(Rs + RSWZ(r32, cb));
        const bf16x8 b1 = *reinterpret_cast<const bf16x8*>(Rs + RSWZ(32 + r32, cb));
        const bf16x8 qq = *reinterpret_cast<const bf16x8*>(Qp + RSWZ(r32, cb));
        p0 = __builtin_amdgcn_mfma_f32_32x32x16_bf16(b0, qq, p0, 0, 0, 0);
        p1 = __builtin_amdgcn_mfma_f32_32x32x16_bf16(b1, qq, p1, 0, 0, 0); }
}
__device__ __forceinline__ int v_st(int k, int c) { const int kk = (k & ~0xC) | ((k & 4) << 1) | ((k & 8) >> 1); return ((kk >> 3) * 4 + (c >> 5)) * 512 + ((kk & 7) * 32 + (c & 31)) * 2; }
__device__ __forceinline__ int v_rd_base(int lane) { return ((lane & 3) << 3) | (((lane >> 2) & 3) << 6) | (((lane >> 4) & 1) << 5) | (((lane >> 5) & 1) << 8); }
constexpr int v_rd_off(int d0, int ks, int half) { return d0 * 512 + ks * 4096 + half * 2048; }
template <int OFF> __device__ __forceinline__ s16x4 tr_read(int vb) {
    s16x4 r; asm volatile("ds_read_b64_tr_b16 %0, %1 offset:%2" : "=&v"(r) : "v"(vb), "i"(OFF) : "memory"); return r;
}
template <int D0> __device__ __forceinline__ void pv_one(f32x16& od, int vb, bf16x8 pa0, bf16x8 pa1, bf16x8 pa2, bf16x8 pa3) {
    const s16x4 l0 = tr_read<v_rd_off(D0, 0, 0)>(vb), h0 = tr_read<v_rd_off(D0, 0, 1)>(vb), l1 = tr_read<v_rd_off(D0, 1, 0)>(vb), h1 = tr_read<v_rd_off(D0, 1, 1)>(vb);
    const s16x4 l2 = tr_read<v_rd_off(D0, 2, 0)>(vb), h2 = tr_read<v_rd_off(D0, 2, 1)>(vb), l3 = tr_read<v_rd_off(D0, 3, 0)>(vb), h3 = tr_read<v_rd_off(D0, 3, 1)>(vb);
    asm volatile("s_waitcnt lgkmcnt(0)" ::: "memory"); SBAR();
#define PK(L, H) (bf16x8){L[0], L[1], L[2], L[3], H[0], H[1], H[2], H[3]}
    od = __builtin_amdgcn_mfma_f32_32x32x16_bf16(pa0, PK(l0, h0), od, 0, 0, 0);
    od = __builtin_amdgcn_mfma_f32_32x32x16_bf16(pa1, PK(l1, h1), od, 0, 0, 0);
    od = __builtin_amdgcn_mfma_f32_32x32x16_bf16(pa2, PK(l2, h2), od, 0, 0, 0);
    od = __builtin_amdgcn_mfma_f32_32x32x16_bf16(pa3, PK(l3, h3), od, 0, 0, 0);
#undef PK
}
__device__ __forceinline__ void pv_d0(f32x16* o, int vb, bf16x8 pa0, bf16x8 pa1, bf16x8 pa2, bf16x8 pa3) {
    pv_one<0>(o[0], vb, pa0, pa1, pa2, pa3); pv_one<1>(o[1], vb, pa0, pa1, pa2, pa3); pv_one<2>(o[2], vb, pa0, pa1, pa2, pa3); pv_one<3>(o[3], vb, pa0, pa1, pa2, pa3);
}
__device__ __forceinline__ void attn_body(const bf16_t* __restrict__ Qb, const bf16_t* __restrict__ Kh, const bf16_t* __restrict__ Vh, const bf16_t* __restrict__ Rh,
                                          bf16_t* __restrict__ Zb, int seq, char* lds, int wv, bool nowrite) {
    const int tid = opaque_tid(wv), wid = wv, lane = tid & 63, r32 = lane & 31, hi = lane >> 5;
    char* V_lds = lds + OFF_V; char* K_lds = lds + OFF_K; char* R_lds = lds + OFF_R;
    float* ws = (float*)(lds + OFF_WS) + wid * 64; float* li_l = ws; float* al_l = ws + 32;
    float m_reg = -1e30f, l_reg = 0; f32x16 o[4] = {}; bf16x8 qr[8];
    const bf16_t* Qw = Qb + (long)(wid * QBLK + r32) * LDQ + hi * 8;
    char* Qp = lds + OFF_QR + wid * 4096;
#pragma unroll
    for (int d0 = 0; d0 < 8; ++d0) qr[d0] = *reinterpret_cast<const bf16x8*>(Qw + d0 * 16);
#pragma unroll
    for (int d0 = 0; d0 < 4; ++d0) *reinterpret_cast<bf16x8*>(Qp + RSWZ(r32, (d0 * 16 + hi * 8) * 2)) = *reinterpret_cast<const bf16x8*>(Qw + 128 + d0 * 16);
    const int sr = tid >> 4, sc = (tid & 15) * 8, vst0 = v_st(sr, sc), vst1 = v_st(32 + sr, sc);
    const int rr = tid >> 3, rc = (tid & 7) * 8;
    const int vb0 = (int)(uintptr_t)(LAS char*)V_lds + v_rd_base(lane);
    bf16x8 vs0, vs1, ks0, ks1, rs0;
#define SLOAD(k0) do { vs0 = *reinterpret_cast<const bf16x8*>(&Vh[(long)((k0) + sr) * LDK + sc]); vs1 = *reinterpret_cast<const bf16x8*>(&Vh[(long)((k0) + 32 + sr) * LDK + sc]); \
    ks0 = *reinterpret_cast<const bf16x8*>(&Kh[(long)((k0) + sr) * LDK + sc]); ks1 = *reinterpret_cast<const bf16x8*>(&Kh[(long)((k0) + 32 + sr) * LDK + sc]); \
    rs0 = *reinterpret_cast<const bf16x8*>(&Rh[(long)((k0) + rr) * LDR + rc]); } while (0)
#define SWRITE(b) do { *(bf16x8*)(V_lds + (b) * SHM_V + vst0) = vs0; *(bf16x8*)(V_lds + (b) * SHM_V + vst1) = vs1; const int kc = sc * 2; \
    *(bf16x8*)(K_lds + (b) * SHM_K + KSWZ(sr, kc)) = ks0; *(bf16x8*)(K_lds + (b) * SHM_K + KSWZ(32 + sr, kc)) = ks1; \
    *(bf16x8*)(R_lds + (b) * SHM_R + RSWZ(rr, rc * 2)) = rs0; } while (0)
#define SWAIT() asm volatile("s_waitcnt vmcnt(0)" ::: "memory")
#define RESC(a) do { if (__any((a) < 1.f)) { if (hi == 0) al_l[r32] = (a); asm volatile("s_waitcnt lgkmcnt(0)" ::: "memory"); \
    _Pragma("unroll") for (int d = 0; d < 4; ++d) _Pragma("unroll") for (int r = 0; r < 16; ++r) o[d][r] *= al_l[crow(r, hi)]; } } while (0)
    f32x16 pA0, pA1, pB0, pB1; float mnA, mnB, alA, alB; bf16x8 pa0, pa1, pa2, pa3; const int NT = seq / KVBLK;
    SLOAD(0); SWAIT(); SWRITE(0); __syncthreads();
    qkt(pA0, pA1, K_lds, R_lds, qr, Qp, r32, hi); partialSM(pA0, pA1, m_reg, mnA, alA);
    SLOAD(KVBLK);
    SWAIT(); SWRITE(1); __syncthreads();
    for (int j = 1; j + 1 < NT; j += 2) {
        SBAR(); qkt(pB0, pB1, K_lds + SHM_K, R_lds + SHM_R, qr, Qp, r32, hi);
        finishSM(pA0, pA1, alA, l_reg, pa0, pa1, pa2, pa3); SBAR();
        SLOAD((j + 1) * KVBLK); SBAR();
        pv_d0(o, vb0, pa0, pa1, pa2, pa3); partialSM(pB0, pB1, m_reg, mnB, alB);
        __syncthreads(); SWAIT(); SWRITE(0);
        RESC(alB); __syncthreads();
        SBAR(); qkt(pA0, pA1, K_lds, R_lds, qr, Qp, r32, hi);
        finishSM(pB0, pB1, alB, l_reg, pa0, pa1, pa2, pa3); SBAR();
        SLOAD((j + 2) * KVBLK); SBAR();
        pv_d0(o, vb0 + SHM_V, pa0, pa1, pa2, pa3); partialSM(pA0, pA1, m_reg, mnA, alA);
        __syncthreads(); SWAIT(); SWRITE(1);
        RESC(alA); __syncthreads();
    }
    SBAR(); qkt(pB0, pB1, K_lds + SHM_K, R_lds + SHM_R, qr, Qp, r32, hi);
    finishSM(pA0, pA1, alA, l_reg, pa0, pa1, pa2, pa3); SBAR();
    pv_d0(o, vb0, pa0, pa1, pa2, pa3); partialSM(pB0, pB1, m_reg, mnB, alB);
    __syncthreads(); RESC(alB);
    finishSM(pB0, pB1, alB, l_reg, pa0, pa1, pa2, pa3); SBAR();
    pv_d0(o, vb0 + SHM_V, pa0, pa1, pa2, pa3);
    if (hi == 0) li_l[r32] = l_reg; asm volatile("s_waitcnt lgkmcnt(0)" ::: "memory");
    float rli[16];
#pragma unroll
    for (int r = 0; r < 16; ++r) rli[r] = __builtin_amdgcn_rcpf(li_l[crow(r, hi)]);
    bf16_t* Zw = Zb + (long)(wid * QBLK + 4 * hi) * LDZ + r32;
    unsigned short zq[16][4];
#pragma unroll
    for (int r = 0; r < 16; ++r)
#pragma unroll
        for (int d0 = 0; d0 < 4; ++d0) zq[r][d0] = Zw[(long)((r & 3) + 8 * (r >> 2)) * LDZ + d0 * 32];
    asm volatile("s_waitcnt vmcnt(0)" ::: "memory"); SBAR();
#pragma unroll
    for (int r = 0; r < 16; ++r) {
#pragma unroll
        for (int d0 = 0; d0 < 4; ++d0) { const float z = bf2f(zq[r][d0]);
            if (!nowrite) Zw[(long)((r & 3) + 8 * (r >> 2)) * LDZ + d0 * 32] = (bf16_t)(cvt_pk_bf16(o[d0][r] * rli[r] * silu_f(z), 0.f) & 0xffffu); } }
    __syncthreads();
#undef SLOAD
#undef SWRITE
#undef SWAIT
#undef RESC
}
__device__ __forceinline__ void phase_attn(const bf16_t* QH, const bf16_t* KNH, const bf16_t* VH, const bf16_t* KRO, bf16_t* Z, int half, char* lds, int wv, bool nowrite) {
    const int c = blockIdx.x, G = gridDim.x;
    const int per = 2048 / G;
    for (int i = 0; i < per; ++i) {
        int bh, qb;
        if (G == 256) { const int xcd = c & 7, slot = c >> 3; bh = i * 32 + xcd * 4 + (slot >> 3); qb = slot & 7; }
        else { const int u = i * G + c; bh = u >> 3; qb = u & 7; }
        const int bl = bh >> 4, h = bh & 15;
        const size_t lrow = (size_t)bl * SEQ, grow = (size_t)half * TH + lrow;
        attn_body(QH + (lrow + qb * 256) * LDQ + h * 192, KNH + lrow * LDK + h * 128, VH + lrow * LDK + h * 128, KRO + grow * 64,
                  Z + (grow + qb * 256) * LDZ + h * 128, SEQ, lds, wv, nowrite);
    }
}
}

#ifndef SC_MASK
#define SC_MASK 0xFFFF
#endif
#define SCB(i) do { if (SC_MASK & (1 << (i))) __builtin_amdgcn_sched_barrier(0); } while (0)
namespace scan {
constexpr int QE_ST = 272, KE_ST = 320, P_ST = 144, V_ST = 576, BC_ST = 528;
constexpr int OFF_QE = 0, OFF_KE = OFF_QE + 64 * QE_ST, OFF_P = OFF_KE + 64 * KE_ST, OFF_V = OFF_P + 64 * P_ST, OFF_BC = OFF_V + 64 * V_ST,
              OFF_GLR = OFF_BC + 64 * BC_ST, OFF_PART = OFF_GLR + 4096, OFF_EBT = OFF_PART + 2048, OFF_WG = OFF_EBT + 512, OFF_SSQW = OFF_WG + 8192, OFF_RN = OFF_SSQW + 2048, OFF_G = OFF_RN + 256, OFF_END = OFF_G + 1024;
static_assert(OFF_END <= LDS_BYTES, "scan LDS");
template <int OFF> __device__ __forceinline__ s16x4 tr_read(int vb) {
    s16x4 r; asm volatile("ds_read_b64_tr_b16 %0, %1 offset:%2" : "=&v"(r) : "v"(vb), "i"(OFF) : "memory"); return r;
}
#define PK8(L, H) (bf16x8){L[0], L[1], L[2], L[3], H[0], H[1], H[2], H[3]}
#define LAUNDER(t) const int t = opaque_tid(wv)
__device__ __forceinline__ void phase_scan(const bf16_t* QK, const bf16_t* V, const float* GLR, bf16_t* OFW, const float* wgate, const float* bgate, char* lds, int wv,
                                           bf16_t* Z, const float* gn, unsigned long long* X, unsigned tag) {
    const int wid = wv;
    if (wv >= 4) __builtin_amdgcn_s_setprio(1);
    for (int item = blockIdx.x; item < 256; item += gridDim.x) {
        const int b = item >> 3, h = (item >> 1) & 3, vh = item & 1;
        __syncthreads();
        { LAUNDER(t); if (t < 256) *(float*)(lds + OFF_G + t * 4) = gn[h * 512 + vh * 256 + t]; }
        for (int dir = 0; dir < 2; ++dir) {
            __syncthreads();
            float bgv; float wgb[8];
            { LAUNDER(t); const int ln = t & 63, r32_ = ln & 31, hi_ = ln >> 5, db_ = wid & 3;
#pragma unroll
              for (int kk = 0; kk < 8; ++kk) wgb[kk] = wgate[((size_t)dir * 16 + 2 * kk + hi_) * 512 + h * 128 + db_ * 32 + r32_];
              bgv = bgate[(size_t)dir * 512 + h * 128 + db_ * 32 + r32_]; }
            f32x16 S[4];
#pragma unroll
            for (int i = 0; i < 4; ++i) S[i] = f32x16{};
            bf16x8 rq[2], rk[2], rv[4]; f32x2 rg;
#define CLOAD_QK(n) do { LAUNDER(t_); const unsigned qo_ = (unsigned)((t_ >> 4) * 1024 + (t_ & 15) * 8) * 2u; const size_t t0_ = (size_t)b * SEQ + (size_t)(n) * 64; const char* qb_ = (const char*)QK + (t0_ * 1024 + h * 128) * 2; \
    rq[0] = *(const bf16x8*)(qb_ + qo_); rq[1] = *(const bf16x8*)(qb_ + 65536 + qo_); rk[0] = *(const bf16x8*)(qb_ + 1024 + qo_); rk[1] = *(const bf16x8*)(qb_ + 1024 + 65536 + qo_); } while (0)
#define CLOAD_VG(n) do { LAUNDER(t_); const unsigned vo_ = (unsigned)((t_ >> 5) * 2048 + (t_ & 31) * 8) * 2u, go_ = (unsigned)((t_ >> 3) * 32 + (t_ & 7) * 2) * 4u; const size_t t0_ = (size_t)b * SEQ + (size_t)(n) * 64; \
    const char* vb_ = (const char*)V + (t0_ * 2048 + h * 512 + vh * 256) * 2; const char* gb_ = (const char*)GLR + (t0_ * 32 + dir * 16) * 4; \
    _Pragma("unroll") for (int i = 0; i < 4; ++i) rv[i] = *(const bf16x8*)(vb_ + (size_t)i * 65536 + vo_); \
    rg = *(const f32x2*)(gb_ + go_); } while (0)
            CLOAD_QK(dir == 0 ? 0 : 31); CLOAD_VG(dir == 0 ? 0 : 31);
#define LBAR() do { asm volatile("s_waitcnt lgkmcnt(0)" ::: "memory"); __builtin_amdgcn_s_barrier(); asm volatile("" ::: "memory"); } while (0)
#define STAGE_VG() do { LAUNDER(t_); const int vr = t_ >> 5, vc = (t_ & 31) * 8, gr = t_ >> 3, gc = (t_ & 7) * 2; \
    _Pragma("unroll") for (int i = 0; i < 4; ++i) *(bf16x8*)(lds + OFF_V + (vr + 16 * i) * V_ST + vc * 2) = rv[i]; \
    *(f32x2*)(lds + OFF_GLR + gr * 64 + gc * 4) = rg; } while (0)
#define XSLOT(nc, half_) (X + ((((size_t)(b * 4 + h) * 32 + (nc)) * 2 + (half_)) * 64))
#define GN_PUBLISH(nc) do { if (wid == 0) { LAUNDER(t_); const int ln_ = t_ & 63; float own_ = 0.f; \
    _Pragma("unroll") for (int w_ = 0; w_ < 8; ++w_) own_ += *(const float*)(lds + OFF_SSQW + (w_ * 64 + ln_) * 4); hown = own_; \
    const unsigned long long g_ = ((unsigned long long)tag << 32) | (unsigned long long)__float_as_uint(own_); \
    __hip_atomic_store(XSLOT(nc, vh) + ln_, g_, __ATOMIC_RELAXED, __HIP_MEMORY_SCOPE_AGENT); } } while (0)
#define GN_POLL(nc) do { if (wid == 0) { LAUNDER(t_); const int ln_ = t_ & 63; unsigned long long g_ = 0ull; unsigned sp_ = 0u; \
    for (;;) { g_ = __hip_atomic_load(XSLOT(nc, vh ^ 1) + ln_, __ATOMIC_RELAXED, __HIP_MEMORY_SCOPE_AGENT); if ((unsigned)(g_ >> 32) == tag || ++sp_ > (1u << 22)) break; __builtin_amdgcn_s_sleep(1); } \
    const float tot_ = hown + __uint_as_float((unsigned)g_); *(float*)(lds + OFF_RN + ln_ * 4) = rsqrtf(tot_ * (1.f / 512.f) + EPS); } } while (0)
#define GN_FINAL(nc) do { LAUNDER(t_); const int ln_ = t_ & 63; const float r_ = *(const float*)(lds + OFF_RN + ln_ * 4); \
    bf16_t* zr_ = Z + ((size_t)b * SEQ + (size_t)(nc) * 64 + ln_) * 2048 + h * 512 + vh * 256 + wid * 32; \
    _Pragma("unroll") for (int j_ = 0; j_ < 4; ++j_) { const f32x4 g0_ = *(const f32x4*)(lds + OFF_G + (wid * 32 + j_ * 8) * 4), g1_ = *(const f32x4*)(lds + OFF_G + (wid * 32 + j_ * 8 + 4) * 4); \
        const f32x4 a_ = hs[2 * j_], c_ = hs[2 * j_ + 1]; const u32x4 z_ = hz[j_]; \
        u32x4 w_ = {cvt_pk_bf16(a_[0] * r_ * g0_[0] * silu_fast(bflo(z_[0])), a_[1] * r_ * g0_[1] * silu_fast(bfhi(z_[0]))), cvt_pk_bf16(a_[2] * r_ * g0_[2] * silu_fast(bflo(z_[1])), a_[3] * r_ * g0_[3] * silu_fast(bfhi(z_[1]))), \
                    cvt_pk_bf16(c_[0] * r_ * g1_[0] * silu_fast(bflo(z_[2])), c_[1] * r_ * g1_[1] * silu_fast(bfhi(z_[2]))), cvt_pk_bf16(c_[2] * r_ * g1_[2] * silu_fast(bflo(z_[3])), c_[3] * r_ * g1_[3] * silu_fast(bfhi(z_[3])))}; \
        *(u32x4*)(zr_ + j_ * 8) = w_; __builtin_amdgcn_sched_barrier(0); } } while (0)
            STAGE_VG();
            CLOAD_VG(dir == 0 ? 1 : 30);
            LBAR();
            for (int step = 0; step < 32; ++step) {
                const int n = dir == 0 ? step : 31 - step;
                const size_t t0 = (size_t)b * SEQ + (size_t)n * 64;
                {
                    LAUNDER(t); const int ln = t & 63, r32 = ln & 31, hi = ln >> 5, cb = wid >> 2, db = wid & 3, d = db * 32 + r32;
                    f32x4 ar[4];
#pragma unroll
                    for (int i = 0; i < 4; ++i) ar[i] = *(const f32x4*)(lds + OFF_GLR + (cb * 32 + r32) * 64 + i * 16);
                    asm volatile("s_waitcnt lgkmcnt(0)" ::: "memory"); __builtin_amdgcn_sched_barrier(0);
                    f32x16 pa;
#pragma unroll
                    for (int r = 0; r < 16; ++r) pa[r] = bgv;
#pragma unroll
                    for (int kk = 0; kk < 8; ++kk) { const float a = hi ? ar[kk >> 1][2 * (kk & 1) + 1] : ar[kk >> 1][2 * (kk & 1)];
                        pa = __builtin_amdgcn_mfma_f32_32x32x2f32(a, wgb[kk], pa, 0, 0, 0); }
                    float lgv[16], pl[16];
#pragma unroll
                    for (int r = 0; r < 16; ++r) { const float pre = pa[r]; lgv[r] = -(fmaxf(-pre, 0.f) + __logf(1.f + __expf(-fabsf(pre)))) * (0.0625f * 1.4426950408889634f); }
#pragma unroll
                    for (int k = 0; k < 4; ++k) { pl[4 * k] = lgv[4 * k]; pl[4 * k + 1] = pl[4 * k] + lgv[4 * k + 1]; pl[4 * k + 2] = pl[4 * k + 1] + lgv[4 * k + 2]; pl[4 * k + 3] = pl[4 * k + 2] + lgv[4 * k + 3]; }
#pragma unroll
                    for (int k = 0; k < 4; ++k) *(float*)(lds + OFF_P + ((cb * 8 + 2 * k + hi) * 128 + d) * 4) = pl[4 * k + 3];
                    LBAR();
                    float gsv[16];
#pragma unroll
                    for (int g = 0; g < 16; ++g) gsv[g] = *(const float*)(lds + OFF_P + (g * 128 + d) * 4);
                    asm volatile("s_waitcnt lgkmcnt(0)" ::: "memory"); __builtin_amdgcn_sched_barrier(0);
                    float ex[16]; float run = 0.f;
#pragma unroll
                    for (int g = 0; g < 16; ++g) { ex[g] = run; run += gsv[g]; }
                    const float tot = run;
#pragma unroll
                    for (int k = 0; k < 4; ++k) { const float e0 = cb ? ex[8 + 2 * k] : ex[2 * k], e1 = cb ? ex[8 + 2 * k + 1] : ex[2 * k + 1]; const float off = hi ? e1 : e0;
#pragma unroll
                        for (int e = 0; e < 4; ++e) { const int r = 4 * k + e; const float bc = dir == 0 ? off + pl[r] : tot - (off + pl[r] - lgv[r]);
                            *(float*)(lds + OFF_BC + (cb * 32 + e + 8 * k + 4 * hi) * BC_ST + d * 4) = bc; } }
                    if (cb == 0 && hi == 0) *(float*)(lds + OFF_EBT + d * 4) = __builtin_amdgcn_exp2f(tot);
                }
                LBAR();
                { LAUNDER(t); const int sr = t >> 4, sc = (t & 15) * 8;
#pragma unroll
                  for (int i = 0; i < 2; ++i) { const int row = sr + 32 * i;
                    const f32x4 b0 = *(const f32x4*)(lds + OFF_BC + row * BC_ST + sc * 4), b1 = *(const f32x4*)(lds + OFF_BC + row * BC_ST + sc * 4 + 16);
                    const bf16x8 qv = rq[i], kv = rk[i];
                    float qf[8], kf[8];
#pragma unroll
                    for (int e = 0; e < 8; ++e) { const float bb = e < 4 ? b0[e] : b1[e - 4]; const float eb = __builtin_amdgcn_exp2f(bb), ei = __builtin_amdgcn_exp2f(-bb);
                        qf[e] = bf2f((unsigned short)qv[e]) * eb; kf[e] = bf2f((unsigned short)kv[e]) * ei; }
                    u32x4 qw = {cvt_pk_bf16(qf[0], qf[1]), cvt_pk_bf16(qf[2], qf[3]), cvt_pk_bf16(qf[4], qf[5]), cvt_pk_bf16(qf[6], qf[7])};
                    u32x4 kw = {cvt_pk_bf16(kf[0], kf[1]), cvt_pk_bf16(kf[2], kf[3]), cvt_pk_bf16(kf[4], kf[5]), cvt_pk_bf16(kf[6], kf[7])};
                    *(u32x4*)(lds + OFF_QE + row * QE_ST + sc * 2) = qw; *(u32x4*)(lds + OFF_KE + row * KE_ST + sc * 2) = kw; } }
                if (step + 1 < 32) { const int nn = dir == 0 ? step + 1 : 30 - step; CLOAD_QK(nn); }
                u32x4 pf[4];
                bf16_t* orow;
                { LAUNDER(t); const int ln = t & 63; orow = OFW + ((((size_t)item * 32 + n) * 8 + wid) * 256 + ln) * 8; }
                if (dir == 1) {
#pragma unroll
                    for (int j = 0; j < 4; ++j) pf[j] = *(const u32x4*)(orow + j * 512);
                }
                LBAR();
                { LAUNDER(t); const int fr = t & 15, fq = (t >> 4) & 3;
#pragma unroll
                  for (int tt = 0; tt < 2; ++tt) { const int tl = wid * 2 + tt, it = tl >> 2, jt = tl & 3;
                    f32x4 pc = {0.f, 0.f, 0.f, 0.f};
                    bf16x8 af[4], bfg[4];
#pragma unroll
                    for (int ks = 0; ks < 4; ++ks) {
                        af[ks] = *(const bf16x8*)(lds + OFF_KE + (jt * 16 + fr) * KE_ST + (ks * 32 + fq * 8) * 2);
                        bfg[ks] = *(const bf16x8*)(lds + OFF_QE + (it * 16 + fr) * QE_ST + (ks * 32 + fq * 8) * 2); }
                    asm volatile("s_waitcnt lgkmcnt(0)" ::: "memory"); SCB(1);
#pragma unroll
                    for (int ks = 0; ks < 4; ++ks) pc = __builtin_amdgcn_mfma_f32_16x16x32_bf16(af[ks], bfg[ks], pc, 0, 0, 0);
                    const int ii = it * 16 + fr, j0 = jt * 16 + fq * 4;
                    float pm[4];
#pragma unroll
                    for (int e = 0; e < 4; ++e) pm[e] = (dir == 0 ? (j0 + e <= ii) : (j0 + e >= ii)) ? pc[e] : 0.f;
                    u32x2 pw = {cvt_pk_bf16(pm[0], pm[1]), cvt_pk_bf16(pm[2], pm[3])};
                    *(u32x2*)(lds + OFF_P + ii * P_ST + j0 * 2) = pw; } }
                bf16x8 vf[4];
                f32x16 o0 = f32x16{}, o1 = f32x16{};
                {
                    LAUNDER(t); const int ln = t & 63, hi = ln >> 5, r32 = ln & 31, m16 = ln & 15, g16 = (ln >> 4) & 1;
                    const int ldsb = (int)(uintptr_t)(LAS char*)lds;
                    const int trv = ldsb + OFF_V + (8 * hi + (m16 >> 2)) * V_ST + (wid * 32 + 16 * g16 + 4 * (m16 & 3)) * 2;
                    const int trk = ldsb + OFF_KE + (8 * hi + (m16 >> 2)) * KE_ST + (16 * g16 + 4 * (m16 & 3)) * 2;
                    {
                    const s16x4 l0 = tr_read<0 * 16 * V_ST>(trv), h0 = tr_read<0 * 16 * V_ST + 4 * V_ST>(trv), l1 = tr_read<1 * 16 * V_ST>(trv), h1 = tr_read<1 * 16 * V_ST + 4 * V_ST>(trv);
                    const s16x4 l2 = tr_read<2 * 16 * V_ST>(trv), h2 = tr_read<2 * 16 * V_ST + 4 * V_ST>(trv), l3 = tr_read<3 * 16 * V_ST>(trv), h3 = tr_read<3 * 16 * V_ST + 4 * V_ST>(trv);
                    asm volatile("s_waitcnt lgkmcnt(0)" ::: "memory"); SCB(2);
                    vf[0] = PK8(l0, h0); vf[1] = PK8(l1, h1); vf[2] = PK8(l2, h2); vf[3] = PK8(l3, h3);
                    }
                    const char* qa = lds + OFF_QE + r32 * QE_ST + 8 * hi;
#pragma unroll
                    for (int db = 0; db < 4; ++db) {
                        s16x4 al[2][2], ah[2][2];
#pragma unroll
                        for (int s = 0; s < 2; ++s) { const int dcol = (db * 32 + 16 * s) * 2;
                            al[s][0] = *(const s16x4*)(qa + dcol); ah[s][0] = *(const s16x4*)(qa + dcol + 16);
                            al[s][1] = *(const s16x4*)(qa + 32 * QE_ST + dcol); ah[s][1] = *(const s16x4*)(qa + 32 * QE_ST + dcol + 16); }
                        bf16x8 bfr[2];
#pragma unroll
                        for (int s = 0; s < 2; ++s) {
                            u32x4 bw = {cvt_pk_bf16(S[db][8 * s + 0], S[db][8 * s + 1]), cvt_pk_bf16(S[db][8 * s + 2], S[db][8 * s + 3]),
                                        cvt_pk_bf16(S[db][8 * s + 4], S[db][8 * s + 5]), cvt_pk_bf16(S[db][8 * s + 6], S[db][8 * s + 7])};
                            bfr[s] = *reinterpret_cast<bf16x8*>(&bw); }
                        asm volatile("s_waitcnt lgkmcnt(0)" ::: "memory"); SCB(3);
#pragma unroll
                        for (int s = 0; s < 2; ++s) {
                            o0 = __builtin_amdgcn_mfma_f32_32x32x16_bf16(PK8(al[s][0], ah[s][0]), bfr[s], o0, 0, 0, 0);
                            o1 = __builtin_amdgcn_mfma_f32_32x32x16_bf16(PK8(al[s][1], ah[s][1]), bfr[s], o1, 0, 0, 0); }
                    }
                    const char* ebp = lds + OFF_EBT + 16 * hi;
#define SUPD(DB) do { \
    const s16x4 l0 = tr_read<(DB) * 64 + 0 * 16 * KE_ST>(trk), h0 = tr_read<(DB) * 64 + 0 * 16 * KE_ST + 4 * KE_ST>(trk), l1 = tr_read<(DB) * 64 + 1 * 16 * KE_ST>(trk), h1 = tr_read<(DB) * 64 + 1 * 16 * KE_ST + 4 * KE_ST>(trk); \
    const s16x4 l2 = tr_read<(DB) * 64 + 2 * 16 * KE_ST>(trk), h2 = tr_read<(DB) * 64 + 2 * 16 * KE_ST + 4 * KE_ST>(trk), l3 = tr_read<(DB) * 64 + 3 * 16 * KE_ST>(trk), h3 = tr_read<(DB) * 64 + 3 * 16 * KE_ST + 4 * KE_ST>(trk); \
    asm volatile("s_waitcnt lgkmcnt(0)" ::: "memory"); SCB(4); \
    S[DB] = __builtin_amdgcn_mfma_f32_32x32x16_bf16(PK8(l0, h0), vf[0], S[DB], 0, 0, 0); \
    S[DB] = __builtin_amdgcn_mfma_f32_32x32x16_bf16(PK8(l1, h1), vf[1], S[DB], 0, 0, 0); \
    S[DB] = __builtin_amdgcn_mfma_f32_32x32x16_bf16(PK8(l2, h2), vf[2], S[DB], 0, 0, 0); \
    S[DB] = __builtin_amdgcn_mfma_f32_32x32x16_bf16(PK8(l3, h3), vf[3], S[DB], 0, 0, 0); \
    _Pragma("unroll") for (int g = 0; g < 4; ++g) { const f32x4 eb = *(const f32x4*)(ebp + ((DB) * 32 + 8 * g) * 4); \
        S[DB][4 * g + 0] *= eb[0]; S[DB][4 * g + 1] *= eb[1]; S[DB][4 * g + 2] *= eb[2]; S[DB][4 * g + 3] *= eb[3]; } asm volatile("" : "+v"(S[DB])); } while (0)
                    SUPD(0); SUPD(1); SUPD(2); SUPD(3);
#undef SUPD
                }
                LBAR();
                if (step + 1 < 32) { STAGE_VG(); if (step + 2 < 32) { const int nn = dir == 0 ? step + 2 : 29 - step; CLOAD_VG(nn); } }

                {
                    LAUNDER(t); const int ln = t & 63, hi = ln >> 5, r32 = ln & 31;
                    const char* pa = lds + OFF_P + r32 * P_ST + 16 * hi;
                    bf16x8 pa0[4], pa1[4];
#pragma unroll
                    for (int ks = 0; ks < 4; ++ks) { pa0[ks] = *(const bf16x8*)(pa + ks * 32); pa1[ks] = *(const bf16x8*)(pa + 32 * P_ST + ks * 32); }
                    asm volatile("s_waitcnt lgkmcnt(0)" ::: "memory"); SCB(5);
#pragma unroll
                    for (int ks = 0; ks < 4; ++ks) {
                        o0 = __builtin_amdgcn_mfma_f32_32x32x16_bf16(pa0[ks], vf[ks], o0, 0, 0, 0);
                        o1 = __builtin_amdgcn_mfma_f32_32x32x16_bf16(pa1[ks], vf[ks], o1, 0, 0, 0);
                    }
                    if (dir == 0) {
#pragma unroll
                        for (int j = 0; j < 4; ++j) {
                            u32x4 w;
                            if (j < 2) w = (u32x4){cvt_pk_bf16(o0[8 * j + 0], o0[8 * j + 1]), cvt_pk_bf16(o0[8 * j + 2], o0[8 * j + 3]), cvt_pk_bf16(o0[8 * j + 4], o0[8 * j + 5]), cvt_pk_bf16(o0[8 * j + 6], o0[8 * j + 7])};
                            else { const int k = j - 2; w = (u32x4){cvt_pk_bf16(o1[8 * k + 0], o1[8 * k + 1]), cvt_pk_bf16(o1[8 * k + 2], o1[8 * k + 3]), cvt_pk_bf16(o1[8 * k + 4], o1[8 * k + 5]), cvt_pk_bf16(o1[8 * k + 6], o1[8 * k + 7])}; }
                            *(u32x4*)(orow + j * 512) = w;
                        }
                    } else {
#pragma unroll
                        for (int j = 0; j < 2; ++j)
#pragma unroll
                            for (int e = 0; e < 4; ++e) { o0[8 * j + 2 * e] += bflo(pf[j][e]); o0[8 * j + 2 * e + 1] += bfhi(pf[j][e]); o1[8 * j + 2 * e] += bflo(pf[2 + j][e]); o1[8 * j + 2 * e + 1] += bfhi(pf[2 + j][e]); }
                        char* ost = lds + (wid < 4 ? OFF_QE + wid * 8192 : OFF_BC + (wid - 4) * 8192);
#pragma unroll
                        for (int r = 0; r < 16; ++r) { const int ic = (r & 3) + 8 * (r >> 2) + 4 * hi;
                            const int sw = ((((r32 >> 2) ^ (ic & 7)) << 4) | ((r32 & 3) << 2));
                            *(float*)(ost + ic * 128 + sw) = o0[r]; *(float*)(ost + (32 + ic) * 128 + sw) = o1[r]; }
                        asm volatile("s_waitcnt lgkmcnt(0)" ::: "memory"); __builtin_amdgcn_sched_barrier(0);
                        f32x4 oa[4], oc[4];
#pragma unroll
                        for (int j = 0; j < 4; ++j) { oa[j] = *(const f32x4*)(ost + ln * 128 + (((2 * j) ^ (ln & 7)) << 4)); oc[j] = *(const f32x4*)(ost + ln * 128 + (((2 * j + 1) ^ (ln & 7)) << 4)); }
                        asm volatile("s_waitcnt lgkmcnt(0)" ::: "memory"); SCB(6);
                        f32x4 hs[8]; u32x4 hz[4]; float hown = 0.f;
                        float ss = 0.f;
#pragma unroll
                        for (int j = 0; j < 4; ++j) {
                            const f32x4 a = oa[j], c = oc[j];
                            ss += a[0] * a[0] + a[1] * a[1] + a[2] * a[2] + a[3] * a[3] + c[0] * c[0] + c[1] * c[1] + c[2] * c[2] + c[3] * c[3];
                            hs[2 * j] = a; hs[2 * j + 1] = c;
                        }
                        *(float*)(lds + OFF_SSQW + (wid * 64 + ln) * 4) = ss;
                        const bf16_t* zr = Z + (t0 + ln) * 2048 + h * 512 + vh * 256 + wid * 32;
#pragma unroll
                        for (int j = 0; j < 4; ++j) hz[j] = *(const u32x4*)(zr + j * 8);
                        LBAR();
                        GN_PUBLISH(n); GN_POLL(n);
                        LBAR();
                        GN_FINAL(n);
                    }
                }
                if (dir == 0) LBAR();
            }
#undef LBAR
#undef STAGE_VG
#undef XSLOT
#undef GN_PUBLISH
#undef GN_POLL
#undef GN_FINAL
#undef CLOAD_QK
#undef CLOAD_VG
        }
    }
    __builtin_amdgcn_s_setprio(0);
}
#undef LAUNDER
#undef PK8
}


#define XB_TMO      128
#define XB_XCNT(j)  (256  + 64 * (j))
#define XB_XSUB(j)  (1280 + 64 * (j))
#define XB_XGEN(j)  (2304 + 64 * (j))
#define XB_TOP      3328
#define XB_TOPGEN   3392
#define XCD_BAR_WORDS 3456
#define XB_SPIN_CAP (1u << 18)
__device__ __forceinline__ unsigned xb_ld(unsigned* p)              { return __hip_atomic_load(p, __ATOMIC_RELAXED, __HIP_MEMORY_SCOPE_AGENT); }
__device__ __forceinline__ unsigned xb_add(unsigned* p, unsigned v) { return __hip_atomic_fetch_add(p, v, __ATOMIC_RELAXED, __HIP_MEMORY_SCOPE_AGENT); }
__device__ __forceinline__ unsigned xb_xcc_id() { return (unsigned)__builtin_amdgcn_s_getreg((3 << 11) | 20) & 0xFu; }
#define XB_SPIN(cond, bar) do { unsigned _sp = 0; while (cond) { __builtin_amdgcn_s_sleep(1); \
    if ((++_sp & 255u) == 0u) { if (xb_ld(&(bar)[XB_TMO])) break; if (_sp > XB_SPIN_CAP) { atomicAdd(&(bar)[XB_TMO], 1u); break; } } } } while (0)
__device__ __forceinline__ void xcd_barrier_complete(unsigned* bar, unsigned x, unsigned& nloc, unsigned& nx) {
    const unsigned G = gridDim.x;
    unsigned sum, cnt, mine, sp = 0u;
    for (;;) {
        sum = 0u; cnt = 0u; mine = 0u;
#pragma unroll
        for (unsigned j = 0; j < 16; ++j) { const unsigned c = xb_ld(&bar[XB_XCNT(j)]); sum += c; cnt += (c > 0u) ? 1u : 0u; mine = (j == x) ? c : mine; }
        if (sum == G) break;
        __builtin_amdgcn_s_sleep(1);
        if ((++sp & 255u) == 0u) { if (xb_ld(&bar[XB_TMO])) break; if (sp > XB_SPIN_CAP) { atomicAdd(&bar[XB_TMO], 1u); break; } }
    }
    nloc = mine > 0u ? mine : 1u; nx = cnt > 0u ? cnt : 1u;
}
__device__ __forceinline__ void xcd_barrier(unsigned* bar, unsigned x, volatile LAS unsigned* st, int wv) {
    asm volatile("s_waitcnt vmcnt(0)" ::: "memory");
    __syncthreads();
    if (wv == 0 && opaque_lane() == 0) {
        __builtin_amdgcn_s_waitcnt(0);
        unsigned nloc = st[0], nx = st[1];
        if (nloc == 0u) { xcd_barrier_complete(bar, x, nloc, nx); st[0] = nloc; st[1] = nx; }
        const unsigned old = xb_add(&bar[XB_XSUB(x)], 1u);
        const unsigned gen = old / nloc;
        if (old + 1u == (gen + 1u) * nloc) {
            __builtin_amdgcn_fence(__ATOMIC_RELEASE, "agent");
            asm volatile("s_waitcnt vmcnt(0)" ::: "memory");
            const unsigned og = xb_add(&bar[XB_TOP], 1u);
            const unsigned tg = og / nx;
            if (og + 1u == (tg + 1u) * nx) xb_add(&bar[XB_TOPGEN], 1u);
            else XB_SPIN(xb_ld(&bar[XB_TOPGEN]) == tg, bar);
            __builtin_amdgcn_fence(__ATOMIC_ACQUIRE, "agent");
            xb_add(&bar[XB_XGEN(x)], 1u);
            asm volatile("s_waitcnt vmcnt(0)" ::: "memory");
        } else {
            XB_SPIN(xb_ld(&bar[XB_XGEN(x)]) == gen, bar);
            __builtin_amdgcn_fence(__ATOMIC_ACQUIRE, "agent");
            asm volatile("s_waitcnt vmcnt(0)" ::: "memory");
        }
    }
    __syncthreads();
}

constexpr int NPHASE = 23;
#ifndef MK_EN
#define MK_EN 0xFFFF
#endif
#ifndef MK_DUP
#define MK_DUP 0
#endif
#define REPS(bit) for (int rep_ = 0, nrep_ = (MK_DUP & (bit)) ? 2 : 1; rep_ < nrep_; ++rep_)
__global__ void __launch_bounds__(512, 2) mk_fwd(Params p) {
    extern __shared__ __attribute__((aligned(16))) unsigned char lds[];
    LAS unsigned char* lds3 = (LAS unsigned char*)lds;
    typedef const __attribute__((address_space(4))) Params* KP;
    const int wv = __builtin_amdgcn_readfirstlane((int)(threadIdx.x >> 6));
    volatile LAS unsigned* bst = (volatile LAS unsigned*)(lds3 + LDS_ST_OFF);
    if (threadIdx.x == 0) { bst[0] = 0u; bst[1] = 0u; }
    __syncthreads();
    const unsigned bx = xb_xcc_id();
    if (threadIdx.x == 0) (void)xb_add(&((unsigned*)(p.ws + WS_BAR))[XB_XCNT(bx)], 1u);
    const int ph_lo = p.ph_lo, ph_hi = p.ph_hi;
    if (ph_lo == 0) {
        KP pp0 = (KP)__builtin_amdgcn_kernarg_segment_ptr();
        if (MK_EN & 1) REPS(1) phase_prep(pp0, lds, wv);
        if (ph_hi > 1) cg::this_grid().sync();
    }
    const int nrounds = (MK_DUP & 4096) ? 2 : 1;
    for (int ph2 = ph_lo > 1 ? ph_lo : 1; ph2 < ph_hi * nrounds; ++ph2) {
        const int ph = ph2 >= ph_hi ? ph2 - ph_hi : ph2;
        if (ph == 0) { KP pp0 = (KP)__builtin_amdgcn_kernarg_segment_ptr(); phase_prep(pp0, lds, wv); xcd_barrier((unsigned*)(p.ws + WS_BAR), xb_xcc_id(), (volatile LAS unsigned*)(lds3 + LDS_ST_OFF), wv); continue; }
        int q = ph; asm volatile("" : "+s"(q));
        KP pp = (KP)__builtin_amdgcn_kernarg_segment_ptr(); asm volatile("" : "+s"(pp));
        unsigned char* ws = pp->ws;
        const int G = gridDim.x, c = blockIdx.x;
        int kind, L = 0, half = 0;
        if (q == 0) kind = 0;
        else { const int pr = (q - 1) / 11, r = (q - 1) % 11;
            if (r < 4) { L = 2 * pr; kind = r == 0 ? 1 : r == 1 ? 2 : r == 2 ? 4 : 5; } else { L = 2 * pr + 1; const int r2 = r - 4;
                if (r2 == 0) kind = 6; else if (r2 < 5) { half = (r2 - 1) >> 1; kind = 8 + ((r2 - 1) & 1); } else kind = r2 == 5 ? 4 : 5; } }
        const int j = L >> 1;
        float* XRES = pp->out;
        bf16_t* XB = (bf16_t*)(ws + WS_XB);
        if (kind == 1) { pg8::Gemm g{XB, (const bf16_t*)(ws + W_GIN + j * W_GIN_SZ), T, GLA_NPAD, 1024}; pg8::StaticOrder S; S.init(T, GLA_NPAD, G, c);
            pg8::EpiGlaIn E{(bf16_t*)(ws + WS_GQK), (bf16_t*)(ws + WS_GV), (bf16_t*)(ws + WS_GZ), (float*)(ws + WS_GLR)}; if (MK_EN & 2) REPS(2) pg8::gemm_phase(lds3, g, S, E, wv); }
        else if (kind == 2) { if (MK_EN & 4) scan::phase_scan((const bf16_t*)(ws + WS_GQK), (const bf16_t*)(ws + WS_GV), (const float*)(ws + WS_GLR), (bf16_t*)(ws + WS_OFW),
                                                              pp->gla_w_gate + (size_t)j * 2 * 16 * 512, pp->gla_b_gate + (size_t)j * 2 * 512, (char*)lds, wv,
                                                              (bf16_t*)(ws + WS_GZ), pp->gla_gn_g + (size_t)j * 2048, (unsigned long long*)(ws + WS_XCH), (unsigned)(j + 1)); }
        else if (kind == 3) { if (MK_EN & 8) REPS(8) phase_gla_gate((const bf16_t*)(ws + WS_OFW), (bf16_t*)(ws + WS_GZ), pp->gla_gn_g + (size_t)j * 2048, wv, rep_ + 1 < nrep_); }
        else if (kind == 4) { const bool gla = (L & 1) == 0; const float* xin = L == 0 ? pp->x : XRES;
            pg8::Gemm g{(const bf16_t*)(ws + (gla ? WS_GZ : WS_MZ)), (const bf16_t*)(ws + (gla ? W_GOUT : W_MOUT) + j * W_OUT_SZ), T, 1024, 2048}; pg8::StaticOrder S; S.init(T, 1024, G, c);
            if (MK_EN & 16) REPS(16) { pg8::EpiRes E{XRES, xin, L == 0 ? (const f32x2*)nullptr : (const f32x2*)(ws + WS_STATS), pp->ln_g + (L - 1) * 1024, pp->ln_b + (L - 1) * 1024, rep_ + 1 < nrep_}; pg8::gemm_phase(lds3, g, S, E, wv); } }
        else if (kind == 5) { if (MK_EN & 1024) REPS(1024) phase_ln(XRES, XB, (f32x2*)(ws + WS_STATS), pp->ln_g + L * 1024, pp->ln_b + L * 1024, wv, rep_ + 1 < nrep_, L == 3); }
        else if (kind == 6) { pg8::Gemm g{XB, (const bf16_t*)(ws + W_MIN + j * W_MIN_SZ), T, MLA_NPAD, 1024}; pg8::StaticOrder S; S.init(T, MLA_NPAD, G, c);
            pg8::EpiMlaIn E{(bf16_t*)(ws + WS_MZ), (bf16_t*)(ws + WS_CKV), (bf16_t*)(ws + WS_CQ), (bf16_t*)(ws + WS_KRO), (float*)(ws + WS_RQ + (size_t)j * 524288), (float*)(ws + WS_RQ + (size_t)j * 524288 + 262144), (const float*)(ws + WS_COS), (const float*)(ws + WS_SIN)}; if (MK_EN & 32) REPS(32) pg8::gemm_phase(lds3, g, S, E, wv); }
        else if (kind == 7) { if (MK_EN & 64) REPS(64) phase_mla_stats((const bf16_t*)(ws + WS_CQ), (const bf16_t*)(ws + WS_CKV), (const float*)(ws + WS_KRR), (bf16_t*)(ws + WS_KRO), (float*)(ws + WS_RQ), (float*)(ws + WS_RKV),
                                                              (const float*)(ws + WS_COS), (const float*)(ws + WS_SIN), wv); }
        else if (kind == 8) {
            { pg8::Gemm g{(const bf16_t*)(ws + WS_CQ) + (size_t)half * TH * 384, (const bf16_t*)(ws + W_MUQ + j * W_MUQ_SZ), TH, 3072, 384}; pg8::StaticOrder S; S.init(TH, 3072, G, c);
              pg8::EpiQup E{(bf16_t*)(ws + WS_QH), (const float*)(ws + WS_RQ + (size_t)j * 524288), (const float*)(ws + WS_COS), (const float*)(ws + WS_SIN), half * TH}; if (MK_EN & 128) REPS(128) pg8::gemm_phase(lds3, g, S, E, wv); }
            { pg8::Gemm g{(const bf16_t*)(ws + WS_CKV) + (size_t)half * TH * 256, (const bf16_t*)(ws + W_MUKV + j * W_MUKV_SZ), TH, 4096, 256}; pg8::StaticOrder S; S.init(TH, 4096, G, c);
              pg8::EpiKVup E{(bf16_t*)(ws + WS_KNH), (bf16_t*)(ws + WS_VH), (const float*)(ws + WS_RQ + (size_t)j * 524288 + 262144), half * TH}; if (MK_EN & 256) REPS(256) pg8::gemm_phase(lds3, g, S, E, wv); }
        }
        else { if (MK_EN & 512) REPS(512) att::phase_attn((const bf16_t*)(ws + WS_QH), (const bf16_t*)(ws + WS_KNH), (const bf16_t*)(ws + WS_VH), (const bf16_t*)(ws + WS_KRO), (bf16_t*)(ws + WS_MZ), half, (char*)lds, wv, rep_ + 1 < nrep_); }
        if (ph2 + 1 < ph_hi * nrounds) REPS(2048) xcd_barrier((unsigned*)(ws + WS_BAR), xb_xcc_id(), (volatile LAS unsigned*)(lds3 + LDS_ST_OFF), wv);
    }
}

#ifndef MK_MULTI
#define MK_MULTI 0
#endif
extern "C" void kernel_launch(void* const* d_in, const int* in_sizes, int n_in, void* d_out, int out_size, void* d_ws, size_t ws_size, hipStream_t stream) {
    static int grid = 0;
    if (grid == 0) {
        if (n_in != 15 || out_size != T * DM || ws_size < WS_END) { fprintf(stderr, "kernel_launch: unexpected shapes n_in %d out %d ws %zu (need %zu)\n", n_in, out_size, ws_size, (size_t)WS_END); grid = -1; return; }
        if (hipFuncSetAttribute((const void*)mk_fwd, hipFuncAttributeMaxDynamicSharedMemorySize, LDS_BYTES) != hipSuccess) { fprintf(stderr, "kernel_launch: hipFuncSetAttribute failed\n"); grid = -1; return; }
        int dev = 0, cus = 0, per_cu = 0;
        hipGetDevice(&dev); hipDeviceGetAttribute(&cus, hipDeviceAttributeMultiprocessorCount, dev);
        hipOccupancyMaxActiveBlocksPerMultiprocessor(&per_cu, (const void*)mk_fwd, 512, LDS_BYTES);
        if (per_cu < 1) { fprintf(stderr, "kernel_launch: occupancy query says %d blocks per CU\n", per_cu); }
        (void)hipGetLastError();
        grid = cus > 0 ? cus : 256;
    }
    if (grid < 0) return;
    Params p{};
    p.x = (const float*)d_in[0]; p.pos = (const int*)d_in[1]; p.ln_g = (const float*)d_in[2]; p.ln_b = (const float*)d_in[3];
    p.gla_w_in = (const float*)d_in[4]; p.gla_w_gate = (const float*)d_in[5]; p.gla_b_gate = (const float*)d_in[6]; p.gla_gn_g = (const float*)d_in[7]; p.gla_w_out = (const float*)d_in[8];
    p.mla_w_in = (const float*)d_in[9]; p.mla_qn_g = (const float*)d_in[10]; p.mla_kvn_g = (const float*)d_in[11]; p.mla_w_uq = (const float*)d_in[12]; p.mla_w_ukv = (const float*)d_in[13]; p.mla_w_out = (const float*)d_in[14];
    p.out = (float*)d_out; p.ws = (unsigned char*)d_ws;
    if (hipMemsetAsync((char*)d_ws + WS_XCH, 0, 4 * MiB, stream) != hipSuccess) { fprintf(stderr, "kernel_launch: memset failed\n"); return; }
    if (hipMemsetAsync((char*)d_ws + WS_BAR, 0, XCD_BAR_WORDS * 4, stream) != hipSuccess) { fprintf(stderr, "kernel_launch: memset failed\n"); return; }
#if MK_MULTI
    for (int ph = 0; ph < NPHASE; ++ph) {
        p.ph_lo = ph; p.ph_hi = ph + 1;
        hipLaunchKernelGGL(mk_fwd, dim3(grid), dim3(512), LDS_BYTES, stream, p);
    }
#else
    p.ph_lo = 0; p.ph_hi = NPHASE;
    void* args[] = {&p};
    hipError_t e = hipLaunchCooperativeKernel((const void*)mk_fwd, dim3(grid), dim3(512), args, LDS_BYTES, stream);
    if (e != hipSuccess) fprintf(stderr, "cooperative launch failed: %s (grid %d)\n", hipGetErrorString(e), grid);
#endif
    const hipError_t le = hipPeekAtLastError();
    if (le != hipSuccess) fprintf(stderr, "kernel_launch: launch failed: %s\n", hipGetErrorName(le));
}
```
